# Optimizing an MI355X kernel written in HIP

```python
import math
import jax
import jax.numpy as jnp
from jax import lax
import numpy as np

D_MODEL = 2048
BATCH = 4
SEQ = 2048
DEPTH = 2

GRID_W = 64
CTX_LEN = 256
EPS = 1e-6
S5_WIDTH = 1024
S5_GROUP_CH = 16
S5_GROUPS = S5_WIDTH // S5_GROUP_CH
S5_STATE = 64
DN_HEADS = 8
DN_HEAD_DIM = 128
DN_WIDTH = DN_HEADS * DN_HEAD_DIM
DN_CONV = 3
DN_CHUNK = 64
IN_U_END = S5_WIDTH
IN_QKV_END = IN_U_END + 3 * DN_WIDTH
IN_Z_END = IN_QKV_END + DN_WIDTH
IN_BA_END = IN_Z_END + 4 * DN_HEADS
IN_TOTAL = IN_BA_END + 2 * D_MODEL
N_EXPERTS = 64
TOP_K = 8
N_GROUPS = 8
TOPK_GROUPS = 4
EXPERT_DIM = 512
SHARED_DIM = 512
ROUTE_SCALE = 2.5
EXPERT_BLOCK = 128

kernel_name = 'hybrid_s5_gdn_moe_prefix_dit'

F32 = jnp.float32


def rms_norm(x, w):
    xf = x.astype(F32)
    y = xf * lax.rsqrt(jnp.mean(xf * xf, axis=-1, keepdims=True) + EPS)
    return (y * w.astype(F32)).astype(x.dtype)


def modulate(h, shift, scale):
    return h * (1.0 + scale) + shift


def l2norm(x):
    return x * lax.rsqrt(jnp.sum(x * x, axis=-1, keepdims=True) + EPS)


def _flip(t):
    return jnp.flip(t, axis=1)


def _keep(t):
    return t


def raster_to_colmajor(t):
    b, l, ch = t.shape
    rows = l // GRID_W
    return t.reshape(b, rows, GRID_W, ch).transpose(0, 2, 1, 3).reshape(b, l, ch)


def colmajor_to_raster(t):
    b, l, ch = t.shape
    rows = l // GRID_W
    return t.reshape(b, GRID_W, rows, ch).transpose(0, 2, 1, 3).reshape(b, l, ch)


def centred_dwconv(x, w):
    k, ch = w.shape
    pad = (k - 1) // 2
    return lax.conv_general_dilated(x, w[:, None, :].astype(x.dtype), window_strides=(1,),
                                    padding=[(pad, pad)], dimension_numbers=('NWC', 'WIO', 'NWC'),
                                    feature_group_count=ch)


def s5_discretise(lam_re, lam_im, log_step, b_re, b_im):
    lr, li = lam_re.astype(F32), lam_im.astype(F32)
    step = jnp.exp(log_step.astype(F32))[:, None]
    mag = jnp.exp(lr * step)
    ab_re, ab_im = mag * jnp.cos(li * step), mag * jnp.sin(li * step)
    den = lr * lr + li * li
    nr = ab_re - 1.0
    cr = (nr * lr + ab_im * li) / den
    ci = (ab_im * lr - nr * li) / den
    br, bi = b_re.astype(F32), b_im.astype(F32)
    bb_re = cr[..., None] * br - ci[..., None] * bi
    bb_im = cr[..., None] * bi + ci[..., None] * br
    return ab_re, ab_im, bb_re, bb_im


def _complex_affine_combine(e1, e2):
    a1r, a1i, b1r, b1i = e1
    a2r, a2i, b2r, b2i = e2
    return (a2r * a1r - a2i * a1i, a2r * a1i + a2i * a1r,
            a2r * b1r - a2i * b1i + b2r, a2r * b1i + a2i * b1r + b2i)


def s5_scan(u, ab_re, ab_im, bb_re, bb_im, h0_re, h0_im):
    bu_re = jnp.einsum('gpj,blgj->blgp', bb_re, u)
    bu_im = jnp.einsum('gpj,blgj->blgp', bb_im, u)
    bu_re = bu_re.at[:, 0].add(ab_re * h0_re - ab_im * h0_im)
    bu_im = bu_im.at[:, 0].add(ab_re * h0_im + ab_im * h0_re)
    a_re = jnp.broadcast_to(ab_re, bu_re.shape)
    a_im = jnp.broadcast_to(ab_im, bu_im.shape)
    _, _, h_re, h_im = lax.associative_scan(_complex_affine_combine, (a_re, a_im, bu_re, bu_im), axis=1)
    return h_re, h_im


def s5_readout(h_re, h_im, c_re, c_im):
    return (jnp.einsum('gjp,blgp->blgj', c_re.astype(F32), h_re)
            - jnp.einsum('gjp,blgp->blgj', c_im.astype(F32), h_im))


def s5_glu(y, w_glu):
    g = jax.nn.gelu(y)
    return g * jax.nn.sigmoid(g @ w_glu.astype(F32))


def s5_branch(u_c, u_l, lam_re, lam_im, log_step, b_re, b_im, c_re, c_im, d_skip, w_glu, need_ctx):
    bsz = u_l.shape[0]
    uc = u_c.astype(F32).reshape(bsz, -1, S5_GROUPS, S5_GROUP_CH)
    ul = raster_to_colmajor(u_l).astype(F32).reshape(bsz, -1, S5_GROUPS, S5_GROUP_CH)
    dsk = d_skip.astype(F32).reshape(S5_GROUPS, S5_GROUP_CH)
    yl_parts, yc_parts = [ul * dsk], [uc * dsk]
    for d in range(2):
        fl = _flip if d == 1 else _keep
        ab_re, ab_im, bb_re, bb_im = s5_discretise(lam_re[d], lam_im[d], log_step[d], b_re[d], b_im[d])
        zero = jnp.zeros((bsz, S5_GROUPS, S5_STATE), F32)
        hc_re, hc_im = s5_scan(fl(uc), ab_re, ab_im, bb_re, bb_im, zero, zero)
        hl_re, hl_im = s5_scan(fl(ul), ab_re, ab_im, bb_re, bb_im, hc_re[:, -1], hc_im[:, -1])
        yl_parts.append(fl(s5_readout(hl_re, hl_im, c_re[d], c_im[d])))
        if need_ctx:
            yc_parts.append(fl(s5_readout(hc_re, hc_im, c_re[d], c_im[d])))
    y_l = (yl_parts[0] + yl_parts[1] + yl_parts[2]).reshape(bsz, -1, S5_WIDTH)
    out_l = colmajor_to_raster(s5_glu(y_l, w_glu)).astype(u_l.dtype)
    out_c = None
    if need_ctx:
        y_c = (yc_parts[0] + yc_parts[1] + yc_parts[2]).reshape(bsz, -1, S5_WIDTH)
        out_c = s5_glu(y_c, w_glu).astype(u_c.dtype)
    return out_c, out_l


def gated_delta_chunked(q, k, v, g, beta, s0):
    bsz, t, nh, dk = q.shape
    dv = v.shape[-1]
    n = t // DN_CHUNK
    c = DN_CHUNK

    def chunks(a):
        return a.reshape(bsz, n, c, nh, -1).transpose(1, 0, 3, 2, 4)

    qc, kc, vc = chunks(q), chunks(k), chunks(v)
    gc = g.reshape(bsz, n, c, nh).transpose(1, 0, 3, 2)
    bc = beta.reshape(bsz, n, c, nh).transpose(1, 0, 3, 2)
    gcum = jnp.cumsum(gc, axis=-1)
    causal = jnp.tril(jnp.ones((c, c), bool))
    strict = jnp.tril(jnp.ones((c, c), bool), -1)
    ldiff = gcum[..., :, None] - gcum[..., None, :]
    decay = jnp.where(causal, jnp.exp(jnp.where(causal, ldiff, 0.0)), 0.0)
    kbeta = kc * bc[..., None]
    a_mat = jnp.where(strict, jnp.einsum('nbhid,nbhjd->nbhij', kbeta, kc) * decay, 0.0)
    rhs = jnp.concatenate([vc * bc[..., None], kbeta * jnp.exp(gcum)[..., None]], axis=-1)
    sol = lax.linalg.triangular_solve(jnp.eye(c, dtype=F32) + a_mat, rhs, left_side=True, lower=True)
    u_c, w_c = sol[..., :dv], sol[..., dv:]
    qk = jnp.where(causal, jnp.einsum('nbhid,nbhjd->nbhij', qc, kc) * decay, 0.0)

    def step(s, inp):
        q_i, k_i, u_i, w_i, g_i, qk_i = inp
        v_new = u_i - jnp.einsum('bhck,bhkv->bhcv', w_i, s)
        o_i = (jnp.einsum('bhck,bhkv->bhcv', q_i * jnp.exp(g_i)[..., None], s)
               + jnp.einsum('bhij,bhjv->bhiv', qk_i, v_new))
        g_last = g_i[..., -1:]
        s = s * jnp.exp(g_last)[..., None] + jnp.einsum(
            'bhck,bhcv->bhkv', k_i * jnp.exp(g_last - g_i)[..., None], v_new)
        return s, o_i

    s_fin, o = lax.scan(step, s0, (qc, kc, u_c, w_c, gcum, qk))
    o = o.transpose(1, 0, 3, 2, 4).reshape(bsz, t, nh, dv)
    return o, s_fin


def dn_prepare(qkv, ba, conv_w, a_log, dt_bias):
    bsz, t, _ = qkv.shape
    qkv = jax.nn.silu(centred_dwconv(qkv, conv_w)).astype(F32).reshape(bsz, t, 3, DN_HEADS, DN_HEAD_DIM)
    q = l2norm(qkv[:, :, 0]) * (DN_HEAD_DIM ** -0.5)
    k = l2norm(qkv[:, :, 1])
    v = qkv[:, :, 2]
    ba = ba.astype(F32).reshape(bsz, t, 2, 2, DN_HEADS)
    beta = jax.nn.sigmoid(ba[:, :, 0])
    g = -jnp.exp(a_log.astype(F32)) * jax.nn.softplus(ba[:, :, 1] + dt_bias.astype(F32))
    return q, k, v, beta, g


def dn_gated_out(o, z, norm_w):
    bsz, t = o.shape[0], o.shape[1]
    zz = z.astype(F32).reshape(o.shape)
    return (rms_norm(o, norm_w) * jax.nn.silu(zz)).reshape(bsz, t, DN_WIDTH)


def deltanet_branch(p_c, p_l, conv_w, a_log, dt_bias, norm_w, need_ctx):
    qc, kc, vc, bc, gc = dn_prepare(p_c[..., IN_U_END:IN_QKV_END], p_c[..., IN_Z_END:IN_BA_END],
                                    conv_w, a_log, dt_bias)
    ql, kl, vl, bl, gl = dn_prepare(p_l[..., IN_U_END:IN_QKV_END], p_l[..., IN_Z_END:IN_BA_END],
                                    conv_w, a_log, dt_bias)
    bsz = p_l.shape[0]
    oc_parts, ol_parts = [], []
    for d in range(2):
        fl = _flip if d == 1 else _keep
        s0 = jnp.zeros((bsz, DN_HEADS, DN_HEAD_DIM, DN_HEAD_DIM), F32)
        oc, s_ctx = gated_delta_chunked(fl(qc), fl(kc), fl(vc), fl(gc[:, :, d]), fl(bc[:, :, d]), s0)
        ol, _ = gated_delta_chunked(fl(ql), fl(kl), fl(vl), fl(gl[:, :, d]), fl(bl[:, :, d]), s_ctx)
        oc_parts.append(fl(oc))
        ol_parts.append(fl(ol))
    out_l = dn_gated_out(ol_parts[0] + ol_parts[1], p_l[..., IN_QKV_END:IN_Z_END], norm_w).astype(p_l.dtype)
    out_c = None
    if need_ctx:
        out_c = dn_gated_out(oc_parts[0] + oc_parts[1], p_c[..., IN_QKV_END:IN_Z_END], norm_w).astype(p_c.dtype)
    return out_c, out_l


def branch_merge(p, y_s5, y_dn, w_br_s5, w_br_dn, w_out):
    g_s5 = p[..., IN_BA_END:IN_BA_END + D_MODEL]
    g_dn = p[..., IN_BA_END + D_MODEL:IN_TOTAL]
    m = jax.nn.sigmoid(g_s5) * (y_s5 @ w_br_s5) + jax.nn.sigmoid(g_dn) * (y_dn @ w_br_dn)
    return m @ w_out


def swiglu(x, wg, wu, wd):
    return (jax.nn.silu(x @ wg) * (x @ wu)) @ wd


def routed_experts(h, eidx, wts, w_gate, w_up, w_down):
    t, d = h.shape
    n_assign = t * TOP_K
    flat_e = eidx.reshape(n_assign).astype(jnp.int32)
    flat_tok = jnp.arange(n_assign, dtype=jnp.int32) // TOP_K
    flat_w = wts.reshape(n_assign)
    order = jnp.argsort(flat_e)
    se, stok, sw = flat_e[order], flat_tok[order], flat_w[order]
    counts = jnp.zeros((N_EXPERTS,), jnp.int32).at[flat_e].add(1)
    padded = (counts + EXPERT_BLOCK - 1) // EXPERT_BLOCK * EXPERT_BLOCK
    pad_end = jnp.cumsum(padded)
    pad_start = pad_end - padded
    start = jnp.cumsum(counts) - counts
    dest = pad_start[se] + jnp.arange(n_assign, dtype=jnp.int32) - start[se]
    n_blocks = (n_assign + N_EXPERTS * (EXPERT_BLOCK - 1) + EXPERT_BLOCK - 1) // EXPERT_BLOCK
    rows = n_blocks * EXPERT_BLOCK
    tok_buf = jnp.zeros((rows,), jnp.int32).at[dest].set(stok)
    w_buf = jnp.zeros((rows,), h.dtype).at[dest].set(sw)
    block_e = jnp.minimum(jnp.searchsorted(pad_end, jnp.arange(n_blocks, dtype=jnp.int32) * EXPERT_BLOCK,
                                           side='right'), N_EXPERTS - 1)

    def block_fn(args):
        e, toks, w = args
        return swiglu(h[toks], w_gate[e], w_up[e], w_down[e]) * w[:, None]

    y = lax.map(block_fn, (block_e, tok_buf.reshape(n_blocks, EXPERT_BLOCK), w_buf.reshape(n_blocks, EXPERT_BLOCK)))
    return jnp.zeros_like(h).at[tok_buf].add(y.reshape(rows, d))


def moe_ffn(h, w_router, e_bias, w_gate, w_up, w_down, ws_gate, ws_up, ws_down):
    t = h.shape[0]
    scores = jax.nn.sigmoid((h @ w_router).astype(F32))
    sel = (scores + e_bias.astype(F32)).reshape(t, N_GROUPS, N_EXPERTS // N_GROUPS)
    group_score = lax.top_k(sel, 2)[0].sum(-1)
    _, gidx = lax.top_k(group_score, TOPK_GROUPS)
    gmask = jnp.any(gidx[:, :, None] == jnp.arange(N_GROUPS)[None, None, :], axis=1)
    sel = jnp.where(gmask[:, :, None], sel, -jnp.inf).reshape(t, N_EXPERTS)
    _, eidx = lax.top_k(sel, TOP_K)
    wts = jnp.take_along_axis(scores, eidx, axis=-1)
    wts = wts / jnp.sum(wts, axis=-1, keepdims=True) * ROUTE_SCALE
    routed = routed_experts(h, eidx, wts.astype(h.dtype), w_gate, w_up, w_down)
    return routed + swiglu(h, ws_gate, ws_up, ws_down)


def setup_inputs(seed: int = 0) -> dict:
    key = jax.random.key(seed)
    ks = iter(list(jax.random.split(key, 40)))
    D, L, G, P, J, H, E = D_MODEL, DEPTH, S5_GROUPS, S5_STATE, S5_GROUP_CH, DN_HEADS, N_EXPERTS

    def nrm(shape, scale):
        return jax.random.normal(next(ks), shape, F32) * scale

    def uni(shape, lo, hi):
        return jax.random.uniform(next(ks), shape, F32, lo, hi)

    dt = jnp.exp(uni((L, 2, H), math.log(1e-3), math.log(1e-1)))
    return {
        'x': nrm((BATCH, SEQ, D), 1.0),
        'c': nrm((BATCH, D), 1.0),
        'ctx': nrm((BATCH, CTX_LEN, D), 1.0),
        'c_ctx': nrm((D,), 1.0),
        'w_mod': nrm((L, D, 6 * D), 0.5 * D ** -0.5),
        'b_mod': nrm((L, 6 * D), 0.02),
        'norm_mix_pre': 1.0 + nrm((L, D), 0.02),
        'norm_mix_post': 1.0 + nrm((L, D), 0.02),
        'norm_ffn_pre': 1.0 + nrm((L, D), 0.02),
        'norm_ffn_post': 1.0 + nrm((L, D), 0.02),
        'w_in': nrm((L, D, IN_TOTAL), D ** -0.5),
        's5_lam_re': -0.5 + nrm((L, 2, G, P), 0.01),
        's5_lam_im': jnp.pi * jnp.arange(P, dtype=F32) + nrm((L, 2, G, P), 0.01),
        's5_log_step': uni((L, 2, G), math.log(1e-3), math.log(1e-1)),
        's5_b_re': nrm((L, 2, G, P, J), (2 * J) ** -0.5),
        's5_b_im': nrm((L, 2, G, P, J), (2 * J) ** -0.5),
        's5_c_re': nrm((L, 2, G, J, P), (2 * P) ** -0.5),
        's5_c_im': nrm((L, 2, G, J, P), (2 * P) ** -0.5),
        's5_d': nrm((L, S5_WIDTH), 1.0),
        's5_w_glu': nrm((L, S5_WIDTH, S5_WIDTH), S5_WIDTH ** -0.5),
        'dn_conv': nrm((L, DN_CONV, 3 * DN_WIDTH), DN_CONV ** -0.5),
        'dn_a_log': jnp.log(uni((L, 2, H), 1.0, 16.0)),
        'dn_dt_bias': dt + jnp.log(-jnp.expm1(-dt)),
        'dn_norm': 1.0 + nrm((L, DN_HEAD_DIM), 0.02),
        'w_br_s5': nrm((L, S5_WIDTH, D), S5_WIDTH ** -0.5),
        'w_br_dn': nrm((L, DN_WIDTH, D), DN_WIDTH ** -0.5),
        'w_out': nrm((L, D, D), D ** -0.5),
        'moe_router': nrm((L, D, E), D ** -0.5),
        'moe_bias': nrm((L, E), 0.01),
        'moe_w_gate': nrm((L, E, D, EXPERT_DIM), D ** -0.5),
        'moe_w_up': nrm((L, E, D, EXPERT_DIM), D ** -0.5),
        'moe_w_down': nrm((L, E, EXPERT_DIM, D), EXPERT_DIM ** -0.5),
        'sh_w_gate': nrm((L, D, SHARED_DIM), D ** -0.5),
        'sh_w_up': nrm((L, D, SHARED_DIM), D ** -0.5),
        'sh_w_down': nrm((L, SHARED_DIM, D), SHARED_DIM ** -0.5),
    }


def reference(x, c, ctx, c_ctx, w_mod, b_mod, norm_mix_pre, norm_mix_post, norm_ffn_pre, norm_ffn_post,
              w_in, s5_lam_re, s5_lam_im, s5_log_step, s5_b_re, s5_b_im, s5_c_re, s5_c_im, s5_d, s5_w_glu,
              dn_conv, dn_a_log, dn_dt_bias, dn_norm, w_br_s5, w_br_dn, w_out,
              moe_router, moe_bias, moe_w_gate, moe_w_up, moe_w_down, sh_w_gate, sh_w_up, sh_w_down):
    x_lat, x_ctx = x, ctx
    for i in range(DEPTH):
        need_ctx = i < DEPTH - 1
        mods_l = jnp.split((jax.nn.silu(c) @ w_mod[i] + b_mod[i])[:, None, :], 6, axis=-1)
        mods_c = jnp.split(jax.nn.silu(c_ctx) @ w_mod[i] + b_mod[i], 6, axis=-1)
        p_l = modulate(rms_norm(x_lat, norm_mix_pre[i]), mods_l[0], mods_l[1]) @ w_in[i]
        p_c = modulate(rms_norm(x_ctx, norm_mix_pre[i]), mods_c[0], mods_c[1]) @ w_in[i]
        s5_c, s5_l = s5_branch(p_c[..., :IN_U_END], p_l[..., :IN_U_END], s5_lam_re[i], s5_lam_im[i],
                               s5_log_step[i], s5_b_re[i], s5_b_im[i], s5_c_re[i], s5_c_im[i], s5_d[i],
                               s5_w_glu[i], need_ctx)
        dn_c, dn_l = deltanet_branch(p_c, p_l, dn_conv[i], dn_a_log[i], dn_dt_bias[i], dn_norm[i], need_ctx)
        mix_l = branch_merge(p_l, s5_l, dn_l, w_br_s5[i], w_br_dn[i], w_out[i])
        x_lat = x_lat + mods_l[2] * rms_norm(mix_l, norm_mix_post[i])
        if need_ctx:
            mix_c = branch_merge(p_c, s5_c, dn_c, w_br_s5[i], w_br_dn[i], w_out[i])
            x_ctx = x_ctx + mods_c[2] * rms_norm(mix_c, norm_mix_post[i])
        h_l = modulate(rms_norm(x_lat, norm_ffn_pre[i]), mods_l[3], mods_l[4]).reshape(-1, D_MODEL)
        moe_args = (moe_router[i], moe_bias[i], moe_w_gate[i], moe_w_up[i], moe_w_down[i],
                    sh_w_gate[i], sh_w_up[i], sh_w_down[i])
        if need_ctx:
            h_c = modulate(rms_norm(x_ctx, norm_ffn_pre[i]), mods_c[3], mods_c[4]).reshape(-1, D_MODEL)
            n_c = h_c.shape[0]
            f = moe_ffn(jnp.concatenate([h_c, h_l], axis=0), *moe_args)
            f_c, f_l = f[:n_c], f[n_c:]
            x_ctx = x_ctx + mods_c[5] * rms_norm(f_c.reshape(x_ctx.shape), norm_ffn_post[i])
        else:
            f_l = moe_ffn(h_l, *moe_args)
        x_lat = x_lat + mods_l[5] * rms_norm(f_l.reshape(x_lat.shape), norm_ffn_post[i])
    return x_lat
```

```cpp
#include <hip/hip_runtime.h>
#include <cstdio>
#include <cstdint>
#ifndef MK_PER_PHASE
#define MK_PER_PHASE 0
#endif
#define DBG_STOP 0
namespace pg8 {
#define PG8_LAS __attribute__((address_space(3)))
typedef unsigned short bf16_t;
typedef short bf16x8 __attribute__((ext_vector_type(8)));
typedef float f32x4 __attribute__((ext_vector_type(4)));
typedef unsigned u32x4 __attribute__((ext_vector_type(4)));
constexpr int BM = 256, BK = 64, HALF = 128, HTB = HALF * BK * 2  , STAGE_BYTES = 8 * HTB, NXCD = 8, WGM = 8;

__host__ __device__ __forceinline__ int lds_byte(int r, int c) { const int st = (r >> 4) * 2 + (c >> 5), rr = r & 15, cc = c & 31, ob = rr * 64 + cc * 2; return st * 1024 + (ob ^ (((ob >> 9) & 1) << 5)); }
__host__ __device__ __forceinline__ void stage_rc(int b, int& R, int& C) { const int st = b / 1024, sb = b % 1024, swz = sb ^ (((sb >> 9) & 1) << 5); R = (st >> 1) * 16 + swz / 64; C = (st & 1) * 32 + (swz % 64) / 2; }
__host__ __device__ __forceinline__ int perm32(int rho) { const int n = rho >> 4, i = rho & 15; return 8 * (i >> 2) + 4 * n + (i & 3); }

struct Unit { int pm, pn; };
struct Gemm { const bf16_t* A; const bf16_t* Bt; int M, N, K; };

struct StaticOrder {
    int nM, nN, nwg, G, c;
    __host__ __device__ void init(int M, int N, int G_, int c_) { nM = M / BM; nN = N / BM; nwg = nM * nN; G = G_; c = c_; }
    __host__ __device__ bool next(int i, Unit& u) const {
        const long L = (long)i * G + c; if (L >= nwg) return false;
        int wgid = (int)L; { const int q = nwg / NXCD, r = nwg % NXCD, xcd = wgid % NXCD, off = wgid / NXCD; wgid = (xcd < r ? xcd * (q + 1) : r * (q + 1) + (xcd - r) * q) + off; }
        const int nig = WGM * nN, gid = wgid / nig, fm = gid * WGM, gsz = (nM - fm) < WGM ? (nM - fm) : WGM;
        u.pm = fm + ((wgid % nig) % gsz); u.pn = (wgid % nig) / gsz; return true;
    }
    __device__ __forceinline__ void a_ready(const Unit&) const {}
    __device__ __forceinline__ void done(const Unit&) const {}
};
struct CountedOrder : StaticOrder {
    const unsigned* ready; unsigned need; unsigned* tmo;
    __device__ __forceinline__ void a_ready(const Unit& u) const {
        if (threadIdx.x < 64) {
            const unsigned long long t0 = __builtin_amdgcn_s_memrealtime(); unsigned polls = 0;
            while ((unsigned)__builtin_amdgcn_readfirstlane(__hip_atomic_load(ready + 64 * u.pm, __ATOMIC_RELAXED, __HIP_MEMORY_SCOPE_AGENT)) < need) {
                if ((++polls & 255u) == 0u && __builtin_amdgcn_readfirstlane(__hip_atomic_load(tmo, __ATOMIC_RELAXED, __HIP_MEMORY_SCOPE_AGENT)) != 0u) break;
                if (__builtin_amdgcn_s_memrealtime() - t0 > 2000000ull) {
                    if (threadIdx.x == 0) { unsigned expect = 0u; __hip_atomic_compare_exchange_strong(tmo + 1, &expect, 0x600u | (unsigned)(u.pm & 0xff), __ATOMIC_RELAXED, __ATOMIC_RELAXED, __HIP_MEMORY_SCOPE_AGENT); __hip_atomic_store(tmo, 1u, __ATOMIC_RELAXED, __HIP_MEMORY_SCOPE_AGENT); }
                    break; }
                __builtin_amdgcn_s_sleep(2); }
            __builtin_amdgcn_fence(__ATOMIC_ACQUIRE, "agent");
            asm volatile("s_waitcnt vmcnt(0)" ::: "memory");
        }
#if !defined(BROKEN_HOOK_NO_BARRIER)
        asm volatile("" ::: "memory"); __builtin_amdgcn_s_barrier(); asm volatile("" ::: "memory");
#endif
    }
};

__device__ __forceinline__ unsigned cvt_pk_bf16(float lo, float hi) { unsigned r; asm volatile("v_cvt_pk_bf16_f32 %0, %1, %2" : "=v"(r) : "v"(lo), "v"(hi)); return r; }
typedef float f32x2 __attribute__((ext_vector_type(2)));
__device__ __forceinline__ f32x2 gelu_pk(f32x2 v) {
    const f32x2 av = __builtin_elementwise_abs(v), d = av * 0.2316418882f + 1.0f;
    f32x2 t; t.x = __builtin_amdgcn_rcpf(d.x); t.y = __builtin_amdgcn_rcpf(d.y);
    f32x2 q = t * 0.5307027145f + (-0.7265760135f); q = q * t + 0.7107068705f; q = q * t + (-0.142248368f); q = q * t + 0.127414796f; q = q * t;
    const f32x2 s = (v * v) * (-0.72134752044f);
    f32x2 e; e.x = __builtin_amdgcn_exp2f(s.x); e.y = __builtin_amdgcn_exp2f(s.y);
    const f32x2 m = v * (q * e), r = v - m;
    f32x2 o; o.x = v.x < 0.f ? m.x : r.x; o.y = v.y < 0.f ? m.y : r.y; return o;
}

struct EpiF32 {
    static constexpr bool PERM = false, AFTER_DRAIN = false;
    float* C; int ldc; const float* bias;
    __device__ __forceinline__ void operator()(const f32x4 (&acc)[2][2][4][2], const Unit& u, int wr, int wc, int fr, int fq) const {
        const int row0 = u.pm * BM + wr * 64 + fr, col0 = u.pn * BM + wc * 32 + 4 * fq;
        f32x4 bv[2][2];
#pragma unroll
        for (int bj = 0; bj < 2; ++bj)
#pragma unroll
            for (int n = 0; n < 2; ++n) bv[bj][n] = bias ? *(const f32x4*)(bias + col0 + bj * HALF + n * 16) : (f32x4){0.f, 0.f, 0.f, 0.f};
#pragma unroll
        for (int ai = 0; ai < 2; ++ai)
#pragma unroll
            for (int m = 0; m < 4; ++m) { float* rowp = C + (size_t)(row0 + ai * HALF + m * 16) * ldc + col0;
#pragma unroll
                for (int bj = 0; bj < 2; ++bj)
#pragma unroll
                    for (int n = 0; n < 2; ++n) *(f32x4*)(rowp + bj * HALF + n * 16) = acc[ai][bj][m][n] + bv[bj][n]; }
    }
};
template <int ACT  > struct EpiBf16 {
    static constexpr bool PERM = true, AFTER_DRAIN = false;
    bf16_t* O; int ldc; const float* bias; int split_cols; size_t split_stride;
    __device__ __forceinline__ void operator()(const f32x4 (&acc)[2][2][4][2], const Unit& u, int wr, int wc, int fr, int fq) const {
        const int row0 = u.pm * BM + wr * 64 + fr; int colt = u.pn * BM; bf16_t* base = O;
        if (split_cols) { const int t = colt / split_cols; base += (size_t)t * split_stride; colt -= t * split_cols; }
        const int col0 = colt + wc * 32 + 8 * fq, bcol0 = u.pn * BM + wc * 32 + 8 * fq;
        f32x4 bv[2][2];
#pragma unroll
        for (int bj = 0; bj < 2; ++bj)
#pragma unroll
            for (int n = 0; n < 2; ++n) bv[bj][n] = bias ? *(const f32x4*)(bias + bcol0 + bj * HALF + 4 * n) : (f32x4){0.f, 0.f, 0.f, 0.f};
#pragma unroll
        for (int ai = 0; ai < 2; ++ai)
#pragma unroll
            for (int m = 0; m < 4; ++m) { bf16_t* rowp = base + (size_t)(row0 + ai * HALF + m * 16) * ldc + col0;
#pragma unroll
                for (int bj = 0; bj < 2; ++bj) { f32x4 v0 = acc[ai][bj][m][0] + bv[bj][0], v1 = acc[ai][bj][m][1] + bv[bj][1];
                    if (ACT == 1) { f32x2 a = gelu_pk((f32x2){v0[0], v0[1]}), b = gelu_pk((f32x2){v0[2], v0[3]}), c = gelu_pk((f32x2){v1[0], v1[1]}), d = gelu_pk((f32x2){v1[2], v1[3]});
                        v0 = (f32x4){a.x, a.y, b.x, b.y}; v1 = (f32x4){c.x, c.y, d.x, d.y}; }
                    if (ACT == 2) {
#pragma unroll
                        for (int j = 0; j < 4; ++j) { v0[j] = 0.5f * v0[j] * (1.0f + erff(v0[j] * 0.70710678f)); v1[j] = 0.5f * v1[j] * (1.0f + erff(v1[j] * 0.70710678f)); } }
                    u32x4 w; w.x = cvt_pk_bf16(v0[0], v0[1]); w.y = cvt_pk_bf16(v0[2], v0[3]); w.z = cvt_pk_bf16(v1[0], v1[1]); w.w = cvt_pk_bf16(v1[2], v1[3]);
                    *(u32x4*)(rowp + bj * HALF) = w; } }
    }
};

struct PanelStats {
    unsigned* xbuf;
    unsigned* cnt;
    unsigned* tmo;
    int ntn; float eps;
    unsigned code;
    __device__ __forceinline__ bool run(const f32x4 (&v)[2][2][4][2], const Unit& u, int wr, int wc, int fr, int fq, PG8_LAS unsigned char* lds, int wid, int lane) const {
        typedef float f32x2v __attribute__((ext_vector_type(2)));
        PG8_LAS f32x2v* P = (PG8_LAS f32x2v*)lds;
        PG8_LAS f32x2v* S = (PG8_LAS f32x2v*)(lds + 8192);
        PG8_LAS unsigned* flag = (PG8_LAS unsigned*)(lds + 8192 + 2048);
#pragma unroll
        for (int ai = 0; ai < 2; ++ai)
#pragma unroll
            for (int m = 0; m < 4; ++m) {
                float s = 0.f;
#pragma unroll
                for (int bj = 0; bj < 2; ++bj)
#pragma unroll
                    for (int n = 0; n < 2; ++n) { const f32x4 x = v[ai][bj][m][n]; s += (x[0] + x[1]) + (x[2] + x[3]); }
                s += __shfl_xor(s, 16); s += __shfl_xor(s, 32);
                const float mw = s * (1.0f / 64.0f); float q = 0.f;
#pragma unroll
                for (int bj = 0; bj < 2; ++bj)
#pragma unroll
                    for (int n = 0; n < 2; ++n) { const f32x4 d = v[ai][bj][m][n] - mw; q += (d[0] * d[0] + d[1] * d[1]) + (d[2] * d[2] + d[3] * d[3]); }
                q += __shfl_xor(q, 16); q += __shfl_xor(q, 32);
                if (fq == 0) P[(ai * HALF + wr * 64 + m * 16 + fr) * 4 + wc] = (f32x2v){mw, q};
            }
        asm volatile("s_waitcnt lgkmcnt(0)" ::: "memory"); __builtin_amdgcn_s_barrier(); asm volatile("" ::: "memory");
#if defined(BROKEN_NO_WAIT)
        if (blockIdx.x >= 64) { const long long t0 = clock64(); while (clock64() - t0 < 60000) __builtin_amdgcn_s_sleep(8); }
#endif
        const int row = wid * 32 + (lane & 31);
        if (lane < 32) {
            const f32x2v a = P[row * 4 + 0], b = P[row * 4 + 1], c = P[row * 4 + 2], d = P[row * 4 + 3];
            const float mt = (a.x + b.x + c.x + d.x) * 0.25f;
            const float da = a.x - mt, db = b.x - mt, dc = c.x - mt, dd = d.x - mt;
            const float m2 = (a.y + b.y) + (c.y + d.y) + 64.0f * ((da * da + db * db) + (dc * dc + dd * dd));
            unsigned long long* slot = (unsigned long long*)xbuf + ((size_t)(u.pm * BM + row) * 4 + u.pn);
            __hip_atomic_store(slot, ((unsigned long long)__float_as_uint(m2) << 32) | __float_as_uint(mt), __ATOMIC_RELAXED, __HIP_MEMORY_SCOPE_AGENT);
        }
        asm volatile("s_waitcnt vmcnt(0)" ::: "memory");
        if (lane == 0) __hip_atomic_fetch_add(cnt + 64 * u.pm, 1u, __ATOMIC_RELAXED, __HIP_MEMORY_SCOPE_AGENT);
        if (wid == 0) {
            bool dead = false; const unsigned long long t0 = __builtin_amdgcn_s_memrealtime(); const unsigned want = 8u * (unsigned)ntn;
            for (;;) {
#if defined(BROKEN_NO_WAIT)
                break;
#endif
                if ((unsigned)__builtin_amdgcn_readfirstlane(__hip_atomic_load(cnt + 64 * u.pm, __ATOMIC_RELAXED, __HIP_MEMORY_SCOPE_AGENT)) >= want) break;
                if (__builtin_amdgcn_s_memrealtime() - t0 > 2000000ull) {
                    if (lane == 0) { unsigned expect = 0u; __hip_atomic_compare_exchange_strong(tmo + 1, &expect, code | (unsigned)(u.pm & 0xff), __ATOMIC_RELAXED, __ATOMIC_RELAXED, __HIP_MEMORY_SCOPE_AGENT);
                                     __hip_atomic_store(tmo, 1u, __ATOMIC_RELAXED, __HIP_MEMORY_SCOPE_AGENT); }
                    dead = true; break; }
                __builtin_amdgcn_s_sleep(2);
            }
            __builtin_amdgcn_fence(__ATOMIC_ACQUIRE, "agent");
            if (lane == 0) flag[0] = dead ? 1u : 0u;
        }
        asm volatile("s_waitcnt vmcnt(0) lgkmcnt(0)" ::: "memory"); __builtin_amdgcn_s_barrier(); asm volatile("" ::: "memory");
        const bool bad = flag[0] != 0u;
        if (lane < 32) {
            const unsigned long long* slot = (const unsigned long long*)xbuf + (size_t)(u.pm * BM + row) * 4; float mt[4], m2[4]; float ms = 0.f;
#pragma unroll
            for (int t = 0; t < 4; ++t) { if (t < ntn) { const unsigned long long w = __hip_atomic_load(slot + t, __ATOMIC_RELAXED, __HIP_MEMORY_SCOPE_AGENT); mt[t] = __uint_as_float((unsigned)w); m2[t] = __uint_as_float((unsigned)(w >> 32)); } else { mt[t] = 0.f; m2[t] = 0.f; } ms += mt[t]; }
            const float mean = ms / (float)ntn; float q = 0.f;
#pragma unroll
            for (int t = 0; t < 4; ++t) if (t < ntn) { const float dm = mt[t] - mean; q += m2[t] + 256.0f * dm * dm; }
            S[row] = (f32x2v){mean, 1.0f / sqrtf(q / (256.0f * (float)ntn) + eps)};
        }
        asm volatile("s_waitcnt lgkmcnt(0)" ::: "memory"); __builtin_amdgcn_s_barrier(); asm volatile("" ::: "memory");
        return bad;
    }
};
struct EpiLnRes {
    static constexpr bool PERM = false, AFTER_DRAIN = true;
    const float* base; float* out; int ldc; const float* bias; PanelStats st; unsigned poison;
    __device__ __forceinline__ void refuse(size_t i0, size_t stride, int M, int N) const { const float q = __builtin_nanf(""); for (size_t i = i0; i < (size_t)M * N; i += stride) out[(i / N) * ldc + i % N] = q;
        if (i0 == 0) { unsigned expect = 0u; __hip_atomic_compare_exchange_strong(st.tmo + 1, &expect, 0x7f0u, __ATOMIC_RELAXED, __ATOMIC_RELAXED, __HIP_MEMORY_SCOPE_AGENT); __hip_atomic_store(st.tmo, 1u, __ATOMIC_RELAXED, __HIP_MEMORY_SCOPE_AGENT); } }
    __device__ __forceinline__ void fused(f32x4 (&acc)[2][2][4][2], const Unit& u, int wr, int wc, int fr, int fq, PG8_LAS unsigned char* lds, int wid, int lane) const {
        typedef float f32x2v __attribute__((ext_vector_type(2)));
        const PG8_LAS f32x2v* S = (const PG8_LAS f32x2v*)(lds + 8192);
        const int col0 = u.pn * BM + wc * 32 + 4 * fq;
#pragma unroll
        for (int bj = 0; bj < 2; ++bj)
#pragma unroll
            for (int n = 0; n < 2; ++n) { const f32x4 bv = bias ? *(const f32x4*)(bias + col0 + bj * HALF + n * 16) : (f32x4){0.f, 0.f, 0.f, 0.f};
#pragma unroll
                for (int ai = 0; ai < 2; ++ai)
#pragma unroll
                    for (int m = 0; m < 4; ++m) acc[ai][bj][m][n] += bv; }
        const bool bad = st.run(acc, u, wr, wc, fr, fq, lds, wid, lane) || poison != 0u;
        const float qnan = __builtin_nanf("");
#pragma unroll
        for (int ai = 0; ai < 2; ++ai)
#pragma unroll
            for (int m = 0; m < 4; ++m) { const int r = ai * HALF + wr * 64 + m * 16 + fr; const f32x2v sr = S[r]; const size_t off = (size_t)(u.pm * BM + r) * ldc + col0;
#pragma unroll
                for (int bj = 0; bj < 2; ++bj)
#pragma unroll
                    for (int n = 0; n < 2; ++n) { const f32x4 bs = *(const f32x4*)(base + off + bj * HALF + n * 16); f32x4 o = bs + (acc[ai][bj][m][n] - sr.x) * sr.y;
                        if (bad) o = (f32x4){qnan, qnan, qnan, qnan}; *(f32x4*)(out + off + bj * HALF + n * 16) = o; }
                asm volatile("" ::: "memory"); }
    }
};
struct EpiLnResLn {
    static constexpr bool PERM = false, AFTER_DRAIN = true;
    const float* base; float* out; bf16_t* xn; int ldc; const float* bias; PanelStats st1, st2; unsigned poison;
    __device__ __forceinline__ void refuse(size_t i0, size_t stride, int M, int N) const { const float q = __builtin_nanf(""); for (size_t i = i0; i < (size_t)M * N; i += stride) { const size_t o = (i / N) * ldc + i % N; out[o] = q; xn[o] = (bf16_t)0x7fc0u; }
        if (i0 == 0) { unsigned expect = 0u; __hip_atomic_compare_exchange_strong(st1.tmo + 1, &expect, 0x7f0u, __ATOMIC_RELAXED, __ATOMIC_RELAXED, __HIP_MEMORY_SCOPE_AGENT); __hip_atomic_store(st1.tmo, 1u, __ATOMIC_RELAXED, __HIP_MEMORY_SCOPE_AGENT); } }
    __device__ __forceinline__ void fused(f32x4 (&acc)[2][2][4][2], const Unit& u, int wr, int wc, int fr, int fq, PG8_LAS unsigned char* lds, int wid, int lane) const {
        typedef float f32x2v __attribute__((ext_vector_type(2))); typedef unsigned u32x2v __attribute__((ext_vector_type(2)));
        const PG8_LAS f32x2v* S = (const PG8_LAS f32x2v*)(lds + 8192);
        const int col0 = u.pn * BM + wc * 32 + 4 * fq;
#pragma unroll
        for (int bj = 0; bj < 2; ++bj)
#pragma unroll
            for (int n = 0; n < 2; ++n) { const f32x4 bv = bias ? *(const f32x4*)(bias + col0 + bj * HALF + n * 16) : (f32x4){0.f, 0.f, 0.f, 0.f};
#pragma unroll
                for (int ai = 0; ai < 2; ++ai)
#pragma unroll
                    for (int m = 0; m < 4; ++m) acc[ai][bj][m][n] += bv; }
        bool bad = st1.run(acc, u, wr, wc, fr, fq, lds, wid, lane) || poison != 0u;
        const float qnan = __builtin_nanf("");
#pragma unroll
        for (int ai = 0; ai < 2; ++ai)
#pragma unroll
            for (int m = 0; m < 4; ++m) { const int r = ai * HALF + wr * 64 + m * 16 + fr; const f32x2v sr = S[r]; const size_t off = (size_t)(u.pm * BM + r) * ldc + col0;
#pragma unroll
                for (int bj = 0; bj < 2; ++bj)
#pragma unroll
                    for (int n = 0; n < 2; ++n) { const f32x4 bs = *(const f32x4*)(base + off + bj * HALF + n * 16); acc[ai][bj][m][n] = bs + (acc[ai][bj][m][n] - sr.x) * sr.y; }
                asm volatile("" : "+v"(acc[ai][0][m][0]), "+v"(acc[ai][0][m][1]), "+v"(acc[ai][1][m][0]), "+v"(acc[ai][1][m][1]));
                if (m & 1) asm volatile("" ::: "memory"); }
        const bool bad1 = bad;
        bad = st2.run(acc, u, wr, wc, fr, fq, lds, wid, lane) || bad;
#pragma unroll
        for (int ai = 0; ai < 2; ++ai)
#pragma unroll
            for (int m = 0; m < 4; ++m) { const int r = ai * HALF + wr * 64 + m * 16 + fr; const f32x2v sr = S[r]; const size_t off = (size_t)(u.pm * BM + r) * ldc + col0;
#pragma unroll
                for (int bj = 0; bj < 2; ++bj)
#pragma unroll
                    for (int n = 0; n < 2; ++n) { const f32x4 x1 = acc[ai][bj][m][n]; *(f32x4*)(out + off + bj * HALF + n * 16) = bad1 ? (f32x4){qnan, qnan, qnan, qnan} : x1;
                        const f32x4 o = (x1 - sr.x) * sr.y; u32x2v w; w.x = cvt_pk_bf16(o[0], o[1]); w.y = cvt_pk_bf16(o[2], o[3]);
                        if (bad) { w.x = 0x7fc07fc0u; w.y = 0x7fc07fc0u; } *(u32x2v*)(xn + off + bj * HALF + n * 16) = w; }
                asm volatile("" ::: "memory"); }
    }
};

template <class Epi, class Sched, bool STAMP = false>
__device__ __forceinline__ void gemm_phase(PG8_LAS unsigned char* lds, const Gemm g, const Sched& S, const Epi& E, unsigned long long* stamps) {
    int tid_ = threadIdx.x; asm volatile("" : "+v"(tid_));
    const int tid = tid_, wid = __builtin_amdgcn_readfirstlane(tid >> 6), lane = tid & 63, wr = wid >> 2, wc = wid & 3, fr = lane & 15, fq = lane >> 4;
    const int K = g.K, nt = K / BK;
    int ts_lo = 0, ts_hi = 0, nts = 0; const unsigned long long rt_entry = STAMP ? (unsigned long long)wall_clock64() : 0ull;
#define PG8_STAMP() do { if (STAMP && wid == 0 && nts < 64) { const unsigned long long _c = (unsigned long long)clock64(); \
        ts_lo = (lane == nts) ? (int)(unsigned)_c : ts_lo; ts_hi = (lane == nts) ? (int)(unsigned)(_c >> 32) : ts_hi; ++nts; } } while (0)
    PG8_STAMP();
    unsigned voffA[2], voffB[2];
#pragma unroll
    for (int i = 0; i < 2; ++i) { int R, C; stage_rc(tid * 16 + i * 8192, R, C); const int Rb = Epi::PERM ? ((R & ~31) + perm32(R & 31)) : R;
        voffA[i] = (unsigned)(R * K + C) * 2u; voffB[i] = (unsigned)(Rb * K + C) * 2u; }
    const size_t kstep = (size_t)(BK * 2);
    const size_t hstep = (size_t)HALF * K * 2;
    const size_t tstep = 2 * hstep;
    const unsigned ldsw = (unsigned)wid * 1024u;
    const int aoff = lds_byte(wr * 64 + fr, fq * 8), boff = lds_byte(wc * 32 + fr, fq * 8);
#define PG8_SA(b, h) (((b) * 2 + (h)) * HTB)
#define PG8_SB(b, h) ((4 + (b) * 2 + (h)) * HTB)
#define PG8_STAGE(bufoff, gbase, voff) do { _Pragma("unroll") for (int _i = 0; _i < 2; ++_i) \
        __builtin_amdgcn_global_load_lds((const unsigned*)((const char*)(gbase) + (voff)[_i]), (PG8_LAS unsigned*)(lds + (bufoff) + ldsw + _i * 8192), 16, 0, 0); } while (0)
#define PG8_LDA(dst, b, h) do { _Pragma("unroll") for (int m = 0; m < 4; ++m) _Pragma("unroll") for (int k = 0; k < 2; ++k) dst[m][k] = *(const PG8_LAS bf16x8*)(lds + PG8_SA(b, h) + aoff + m * 2048 + k * 1024); } while (0)
#define PG8_LDB(dst, b, h) do { _Pragma("unroll") for (int n = 0; n < 2; ++n) _Pragma("unroll") for (int k = 0; k < 2; ++k) dst[n][k] = *(const PG8_LAS bf16x8*)(lds + PG8_SB(b, h) + boff + n * 2048 + k * 1024); } while (0)
#define PG8_MMA(ai, bj, At, Bt) do { __builtin_amdgcn_s_setprio(1); _Pragma("unroll") for (int m = 0; m < 4; ++m) _Pragma("unroll") for (int n = 0; n < 2; ++n) _Pragma("unroll") for (int k = 0; k < 2; ++k) \
        acc[ai][bj][m][n] = __builtin_amdgcn_mfma_f32_16x16x32_bf16(Bt[n][k], At[m][k], acc[ai][bj][m][n], 0, 0, 0); __builtin_amdgcn_s_setprio(0); } while (0)
#define PG8_WAIT_V(n) asm volatile("s_waitcnt vmcnt(" #n ")" ::: "memory")
#define PG8_WAIT_L(n) asm volatile("s_waitcnt lgkmcnt(" #n ")" ::: "memory")
#define PG8_BAR __builtin_amdgcn_s_barrier()
#define PG8_SCHED __builtin_amdgcn_sched_barrier(0)
    Unit cur, nxt; int ui = 0;
    if (!S.next(0, cur)) return;
    f32x4 acc[2][2][4][2];
#pragma unroll
    for (int a = 0; a < 2; ++a)
#pragma unroll
        for (int b = 0; b < 2; ++b)
#pragma unroll
            for (int m = 0; m < 4; ++m)
#pragma unroll
                for (int n = 0; n < 2; ++n) acc[a][b][m][n] = (f32x4){0.f, 0.f, 0.f, 0.f};
    bf16x8 At[4][2], B0[2][2], B1[2][2];
    const char* cA = (const char*)g.A + (size_t)cur.pm * tstep; const char* cB = (const char*)g.Bt + (size_t)cur.pn * tstep;
    S.a_ready(cur);
    PG8_STAGE(PG8_SB(0, 0), cB, voffB); PG8_STAGE(PG8_SA(0, 0), cA, voffA); PG8_STAGE(PG8_SB(0, 1), cB + hstep, voffB); PG8_STAGE(PG8_SA(0, 1), cA + hstep, voffA);
    if (wr == 1) PG8_BAR;
    PG8_WAIT_V(4); PG8_BAR;
    PG8_STAGE(PG8_SB(1, 0), cB + kstep, voffB); PG8_STAGE(PG8_SA(1, 0), cA + kstep, voffA); PG8_STAGE(PG8_SB(1, 1), cB + hstep + kstep, voffB);
    PG8_WAIT_V(6); PG8_BAR;
    PG8_STAMP();
    for (;;) {
        const bool has_next = S.next(ui + 1, nxt);
        const char* nA = has_next ? (const char*)g.A + (size_t)nxt.pm * tstep : cA; const char* nB = has_next ? (const char*)g.Bt + (size_t)nxt.pn * tstep : cB;
        for (int t = 0; t < nt; t += 2) {
            const bool last = (t == nt - 2);
            const char* a1 = cA + (size_t)(t + 1) * kstep;
            const char* a2 = last ? nA : cA + (size_t)(t + 2) * kstep; const char* b2 = last ? nB : cB + (size_t)(t + 2) * kstep;
            const char* a3 = a2 + kstep; const char* b3 = b2 + kstep;
            if (last && has_next) S.a_ready(nxt);
            PG8_LDB(B0, 0, 0); PG8_SCHED; PG8_LDA(At, 0, 0); PG8_STAGE(PG8_SA(1, 1), a1 + hstep, voffA);
            PG8_WAIT_L(8); PG8_BAR; PG8_WAIT_L(0); PG8_MMA(0, 0, At, B0); PG8_BAR; PG8_SCHED;
            PG8_LDB(B1, 0, 1); PG8_STAGE(PG8_SB(0, 0), b2, voffB);
            PG8_BAR; PG8_WAIT_L(0); PG8_MMA(0, 1, At, B1); PG8_BAR;
            PG8_LDA(At, 0, 1); PG8_STAGE(PG8_SA(0, 0), a2, voffA);
            PG8_BAR; PG8_WAIT_L(0); PG8_MMA(1, 0, At, B0); PG8_BAR; PG8_SCHED;
            PG8_STAGE(PG8_SB(0, 1), b2 + hstep, voffB);
            PG8_WAIT_V(6); PG8_BAR; PG8_MMA(1, 1, At, B1); PG8_BAR;
            PG8_LDB(B0, 1, 0); PG8_SCHED; PG8_LDA(At, 1, 0); PG8_STAGE(PG8_SA(0, 1), a2 + hstep, voffA);
            PG8_WAIT_L(8); PG8_BAR; PG8_WAIT_L(0); PG8_MMA(0, 0, At, B0); PG8_BAR; PG8_SCHED;
            PG8_LDB(B1, 1, 1); PG8_STAGE(PG8_SB(1, 0), b3, voffB);
            PG8_BAR; PG8_WAIT_L(0); PG8_MMA(0, 1, At, B1); PG8_BAR;
            PG8_LDA(At, 1, 1); PG8_STAGE(PG8_SA(1, 0), a3, voffA);
            PG8_BAR; PG8_WAIT_L(0); PG8_MMA(1, 0, At, B0); PG8_BAR; PG8_SCHED;
            PG8_STAGE(PG8_SB(1, 1), b3 + hstep, voffB);
            PG8_WAIT_V(6); PG8_BAR; PG8_MMA(1, 1, At, B1); PG8_BAR;
        }
        PG8_STAMP();
        if constexpr (!Epi::AFTER_DRAIN) { E(acc, cur, wr, wc, fr, fq); S.done(cur); }
        PG8_STAMP();
        if (!has_next) break;
#pragma unroll
        for (int a = 0; a < 2; ++a)
#pragma unroll
            for (int b = 0; b < 2; ++b)
#pragma unroll
                for (int m = 0; m < 4; ++m)
#pragma unroll
                    for (int n = 0; n < 2; ++n) acc[a][b][m][n] = (f32x4){0.f, 0.f, 0.f, 0.f};
        cur = nxt; cA = nA; cB = nB; ++ui;
    }
    PG8_WAIT_V(0);
    if (wr == 0) PG8_BAR;
    PG8_BAR;
    if constexpr (Epi::AFTER_DRAIN) { E.fused(acc, cur, wr, wc, fr, fq, lds, wid, lane); S.done(cur); }
    PG8_STAMP();
    if (STAMP && wid == 0) { stamps[lane] = lane < nts ? (((unsigned long long)(unsigned)ts_hi << 32) | (unsigned)ts_lo) : 0ull;
        if (lane == 62) stamps[62] = rt_entry; if (lane == 63) stamps[63] = (unsigned long long)wall_clock64(); }
#undef PG8_STAMP
#undef PG8_SA
#undef PG8_SB
#undef PG8_STAGE
#undef PG8_LDA
#undef PG8_LDB
#undef PG8_MMA
#undef PG8_WAIT_V
#undef PG8_WAIT_L
#undef PG8_BAR
#undef PG8_SCHED
}
}

constexpr int DM = 2048, NBATCH = 4, SEQ = 2048, CTXL = 256;
constexpr int TC = NBATCH * CTXL;
constexpr int TL = NBATCH * SEQ;
constexpr int TT = TC + TL;
constexpr int NLAYER = 2;
constexpr int NPAD = 9472;
constexpr int PC_U = 0, PC_QKV = 1024, PC_Z = 4096, PC_GS5 = 5120, PC_GDN = 7168, PC_BA = 9216;
constexpr int NE = 64, NEX = 65, EDIM = 512;
constexpr int MAXTILES = 388, MAXSLOT = MAXTILES * 256;
constexpr float EPS = 1e-6f;
constexpr int MODW = 12288;

constexpr size_t MiB = 1u << 20;
constexpr size_t WS_CTL = 0, CTL_ZERO_BYTES = 2 * MiB;
constexpr int CW_BAR = 4096;
constexpr int CW_CNT = 16384;
constexpr int CW_FILL = 16384 + 256;
constexpr size_t WS_MODS = 1 * MiB;
constexpr size_t WS_MISC = 2 * MiB;
constexpr size_t WS_W = 4 * MiB;
constexpr size_t WO_IN = 0, WO_GLU = 37 * MiB, WO_BRS = 39 * MiB, WO_BRD = 43 * MiB, WO_OUT = 47 * MiB, WO_GU = 55 * MiB, WO_DN = (55 + 260) * MiB, W_BYTES = (55 + 260 + 130) * MiB;
constexpr size_t WS_X = WS_W + W_BYTES;
constexpr size_t WS_EIDX = WS_X + 72 * MiB;
constexpr size_t WS_WTS = WS_EIDX + 1 * MiB;
constexpr size_t WS_SLOT = WS_WTS + 1 * MiB;
constexpr size_t WS_AB = WS_SLOT + 1 * MiB;
constexpr size_t WS_B = WS_AB + 36 * MiB;
constexpr size_t WB_P = 0;
constexpr size_t WB_QKV = 167 * MiB;
constexpr size_t WB_BG = WB_QKV + 108 * MiB;
constexpr size_t WB_Y = WB_BG + 2 * MiB;
constexpr size_t WB_O = WB_Y + 72 * MiB;
constexpr size_t WB_G = WB_O + 72 * MiB;
constexpr size_t WB_DNO = WB_G + 18 * MiB;
constexpr size_t WB_S5O = WB_DNO + 18 * MiB;
constexpr size_t WB_M1 = WB_S5O + 18 * MiB;
constexpr size_t WB_M = WB_M1 + 72 * MiB;
constexpr size_t WB_MIX = WB_M + 36 * MiB;
constexpr size_t WB_END = WB_MIX + 72 * MiB;
constexpr size_t WB_HPERM = 0;
constexpr size_t WB_ACT = 388 * MiB;
static_assert(WB_ACT + 97 * MiB <= WB_END, "moe scratch fits");
constexpr size_t WS_END = WS_B + WB_END;

constexpr int LDS_BYTES = 147456;
constexpr int LDS_MISC = 131072 + 1024;

#define LAS __attribute__((address_space(3)))
typedef unsigned short bf16;
typedef float f32x4 __attribute__((ext_vector_type(4)));
typedef float f32x2 __attribute__((ext_vector_type(2)));
typedef unsigned u32x4 __attribute__((ext_vector_type(4)));
typedef unsigned u32x2 __attribute__((ext_vector_type(2)));

#define LDS_WAIT() asm volatile("s_waitcnt lgkmcnt(0)" ::: "memory")
#define VM_WAIT() asm volatile("s_waitcnt vmcnt(0)" ::: "memory")

__device__ __forceinline__ unsigned f2bf(float f) { unsigned u = __float_as_uint(f); return (u + 0x7fffu + ((u >> 16) & 1u)) >> 16; }
__device__ __forceinline__ unsigned pk2(float lo, float hi) { return f2bf(lo) | (f2bf(hi) << 16); }
__device__ __forceinline__ float bflo(unsigned w) { return __uint_as_float(w << 16); }
__device__ __forceinline__ float bfhi(unsigned w) { return __uint_as_float(w & 0xffff0000u); }
__device__ __forceinline__ float bf2f(bf16 b) { return __uint_as_float(((unsigned)b) << 16); }
__device__ __forceinline__ float sigmoidf_(float x) { return 1.f / (1.f + __expf(-x)); }
__device__ __forceinline__ float siluf_(float x) { return x / (1.f + __expf(-x)); }
__device__ __forceinline__ float gelu_tanh(float x) { const float t = tanhf(0.7978845608028654f * (x + 0.044715f * x * x * x)); return 0.5f * x * (1.f + t); }
__device__ __forceinline__ float wave_sum(float v) {
#pragma unroll
    for (int o = 1; o < 64; o <<= 1) v += __shfl_xor(v, o);
    return v;
}

#define XB_TMO      128
#define XB_XCNT(j)  (256  + 64 * (j))
#define XB_XSUB(j)  (1280 + 64 * (j))
#define XB_XGEN(j)  (2304 + 64 * (j))
#define XB_TOP      3328
#define XB_TOPGEN   3392
#define XCD_BAR_WORDS 3456
#define XB_SPIN_CAP (1u << 20)

__device__ __forceinline__ unsigned xb_ld(unsigned* p)              { return __hip_atomic_load(p, __ATOMIC_RELAXED, __HIP_MEMORY_SCOPE_AGENT); }
__device__ __forceinline__ unsigned xb_add(unsigned* p, unsigned v) { return __hip_atomic_fetch_add(p, v, __ATOMIC_RELAXED, __HIP_MEMORY_SCOPE_AGENT); }
__device__ __forceinline__ unsigned xb_xcc_id() { return (unsigned)__builtin_amdgcn_s_getreg((3 << 11) | 20) & 0xFu; }
#define XB_SPIN(cond, bar) do { unsigned _sp = 0; while (cond) { __builtin_amdgcn_s_sleep(1); \
    if ((++_sp & 255u) == 0u) { if (xb_ld(&(bar)[XB_TMO])) break; if (_sp > XB_SPIN_CAP) { atomicAdd(&(bar)[XB_TMO], 1u); break; } } } } while (0)

struct XcdBarrier { unsigned* bar; unsigned x; volatile LAS unsigned* st; };

__device__ __forceinline__ XcdBarrier xcd_barrier_post(unsigned* bar, volatile LAS unsigned* st) {
    XcdBarrier b; b.bar = bar; b.x = xb_xcc_id(); b.st = st;
    if (threadIdx.x == 0) (void)xb_add(&bar[XB_XCNT(b.x)], 1u);
    return b;
}
__device__ __forceinline__ void xcd_barrier_complete(unsigned* bar, unsigned x, unsigned& nloc, unsigned& nx) {
    const unsigned G = gridDim.x * gridDim.y * gridDim.z;
    unsigned sum, cnt, mine, sp = 0u;
    for (;;) {
        sum = 0u; cnt = 0u; mine = 0u;
#pragma unroll
        for (unsigned j = 0; j < 16; ++j) { const unsigned c = xb_ld(&bar[XB_XCNT(j)]); sum += c; cnt += (c > 0u) ? 1u : 0u; mine = (j == x) ? c : mine; }
        if (sum == G) break;
        __builtin_amdgcn_s_sleep(1);
        if ((++sp & 255u) == 0u) { if (xb_ld(&bar[XB_TMO])) break; if (sp > XB_SPIN_CAP) { atomicAdd(&bar[XB_TMO], 1u); break; } }
    }
    nloc = mine > 0u ? mine : 1u; nx = cnt > 0u ? cnt : 1u;
}
__device__ __forceinline__ void xcd_barrier(const XcdBarrier& b) {
    asm volatile("s_waitcnt vmcnt(0)" ::: "memory");
    __syncthreads();
    if (threadIdx.x == 0) {
        unsigned* bar = b.bar; asm volatile("" : "+s"(bar));
        __builtin_amdgcn_s_waitcnt(0);
        unsigned nloc = b.st[0], nx = b.st[1];
        if (nloc == 0u) { xcd_barrier_complete(bar, b.x, nloc, nx); b.st[0] = nloc; b.st[1] = nx; }
        const unsigned old = xb_add(&bar[XB_XSUB(b.x)], 1u);
        const unsigned gen = old / nloc;
        if (old + 1u == (gen + 1u) * nloc) {
            __builtin_amdgcn_fence(__ATOMIC_RELEASE, "agent");
            asm volatile("s_waitcnt vmcnt(0)" ::: "memory");
            const unsigned og = xb_add(&bar[XB_TOP], 1u);
            const unsigned tg = og / nx;
            if (og + 1u == (tg + 1u) * nx) xb_add(&bar[XB_TOPGEN], 1u);
            else XB_SPIN(xb_ld(&bar[XB_TOPGEN]) == tg, bar);
            __builtin_amdgcn_fence(__ATOMIC_ACQUIRE, "agent");
            xb_add(&bar[XB_XGEN(b.x)], 1u);
            asm volatile("s_waitcnt vmcnt(0)" ::: "memory");
        } else {
            XB_SPIN(xb_ld(&bar[XB_XGEN(b.x)]) == gen, bar);
            __builtin_amdgcn_fence(__ATOMIC_ACQUIRE, "agent");
            asm volatile("s_waitcnt vmcnt(0)" ::: "memory");
        }
    }
    __syncthreads();
}

struct Args { const float* in[35]; float* out; unsigned char* ws; int ph_lo, ph_hi; };
struct Frame { LAS unsigned char* lds; int tid, lane, wave, G, bx, vcu, gw, NGW; };
__device__ __forceinline__ Frame make_frame(LAS unsigned char* lds) {
    Frame F; int tid = threadIdx.x; asm volatile("" : "+v"(tid)); int bx = blockIdx.x; asm volatile("" : "+s"(bx));
    F.lds = lds; F.tid = tid; F.lane = tid & 63; F.wave = __builtin_amdgcn_readfirstlane(tid >> 6); F.G = gridDim.x; F.bx = bx;
    F.vcu = (F.G % 8 == 0) ? (bx % 8) * (F.G / 8) + bx / 8 : bx; F.gw = F.vcu * 8 + F.wave; F.NGW = F.G * 8; return F;
}
#define CAS __attribute__((address_space(4)))
__device__ __forceinline__ const float* inp(int i) {
    asm volatile("" : "+s"(i));
    const CAS char* ka = (const CAS char*)__builtin_amdgcn_kernarg_segment_ptr();
    return *(const float* const CAS*)(ka + 8 * i);
}

enum { I_X = 0, I_C, I_CTX, I_CCTX, I_WMOD, I_BMOD, I_NMPRE, I_NMPOST, I_NFPRE, I_NFPOST, I_WIN, I_LAMRE, I_LAMIM, I_LOGSTEP, I_BRE, I_BIM, I_CRE, I_CIM,
       I_S5D, I_WGLU, I_CONV, I_ALOG, I_DTB, I_DNNORM, I_WBRS, I_WBRD, I_WOUT, I_ROUTER, I_MBIAS, I_MGATE, I_MUP, I_MDOWN, I_SGATE, I_SUP, I_SDOWN };

struct MoeOrder {
    int ntiles, npn, G, c; const int* tile_e;
    __device__ __forceinline__ bool next(int i, pg8::Unit& u) const {
        const long L = (long)i * G + c; if (L >= (long)ntiles * npn) return false;
        const int tile = (int)(L / npn), pl = (int)(L % npn);
        const int e = __builtin_amdgcn_readfirstlane((int)__hip_atomic_load(tile_e + tile, __ATOMIC_RELAXED, __HIP_MEMORY_SCOPE_AGENT));
        u.pm = tile; u.pn = e * npn + pl; return true;
    }
    __device__ __forceinline__ void a_ready(const pg8::Unit&) const {}
    __device__ __forceinline__ void done(const pg8::Unit&) const {}
};

struct EpiBf16Mod {
    static constexpr bool PERM = true, AFTER_DRAIN = false;
    bf16* O; int ldc; int npn;
    __device__ __forceinline__ void operator()(const pg8::f32x4 (&acc)[2][2][4][2], const pg8::Unit& u, int wr, int wc, int fr, int fq) const {
        const int row0 = u.pm * 256 + wr * 64 + fr, col0 = (u.pn % npn) * 256 + wc * 32 + 8 * fq;
#pragma unroll
        for (int ai = 0; ai < 2; ++ai)
#pragma unroll
            for (int m = 0; m < 4; ++m) { bf16* rowp = O + (size_t)(row0 + ai * 128 + m * 16) * ldc + col0;
#pragma unroll
                for (int bj = 0; bj < 2; ++bj) { const pg8::f32x4 v0 = acc[ai][bj][m][0], v1 = acc[ai][bj][m][1];
                    u32x4 w; w.x = pk2(v0[0], v0[1]); w.y = pk2(v0[2], v0[3]); w.z = pk2(v1[0], v1[1]); w.w = pk2(v1[2], v1[3]);
                    *(u32x4*)(rowp + bj * 128) = w; } }
    }
};
struct EpiGlu {
    static constexpr bool PERM = true, AFTER_DRAIN = false;
    const bf16* Gb; bf16* O;
    __device__ __forceinline__ void operator()(const pg8::f32x4 (&acc)[2][2][4][2], const pg8::Unit& u, int wr, int wc, int fr, int fq) const {
        const int row0 = u.pm * 256 + wr * 64 + fr, col0 = u.pn * 256 + wc * 32 + 8 * fq;
#pragma unroll
        for (int ai = 0; ai < 2; ++ai)
#pragma unroll
            for (int m = 0; m < 4; ++m) { const size_t ro = (size_t)(row0 + ai * 128 + m * 16) * 1024 + col0;
#pragma unroll
                for (int bj = 0; bj < 2; ++bj) { const pg8::f32x4 v0 = acc[ai][bj][m][0], v1 = acc[ai][bj][m][1];
                    const u32x4 gq = *(const u32x4*)(Gb + ro + bj * 128);
                    u32x4 w;
                    w.x = pk2(bflo(gq.x) * sigmoidf_(v0[0]), bfhi(gq.x) * sigmoidf_(v0[1]));
                    w.y = pk2(bflo(gq.y) * sigmoidf_(v0[2]), bfhi(gq.y) * sigmoidf_(v0[3]));
                    w.z = pk2(bflo(gq.z) * sigmoidf_(v1[0]), bfhi(gq.z) * sigmoidf_(v1[1]));
                    w.w = pk2(bflo(gq.w) * sigmoidf_(v1[2]), bfhi(gq.w) * sigmoidf_(v1[3]));
                    *(u32x4*)(O + ro + bj * 128) = w; } }
    }
};
template <bool SECOND> struct EpiBr {
    static constexpr bool PERM = true, AFTER_DRAIN = false;
    const bf16* P; int gcol; float* M1; bf16* Mo;
    __device__ __forceinline__ void operator()(const pg8::f32x4 (&acc)[2][2][4][2], const pg8::Unit& u, int wr, int wc, int fr, int fq) const {
        const int row0 = u.pm * 256 + wr * 64 + fr, col0 = u.pn * 256 + wc * 32 + 8 * fq;
#pragma unroll
        for (int ai = 0; ai < 2; ++ai)
#pragma unroll
            for (int m = 0; m < 4; ++m) { const size_t row = (size_t)(row0 + ai * 128 + m * 16);
#pragma unroll
                for (int bj = 0; bj < 2; ++bj) { const pg8::f32x4 v0 = acc[ai][bj][m][0], v1 = acc[ai][bj][m][1];
                    const int col = col0 + bj * 128;
                    const u32x4 gq = *(const u32x4*)(P + row * NPAD + gcol + col);
                    f32x4 r0, r1;
                    r0[0] = sigmoidf_(bflo(gq.x)) * v0[0]; r0[1] = sigmoidf_(bfhi(gq.x)) * v0[1]; r0[2] = sigmoidf_(bflo(gq.y)) * v0[2]; r0[3] = sigmoidf_(bfhi(gq.y)) * v0[3];
                    r1[0] = sigmoidf_(bflo(gq.z)) * v1[0]; r1[1] = sigmoidf_(bfhi(gq.z)) * v1[1]; r1[2] = sigmoidf_(bflo(gq.w)) * v1[2]; r1[3] = sigmoidf_(bfhi(gq.w)) * v1[3];
                    float* mp = M1 + row * DM + col;
                    if (!SECOND) { *(f32x4*)mp = r0; *(f32x4*)(mp + 4) = r1; }
                    else { const f32x4 a0 = *(const f32x4*)mp, a1 = *(const f32x4*)(mp + 4); r0 += a0; r1 += a1;
                        u32x4 w; w.x = pk2(r0[0], r0[1]); w.y = pk2(r0[2], r0[3]); w.z = pk2(r1[0], r1[1]); w.w = pk2(r1[2], r1[3]);
                        *(u32x4*)(Mo + row * DM + col) = w; } }
                asm volatile("" ::: "memory"); }
    }
};
struct EpiSwiglu {
    static constexpr bool PERM = true, AFTER_DRAIN = false;
    bf16* O;
    __device__ __forceinline__ void operator()(const pg8::f32x4 (&acc)[2][2][4][2], const pg8::Unit& u, int wr, int wc, int fr, int fq) const {
        const int row0 = u.pm * 256 + wr * 64 + fr, col0 = (u.pn & 3) * 128 + wc * 32 + 8 * fq;
#pragma unroll
        for (int ai = 0; ai < 2; ++ai)
#pragma unroll
            for (int m = 0; m < 4; ++m) { bf16* rowp = O + (size_t)(row0 + ai * 128 + m * 16) * EDIM + col0;
                const pg8::f32x4 g0 = acc[ai][0][m][0], g1 = acc[ai][0][m][1], u0 = acc[ai][1][m][0], u1 = acc[ai][1][m][1];
                u32x4 w; w.x = pk2(siluf_(g0[0]) * u0[0], siluf_(g0[1]) * u0[1]); w.y = pk2(siluf_(g0[2]) * u0[2], siluf_(g0[3]) * u0[3]);
                w.z = pk2(siluf_(g1[0]) * u1[0], siluf_(g1[1]) * u1[1]); w.w = pk2(siluf_(g1[2]) * u1[2], siluf_(g1[3]) * u1[3]);
                *(u32x4*)rowp = w; }
    }
};

__device__ __forceinline__ const float* xrow_ptr(const unsigned char* ws, int layer, int t) {
    if (layer == 0) return t < TC ? inp(I_CTX) + (size_t)t * DM : inp(I_X) + (size_t)(t - TC) * DM;
    return (const float*)(ws + WS_X) + (size_t)t * DM;
}
__device__ __forceinline__ int mods_row(int t) { return t < TC ? 4 : (t - TC) / SEQ; }
__device__ __forceinline__ void tr_item(const float* src, size_t ld, bf16* dst, int K, LAS float* scr, int lane) {
#pragma unroll 8
    for (int i = 0; i < 32; ++i) { const int kk = 2 * i + (lane >> 5); scr[kk * 33 + (lane & 31)] = src[(size_t)kk * ld + (lane & 31)]; }
    LDS_WAIT();
    const int c = lane & 7;
#pragma unroll
    for (int j = 0; j < 4; ++j) { const int n = (lane >> 3) + 8 * j; const LAS float* s = scr + (8 * c) * 33 + n;
        u32x4 o; o.x = pk2(s[0 * 33], s[1 * 33]); o.y = pk2(s[2 * 33], s[3 * 33]); o.z = pk2(s[4 * 33], s[5 * 33]); o.w = pk2(s[6 * 33], s[7 * 33]);
        *(u32x4*)(dst + (size_t)n * K + 8 * c) = o; }
    LDS_WAIT();
}

__device__ __forceinline__ void ph_pre(const Args& A, const Frame& F, int layer) {
    unsigned char* ws = A.ws; asm volatile("" : "+s"(ws));
    if (layer == 0) {
        LAS float* sil = (LAS float*)F.lds;
        for (int i = F.tid; i < 5 * DM; i += 512) { const int r = i / DM, k = i % DM; const float c = (r < 4) ? inp(I_C)[r * DM + k] : inp(I_CCTX)[k]; sil[i] = c / (1.f + expf(-c)); }
        __syncthreads();
        float* mods = (float*)(ws + WS_MODS);
        LAS float* part = (LAS float*)(F.lds + 5 * DM * 4);
        for (int it = F.vcu; it < NLAYER * 96; it += F.G) {
            const int l = it / 96, nb = it % 96;
            const float* W = inp(I_WMOD) + (size_t)l * DM * MODW + (size_t)(F.wave * 256) * MODW + nb * 128 + F.lane * 2;
            f32x2 acc[5];
#pragma unroll
            for (int r = 0; r < 5; ++r) acc[r] = (f32x2){0.f, 0.f};
#pragma unroll 8
            for (int k = 0; k < 256; ++k) { const f32x2 w = *(const f32x2*)(W + (size_t)k * MODW);
#pragma unroll
                for (int r = 0; r < 5; ++r) acc[r] += sil[r * DM + F.wave * 256 + k] * w; }
#pragma unroll
            for (int r = 0; r < 5; ++r) *(LAS f32x2*)(part + (F.wave * 5 + r) * 128 + F.lane * 2) = acc[r];
            __syncthreads();
            for (int o = F.tid; o < 5 * 128; o += 512) { const int r = o / 128, c = o % 128; float sum = inp(I_BMOD)[(size_t)l * MODW + nb * 128 + c];
#pragma unroll
                for (int w8 = 0; w8 < 8; ++w8) sum += part[(w8 * 5 + r) * 128 + c];
                mods[((size_t)l * 5 + r) * MODW + nb * 128 + c] = sum; }
            __syncthreads();
        }
        __syncthreads();
    }
    LAS float* scr = (LAS float*)(F.lds + F.wave * 16384);
    bf16* Wb = (bf16*)(ws + WS_W);
    constexpr int S_IN = 296 * 32, S_GLU = 512, S_BR = 1024, S_OUT = 2048, S_GU = NEX * 1024, S_DN = NEX * 512;
    constexpr int NITEMS = S_IN + S_GLU + 2 * S_BR + S_OUT + S_GU + S_DN;
    for (int it = F.gw; it < NITEMS; it += F.NGW) {
        int r = it;
        if (r < S_IN) {
            const int kb = r / 296, nb = r % 296, n0 = nb * 32, k0 = kb * 64;
            bf16* dst = Wb + WO_IN / 2 + (size_t)n0 * DM + k0;
            if (n0 >= 9248) { const int c = F.lane & 7;
#pragma unroll
                for (int j = 0; j < 4; ++j) { const int n = (F.lane >> 3) + 8 * j; *(u32x4*)(dst + (size_t)n * DM + 8 * c) = (u32x4){0u, 0u, 0u, 0u}; } }
            else { const int no = n0 < 5120 ? n0 : (n0 < 9216 ? n0 + 32 : n0 - 9216 + 5120);
                tr_item(inp(I_WIN) + (size_t)layer * DM * 9248 + (size_t)k0 * 9248 + no, 9248, dst, DM, scr, F.lane); }
            continue; }
        r -= S_IN;
        if (r < S_GLU) { const int kb = r / 32, nb = r % 32;
            tr_item(inp(I_WGLU) + (size_t)layer * 1024 * 1024 + (size_t)(kb * 64) * 1024 + nb * 32, 1024, Wb + WO_GLU / 2 + (size_t)(nb * 32) * 1024 + kb * 64, 1024, scr, F.lane); continue; }
        r -= S_GLU;
        if (r < 2 * S_BR) { const int which = r / S_BR, rr = r % S_BR, kb = rr / 64, nb = rr % 64;
            const float* src = inp(which ? I_WBRD : I_WBRS) + (size_t)layer * 1024 * DM + (size_t)(kb * 64) * DM + nb * 32;
            tr_item(src, DM, Wb + (which ? WO_BRD : WO_BRS) / 2 + (size_t)(nb * 32) * 1024 + kb * 64, 1024, scr, F.lane); continue; }
        r -= 2 * S_BR;
        if (r < S_OUT) { const int kb = r / 64, nb = r % 64;
            tr_item(inp(I_WOUT) + (size_t)layer * DM * DM + (size_t)(kb * 64) * DM + nb * 32, DM, Wb + WO_OUT / 2 + (size_t)(nb * 32) * DM + kb * 64, DM, scr, F.lane); continue; }
        r -= S_OUT;
        if (r < S_GU) { const int e = r / 1024, rr = r % 1024, kb = rr / 32, nb = rr % 32, nd0 = nb * 32;
            const int pn = nd0 / 256, half = (nd0 % 256) / 128, j0 = pn * 128 + (nd0 % 128);
            const float* base = (e < NE) ? (inp(half ? I_MUP : I_MGATE) + ((size_t)layer * NE + e) * DM * EDIM) : (inp(half ? I_SUP : I_SGATE) + (size_t)layer * DM * EDIM);
            tr_item(base + (size_t)(kb * 64) * EDIM + j0, EDIM, Wb + WO_GU / 2 + ((size_t)e * 1024 + nd0) * DM + kb * 64, DM, scr, F.lane); continue; }
        r -= S_GU;
        { const int e = r / 512, rr = r % 512, kb = rr / 64, nb = rr % 64;
            const float* base = (e < NE) ? (inp(I_MDOWN) + ((size_t)layer * NE + e) * EDIM * DM) : (inp(I_SDOWN) + (size_t)layer * EDIM * DM);
            tr_item(base + (size_t)(kb * 64) * DM + nb * 32, DM, Wb + WO_DN / 2 + ((size_t)e * DM + nb * 32) * EDIM + kb * 64, EDIM, scr, F.lane); }
    }
}

__device__ __forceinline__ void ph_n1(const Args& A, const Frame& F, int layer) {
    unsigned char* ws = A.ws; asm volatile("" : "+s"(ws));
    const float* mods = (const float*)(ws + WS_MODS) + (size_t)layer * 5 * MODW;
    const float* nw = inp(I_NMPRE) + (size_t)layer * DM;
    bf16* ab = (bf16*)(ws + WS_AB);
    for (int t = F.gw; t < TT; t += F.NGW) {
        const f32x4* xr = (const f32x4*)xrow_ptr(ws, layer, t) + F.lane;
        f32x4 v[8]; float ss = 0.f;
#pragma unroll
        for (int j = 0; j < 8; ++j) { v[j] = xr[64 * j]; ss += (v[j].x * v[j].x + v[j].y * v[j].y) + (v[j].z * v[j].z + v[j].w * v[j].w); }
        const float r = rsqrtf(wave_sum(ss) * (1.f / DM) + EPS);
        const float* mr = mods + (size_t)mods_row(t) * MODW;
        u32x2* o = (u32x2*)(ab + (size_t)t * DM) + F.lane;
#pragma unroll
        for (int j = 0; j < 8; ++j) { const int col = 4 * (F.lane + 64 * j);
            const f32x4 w = *(const f32x4*)(nw + col), sh = *(const f32x4*)(mr + col), sc = *(const f32x4*)(mr + DM + col);
            const f32x4 y = (v[j] * r * w) * (1.f + sc) + sh;
            u32x2 q; q.x = pk2(y.x, y.y); q.y = pk2(y.z, y.w); o[64 * j] = q; }
    }
}

__device__ __forceinline__ void ph_prep(const Args& A, const Frame& F, int layer) {
    unsigned char* ws = A.ws; asm volatile("" : "+s"(ws));
    const bf16* P = (const bf16*)(ws + WS_B + WB_P);
    float* qkv = (float*)(ws + WS_B + WB_QKV);
    float* bg = (float*)(ws + WS_B + WB_BG);
    const float* cw = inp(I_CONV) + (size_t)layer * 3 * 3072;
    for (int it = F.gw; it < TT * 8; it += F.NGW) {
        const int t = it >> 3, h = it & 7;
        bool hp, hn;
        if (t < TC) { const int i = t & 255; hp = i > 0; hn = i < 255; } else { const int l = (t - TC) & 2047; hp = l > 0; hn = l < 2047; }
        float val[3][2];
#pragma unroll
        for (int part = 0; part < 3; ++part) {
            const int ch = part * 1024 + h * 128 + 2 * F.lane;
            const bf16* pc = P + (size_t)t * NPAD + PC_QKV + ch;
            const unsigned x0 = *(const unsigned*)pc;
            const unsigned xm = hp ? *(const unsigned*)(pc - NPAD) : 0u;
            const unsigned xp = hn ? *(const unsigned*)(pc + NPAD) : 0u;
            const f32x2 w0 = *(const f32x2*)(cw + ch), w1 = *(const f32x2*)(cw + 3072 + ch), w2 = *(const f32x2*)(cw + 2 * 3072 + ch);
            val[part][0] = siluf_(w0.x * bflo(xm) + w1.x * bflo(x0) + w2.x * bflo(xp));
            val[part][1] = siluf_(w0.y * bfhi(xm) + w1.y * bfhi(x0) + w2.y * bfhi(xp));
        }
        const float qs = rsqrtf(wave_sum(val[0][0] * val[0][0] + val[0][1] * val[0][1]) + EPS) * 0.08838834764831845f;
        const float ks = rsqrtf(wave_sum(val[1][0] * val[1][0] + val[1][1] * val[1][1]) + EPS);
        float* o = qkv + (size_t)t * 3072 + h * 128 + 2 * F.lane;
        *(f32x2*)o = (f32x2){val[0][0] * qs, val[0][1] * qs};
        *(f32x2*)(o + 1024) = (f32x2){val[1][0] * ks, val[1][1] * ks};
        *(f32x2*)(o + 2048) = (f32x2){val[2][0], val[2][1]};
        if (h == 0 && F.lane < 32) {
            const int idx = F.lane, kind = idx >> 4, dh = idx & 15;
            const float raw = bf2f(P[(size_t)t * NPAD + PC_BA + idx]);
            float o2;
            if (kind == 0) o2 = 1.f / (1.f + expf(-raw));
            else { const float xx = raw + inp(I_DTB)[layer * 16 + dh]; const float sp = xx > 20.f ? xx : log1pf(expf(xx)); o2 = -expf(inp(I_ALOG)[layer * 16 + dh]) * sp; }
            bg[(size_t)t * 32 + idx] = o2;
        }
    }
}

__device__ __forceinline__ int s5_tok(int b, int dir, int s) {
    if (s < CTXL) return b * CTXL + (dir ? (CTXL - 1 - s) : s);
    const int m = s - CTXL, cm = dir ? (SEQ - 1 - m) : m, col = cm >> 5, row = cm & 31;
    return TC + b * SEQ + row * 64 + col;
}
__device__ __forceinline__ int dn_tok(int b, int dir, int s) {
    if (s < CTXL) return b * CTXL + (dir ? (CTXL - 1 - s) : s);
    const int m = s - CTXL; return TC + b * SEQ + (dir ? (SEQ - 1 - m) : m);
}
__device__ __forceinline__ void ph_scan(const Args& A, const Frame& F, int layer) {
    unsigned char* ws = A.ws; asm volatile("" : "+s"(ws));
    const bf16* P = (const bf16*)(ws + WS_B + WB_P);
#ifndef NO_S5
    if (F.gw < 512) {
        const int dir = F.gw & 1, g = (F.gw >> 1) & 63, b = F.gw >> 7, p = F.lane;
        const size_t pg = (size_t)(layer * 2 + dir) * 64 + g;
        const float lr = inp(I_LAMRE)[pg * 64 + p], li = inp(I_LAMIM)[pg * 64 + p], step = expf(inp(I_LOGSTEP)[pg]);
        const float mag = expf(lr * step), abr = mag * cosf(li * step), abi = mag * sinf(li * step);
        const float den = lr * lr + li * li, nr = abr - 1.f, cr = (nr * lr + abi * li) / den, ci = (abi * lr - nr * li) / den;
        float bbr[16], bbi[16], cre[16], cim[16];
#pragma unroll
        for (int j = 0; j < 16; ++j) { const float br = inp(I_BRE)[(pg * 64 + p) * 16 + j], bi = inp(I_BIM)[(pg * 64 + p) * 16 + j];
            bbr[j] = cr * br - ci * bi; bbi[j] = cr * bi + ci * br;
            cre[j] = inp(I_CRE)[(pg * 16 + j) * 64 + p]; cim[j] = inp(I_CIM)[(pg * 16 + j) * 64 + p]; }
        float* yb = (float*)(ws + WS_B + WB_Y) + (size_t)dir * TT * 1024;
        LAS u32x4* ust = (LAS u32x4*)(F.lds + F.wave * 2048);
        float hr = 0.f, hi = 0.f;
        u32x4 nx = *(const u32x4*)(P + (size_t)s5_tok(b, dir, F.lane >> 1) * NPAD + g * 16 + (F.lane & 1) * 8);
        for (int blk = 0; blk < 72; ++blk) {
            const int buf = blk & 1;
            ust[buf * 64 + F.lane] = nx;
            if (blk + 1 < 72) nx = *(const u32x4*)(P + (size_t)s5_tok(b, dir, (blk + 1) * 32 + (F.lane >> 1)) * NPAD + g * 16 + (F.lane & 1) * 8);
            LDS_WAIT();
            for (int ss = 0; ss < 32; ++ss) {
                const u32x4 ua = ust[buf * 64 + ss * 2], ub = ust[buf * 64 + ss * 2 + 1];
                float u[16];
                u[0] = bflo(ua.x); u[1] = bfhi(ua.x); u[2] = bflo(ua.y); u[3] = bfhi(ua.y); u[4] = bflo(ua.z); u[5] = bfhi(ua.z); u[6] = bflo(ua.w); u[7] = bfhi(ua.w);
                u[8] = bflo(ub.x); u[9] = bfhi(ub.x); u[10] = bflo(ub.y); u[11] = bfhi(ub.y); u[12] = bflo(ub.z); u[13] = bfhi(ub.z); u[14] = bflo(ub.w); u[15] = bfhi(ub.w);
                float bur = 0.f, bui = 0.f;
#pragma unroll
                for (int j = 0; j < 16; ++j) { bur += bbr[j] * u[j]; bui += bbi[j] * u[j]; }
                const float nhr = abr * hr - abi * hi + bur, nhi = abr * hi + abi * hr + bui;
                hr = nhr; hi = nhi;
                float z[16];
#pragma unroll
                for (int j = 0; j < 16; ++j) z[j] = cre[j] * hr - cim[j] * hi;
                const bool b5 = F.lane & 32, b4 = F.lane & 16, b3 = F.lane & 8, b2 = F.lane & 4;
                float a8[8], a4[4], a2[2];
#pragma unroll
                for (int j = 0; j < 8; ++j) { const float keep = b5 ? z[j + 8] : z[j], send = b5 ? z[j] : z[j + 8]; a8[j] = keep + __shfl_xor(send, 32); }
#pragma unroll
                for (int j = 0; j < 4; ++j) { const float keep = b4 ? a8[j + 4] : a8[j], send = b4 ? a8[j] : a8[j + 4]; a4[j] = keep + __shfl_xor(send, 16); }
#pragma unroll
                for (int j = 0; j < 2; ++j) { const float keep = b3 ? a4[j + 2] : a4[j], send = b3 ? a4[j] : a4[j + 2]; a2[j] = keep + __shfl_xor(send, 8); }
                float a1 = (b2 ? a2[1] : a2[0]) + __shfl_xor(b2 ? a2[0] : a2[1], 4);
                a1 += __shfl_xor(a1, 2); a1 += __shfl_xor(a1, 1);
                if ((F.lane & 3) == 0) yb[(size_t)s5_tok(b, dir, blk * 32 + ss) * 1024 + g * 16 + (F.lane >> 2)] = a1;
            }
        }
    }
#endif
#ifndef NO_DN
    if (F.gw >= 512 && F.gw < 512 + 256) {
        const int idx = F.gw - 512, seq = idx >> 2, wq = idx & 3, dir = seq & 1, h = (seq >> 1) & 7, b = seq >> 4, vc = wq * 32 + (F.lane >> 1), kh = F.lane & 1;
        const float* qkv = (const float*)(ws + WS_B + WB_QKV);
        const float* bg = (const float*)(ws + WS_B + WB_BG);
        float* ob = (float*)(ws + WS_B + WB_O) + (size_t)dir * TT * 1024;
        LAS f32x4* st = (LAS f32x4*)(F.lds + F.wave * 16384);
        float S[64];
#pragma unroll
        for (int i = 0; i < 64; ++i) S[i] = 0.f;
        const int kqoff = (F.lane < 32) ? (1024 + h * 128 + 4 * F.lane) : (h * 128 + 4 * (F.lane - 32));
        const int vboff = 2048 + h * 128 + vc, bgo = dir * 8 + h;
        f32x4 nkq0, nkq1; float nv0, nv1, nb0, nb1, ng0, ng1;
        { const int t0 = dn_tok(b, dir, 0), t1 = dn_tok(b, dir, 1);
          nkq0 = *(const f32x4*)(qkv + (size_t)t0 * 3072 + kqoff); nv0 = qkv[(size_t)t0 * 3072 + vboff]; nb0 = bg[(size_t)t0 * 32 + bgo]; ng0 = bg[(size_t)t0 * 32 + 16 + bgo];
          nkq1 = *(const f32x4*)(qkv + (size_t)t1 * 3072 + kqoff); nv1 = qkv[(size_t)t1 * 3072 + vboff]; nb1 = bg[(size_t)t1 * 32 + bgo]; ng1 = bg[(size_t)t1 * 32 + 16 + bgo]; }
        for (int pp = 0; pp < 1152; ++pp) {
            const int buf = pp & 1;
            st[(buf * 2 + 0) * 64 + F.lane] = nkq0; st[(buf * 2 + 1) * 64 + F.lane] = nkq1;
            const float cv0 = nv0, cv1 = nv1, cb0 = nb0, cb1 = nb1, cg0 = ng0, cg1 = ng1;
            if (pp + 1 < 1152) { const int t0 = dn_tok(b, dir, 2 * pp + 2), t1 = dn_tok(b, dir, 2 * pp + 3);
                nkq0 = *(const f32x4*)(qkv + (size_t)t0 * 3072 + kqoff); nv0 = qkv[(size_t)t0 * 3072 + vboff]; nb0 = bg[(size_t)t0 * 32 + bgo]; ng0 = bg[(size_t)t0 * 32 + 16 + bgo];
                nkq1 = *(const f32x4*)(qkv + (size_t)t1 * 3072 + kqoff); nv1 = qkv[(size_t)t1 * 3072 + vboff]; nb1 = bg[(size_t)t1 * 32 + bgo]; ng1 = bg[(size_t)t1 * 32 + 16 + bgo]; }
            LDS_WAIT();
#pragma unroll
            for (int j = 0; j < 2; ++j) {
                const LAS f32x4* kk = st + (buf * 2 + j) * 64 + kh * 16;
                const float alpha = expf(j ? cg1 : cg0), beta = j ? cb1 : cb0, vv = j ? cv1 : cv0;
                float ks = 0.f;
#pragma unroll
                for (int i = 0; i < 16; ++i) { const f32x4 k4 = kk[i]; ks += k4.x * S[4 * i] + k4.y * S[4 * i + 1] + k4.z * S[4 * i + 2] + k4.w * S[4 * i + 3]; }
                ks += __shfl_xor(ks, 1);
                const float vn = beta * (vv - alpha * ks);
                float o = 0.f;
#pragma unroll
                for (int i = 0; i < 16; ++i) { const f32x4 k4 = kk[i], q4 = kk[32 + i];
                    S[4 * i] = alpha * S[4 * i] + k4.x * vn; S[4 * i + 1] = alpha * S[4 * i + 1] + k4.y * vn; S[4 * i + 2] = alpha * S[4 * i + 2] + k4.z * vn; S[4 * i + 3] = alpha * S[4 * i + 3] + k4.w * vn;
                    o += q4.x * S[4 * i] + q4.y * S[4 * i + 1] + q4.z * S[4 * i + 2] + q4.w * S[4 * i + 3]; }
                o += __shfl_xor(o, 1);
                if (kh == 0) ob[(size_t)dn_tok(b, dir, 2 * pp + j) * 1024 + h * 128 + vc] = o;
                asm volatile("" ::: "memory");
            }
        }
    }
#endif
}

__device__ __forceinline__ void ph_post(const Args& A, const Frame& F, int layer) {
    unsigned char* ws = A.ws; asm volatile("" : "+s"(ws));
    const bf16* P = (const bf16*)(ws + WS_B + WB_P);
    const float* yb = (const float*)(ws + WS_B + WB_Y);
    const float* ob = (const float*)(ws + WS_B + WB_O);
    bf16* gb = (bf16*)(ws + WS_B + WB_G);
    bf16* dno = (bf16*)(ws + WS_B + WB_DNO);
    const int c0 = 16 * F.lane;
    for (int t = F.gw; t < TT; t += F.NGW) {
        {
            const u32x4 ua = *(const u32x4*)(P + (size_t)t * NPAD + PC_U + c0), ub = *(const u32x4*)(P + (size_t)t * NPAD + PC_U + c0 + 8);
            float u[16];
            u[0] = bflo(ua.x); u[1] = bfhi(ua.x); u[2] = bflo(ua.y); u[3] = bfhi(ua.y); u[4] = bflo(ua.z); u[5] = bfhi(ua.z); u[6] = bflo(ua.w); u[7] = bfhi(ua.w);
            u[8] = bflo(ub.x); u[9] = bfhi(ub.x); u[10] = bflo(ub.y); u[11] = bfhi(ub.y); u[12] = bflo(ub.z); u[13] = bfhi(ub.z); u[14] = bflo(ub.w); u[15] = bfhi(ub.w);
            float gg[16];
#pragma unroll
            for (int q = 0; q < 4; ++q) { const f32x4 y0 = *(const f32x4*)(yb + (size_t)t * 1024 + c0 + 4 * q), y1 = *(const f32x4*)(yb + (size_t)(TT + t) * 1024 + c0 + 4 * q);
                const f32x4 d = *(const f32x4*)(inp(I_S5D) + (size_t)layer * 1024 + c0 + 4 * q);
#pragma unroll
                for (int j = 0; j < 4; ++j) gg[4 * q + j] = gelu_tanh(d[j] * u[4 * q + j] + y0[j] + y1[j]); }
            u32x4 w0, w1;
            w0.x = pk2(gg[0], gg[1]); w0.y = pk2(gg[2], gg[3]); w0.z = pk2(gg[4], gg[5]); w0.w = pk2(gg[6], gg[7]);
            w1.x = pk2(gg[8], gg[9]); w1.y = pk2(gg[10], gg[11]); w1.z = pk2(gg[12], gg[13]); w1.w = pk2(gg[14], gg[15]);
            *(u32x4*)(gb + (size_t)t * 1024 + c0) = w0; *(u32x4*)(gb + (size_t)t * 1024 + c0 + 8) = w1;
        }
        {
            float o[16]; float ss = 0.f;
#pragma unroll
            for (int q = 0; q < 4; ++q) { const f32x4 a = *(const f32x4*)(ob + (size_t)t * 1024 + c0 + 4 * q), bq = *(const f32x4*)(ob + (size_t)(TT + t) * 1024 + c0 + 4 * q);
#pragma unroll
                for (int j = 0; j < 4; ++j) { o[4 * q + j] = a[j] + bq[j]; ss += o[4 * q + j] * o[4 * q + j]; } }
            ss += __shfl_xor(ss, 1); ss += __shfl_xor(ss, 2); ss += __shfl_xor(ss, 4);
            const float r = rsqrtf(ss * (1.f / 128.f) + EPS);
            const u32x4 za = *(const u32x4*)(P + (size_t)t * NPAD + PC_Z + c0), zb = *(const u32x4*)(P + (size_t)t * NPAD + PC_Z + c0 + 8);
            float z[16];
            z[0] = bflo(za.x); z[1] = bfhi(za.x); z[2] = bflo(za.y); z[3] = bfhi(za.y); z[4] = bflo(za.z); z[5] = bfhi(za.z); z[6] = bflo(za.w); z[7] = bfhi(za.w);
            z[8] = bflo(zb.x); z[9] = bfhi(zb.x); z[10] = bflo(zb.y); z[11] = bfhi(zb.y); z[12] = bflo(zb.z); z[13] = bfhi(zb.z); z[14] = bflo(zb.w); z[15] = bfhi(zb.w);
            const float* nw = inp(I_DNNORM) + (size_t)layer * 128 + (c0 & 127);
            float e[16];
#pragma unroll
            for (int j = 0; j < 16; ++j) e[j] = o[j] * r * nw[j] * siluf_(z[j]);
            u32x4 w0, w1;
            w0.x = pk2(e[0], e[1]); w0.y = pk2(e[2], e[3]); w0.z = pk2(e[4], e[5]); w0.w = pk2(e[6], e[7]);
            w1.x = pk2(e[8], e[9]); w1.y = pk2(e[10], e[11]); w1.z = pk2(e[12], e[13]); w1.w = pk2(e[14], e[15]);
            *(u32x4*)(dno + (size_t)t * 1024 + c0) = w0; *(u32x4*)(dno + (size_t)t * 1024 + c0 + 8) = w1;
        }
    }
}

__device__ __forceinline__ void ph_row2(const Args& A, const Frame& F, int layer) {
    unsigned char* ws = A.ws; asm volatile("" : "+s"(ws));
    const float* mods = (const float*)(ws + WS_MODS) + (size_t)layer * 5 * MODW;
    const float* mix = (const float*)(ws + WS_B + WB_MIX);
    float* xc = (float*)(ws + WS_X);
    bf16* hb = (bf16*)(ws + WS_AB);
    const float* nwp = inp(I_NMPOST) + (size_t)layer * DM;
    const float* nwf = inp(I_NFPRE) + (size_t)layer * DM;
    const float* wr = inp(I_ROUTER) + (size_t)layer * DM * NE;
    int* eidx = (int*)(ws + WS_EIDX); float* wts = (float*)(ws + WS_WTS);
    unsigned* cnt = (unsigned*)(ws + WS_CTL) + CW_CNT + layer * 128;
    LAS float* hrow = (LAS float*)(F.lds + F.wave * 8192);
    const float ebias = inp(I_MBIAS)[layer * NE + F.lane];
    for (int t = F.gw; t < TT; t += F.NGW) {
        const f32x4* mr4 = (const f32x4*)(mix + (size_t)t * DM) + F.lane;
        const f32x4* xr4 = (const f32x4*)xrow_ptr(ws, layer, t) + F.lane;
        const float* mrow = mods + (size_t)mods_row(t) * MODW;
        f32x4 v[8]; float ss = 0.f;
#pragma unroll
        for (int j = 0; j < 8; ++j) { v[j] = mr4[64 * j]; ss += (v[j].x * v[j].x + v[j].y * v[j].y) + (v[j].z * v[j].z + v[j].w * v[j].w); }
        const float r = rsqrtf(wave_sum(ss) * (1.f / DM) + EPS);
        float ss2 = 0.f;
#pragma unroll
        for (int j = 0; j < 8; ++j) { const int col = 4 * (F.lane + 64 * j);
            const f32x4 w = *(const f32x4*)(nwp + col), gt = *(const f32x4*)(mrow + 2 * DM + col), xo = xr4[64 * j];
            v[j] = xo + gt * (v[j] * r * w);
            *((f32x4*)(xc + (size_t)t * DM) + F.lane + 64 * j) = v[j];
            ss2 += (v[j].x * v[j].x + v[j].y * v[j].y) + (v[j].z * v[j].z + v[j].w * v[j].w); }
        const float r2 = rsqrtf(wave_sum(ss2) * (1.f / DM) + EPS);
        u32x2* ho = (u32x2*)(hb + (size_t)t * DM) + F.lane;
#pragma unroll
        for (int j = 0; j < 8; ++j) { const int col = 4 * (F.lane + 64 * j);
            const f32x4 w = *(const f32x4*)(nwf + col), sh = *(const f32x4*)(mrow + 3 * DM + col), sc = *(const f32x4*)(mrow + 4 * DM + col);
            const f32x4 y = (v[j] * r2 * w) * (1.f + sc) + sh;
            u32x2 q; q.x = pk2(y.x, y.y); q.y = pk2(y.z, y.w); ho[64 * j] = q;
            *((LAS f32x4*)hrow + F.lane + 64 * j) = y; }
        LDS_WAIT();
        float logit = 0.f;
#pragma unroll 4
        for (int d4 = 0; d4 < DM / 4; ++d4) { const f32x4 h4 = *((const LAS f32x4*)hrow + d4);
            const float* wp = wr + (size_t)(4 * d4) * NE + F.lane;
            logit += h4.x * wp[0]; logit += h4.y * wp[NE]; logit += h4.z * wp[2 * NE]; logit += h4.w * wp[3 * NE]; }
        const float score = 1.f / (1.f + expf(-logit));
        const float sel = score + ebias;
        float m1 = sel;
        m1 = fmaxf(m1, __shfl_xor(m1, 1)); m1 = fmaxf(m1, __shfl_xor(m1, 2)); m1 = fmaxf(m1, __shfl_xor(m1, 4));
        const unsigned long long eqm = __ballot(sel == m1);
        const int gbase = F.lane & ~7;
        const unsigned gm = (unsigned)((eqm >> gbase) & 0xffull);
        const int amax = gbase + __builtin_ctz(gm);
        float s2 = (F.lane == amax) ? -__builtin_inff() : sel;
        s2 = fmaxf(s2, __shfl_xor(s2, 1)); s2 = fmaxf(s2, __shfl_xor(s2, 2)); s2 = fmaxf(s2, __shfl_xor(s2, 4));
        const float gs = m1 + s2;
        int grank = 0; const int myg = F.lane >> 3;
#pragma unroll
        for (int g2 = 0; g2 < 8; ++g2) { const float og = __shfl(gs, g2 * 8); grank += (og > gs || (og == gs && g2 < myg)) ? 1 : 0; }
        const float selm = (grank < 4) ? sel : -__builtin_inff();
        int rank = 0;
#pragma unroll 8
        for (int e2 = 0; e2 < 64; ++e2) { const float os = __shfl(selm, e2); rank += (os > selm || (os == selm && e2 < F.lane)) ? 1 : 0; }
        const bool chosen = (grank < 4) && (rank < 8);
        const float wsum = wave_sum(chosen ? score : 0.f);
        if (chosen) { eidx[(size_t)t * 8 + rank] = F.lane; wts[(size_t)t * 8 + rank] = score / wsum * 2.5f; atomicAdd(cnt + F.lane, 1u); }
        LDS_WAIT();
    }
}

__device__ __forceinline__ void ph_fill(const Args& A, const Frame& F, int layer) {
    unsigned char* ws = A.ws; asm volatile("" : "+s"(ws));
    unsigned* ctl = (unsigned*)(ws + WS_CTL);
    LAS int* off = (LAS int*)(F.lds);
    LAS int* cn = (LAS int*)(F.lds + 1024);
    if (F.tid < NEX) cn[F.tid] = (F.tid < NE) ? (int)__hip_atomic_load(ctl + CW_CNT + layer * 128 + F.tid, __ATOMIC_RELAXED, __HIP_MEMORY_SCOPE_AGENT) : TT;
    __syncthreads();
    if (F.tid == 0) {
        int o = 0;
        for (int e = 0; e < NEX; ++e) { off[e] = o; o += (cn[e] + 255) & ~255; }
        off[NEX] = o;
    }
    __syncthreads();
    int* misc = (int*)(ws + WS_MISC) + layer * 1024;
    if (blockIdx.x == 0) {
        const int ntiles = off[NEX] >> 8;
        for (int tl = F.tid; tl < ntiles; tl += 512) { int e = 0; for (int q = 0; q < NEX; ++q) if ((off[q] >> 8) <= tl) e = q; misc[tl] = e; }
        if (F.tid == 0) misc[512] = ntiles;
    }
    {
        bf16* hpz = (bf16*)(ws + WS_B + WB_HPERM);
        for (int e = 0; e < NE; ++e) { const int r0 = off[e] + cn[e], r1 = off[e + 1];
            for (int r = r0 + F.gw; r < r1; r += F.NGW) { u32x4* d = (u32x4*)(hpz + (size_t)r * DM) + F.lane;
#pragma unroll
                for (int j = 0; j < 4; ++j) d[64 * j] = (u32x4){0u, 0u, 0u, 0u}; } }
    }
    const int* eidx = (const int*)(ws + WS_EIDX);
    int* slot_of = (int*)(ws + WS_SLOT);
    const bf16* hb = (const bf16*)(ws + WS_AB);
    bf16* hp = (bf16*)(ws + WS_B + WB_HPERM);
    for (int it = F.gw; it < TT * 9; it += F.NGW) {
        const int t = it / 9, k = it % 9;
        int slot;
        if (k < 8) { const int e = eidx[(size_t)t * 8 + k]; int pos = 0;
            if (F.lane == 0) pos = (int)atomicAdd(ctl + CW_FILL + layer * 128 + e, 1u);
            pos = __builtin_amdgcn_readfirstlane(pos); slot = off[e] + pos; }
        else slot = off[NE] + t;
        if (F.lane == 0) slot_of[(size_t)t * 9 + k] = slot;
        const u32x4* s = (const u32x4*)(hb + (size_t)t * DM) + F.lane; u32x4* d = (u32x4*)(hp + (size_t)slot * DM) + F.lane;
#pragma unroll
        for (int j = 0; j < 4; ++j) d[64 * j] = s[64 * j];
    }
}

__device__ __forceinline__ void ph_comb(const Args& A, const Frame& F, int layer) {
    unsigned char* ws = A.ws; asm volatile("" : "+s"(ws));
    const float* mods = (const float*)(ws + WS_MODS) + (size_t)layer * 5 * MODW;
    const bf16* ys = (const bf16*)(ws + WS_B + WB_HPERM);
    const int* slot_of = (const int*)(ws + WS_SLOT);
    const float* wts = (const float*)(ws + WS_WTS);
    float* xc = (float*)(ws + WS_X);
    const float* nw = inp(I_NFPOST) + (size_t)layer * DM;
    const bool last = (layer == NLAYER - 1);
    for (int t = F.gw; t < TT; t += F.NGW) {
        float f[32];
#pragma unroll
        for (int j = 0; j < 32; ++j) f[j] = 0.f;
#pragma unroll
        for (int k = 0; k < 9; ++k) {
            const int slot = slot_of[(size_t)t * 9 + k]; const float w = (k < 8) ? wts[(size_t)t * 8 + k] : 1.f;
            const u32x4* yr = (const u32x4*)(ys + (size_t)slot * DM + 32 * F.lane);
#pragma unroll
            for (int q = 0; q < 4; ++q) { const u32x4 y = yr[q];
                f[8 * q + 0] += w * bflo(y.x); f[8 * q + 1] += w * bfhi(y.x); f[8 * q + 2] += w * bflo(y.y); f[8 * q + 3] += w * bfhi(y.y);
                f[8 * q + 4] += w * bflo(y.z); f[8 * q + 5] += w * bfhi(y.z); f[8 * q + 6] += w * bflo(y.w); f[8 * q + 7] += w * bfhi(y.w); }
            if (k % 3 == 2) asm volatile("" ::: "memory");
        }
        float ss = 0.f;
#pragma unroll
        for (int j = 0; j < 32; ++j) ss += f[j] * f[j];
        const float r = rsqrtf(wave_sum(ss) * (1.f / DM) + EPS);
        const float* mrow = mods + (size_t)mods_row(t) * MODW + 5 * DM;
        const int c0 = 32 * F.lane;
        float* xr = xc + (size_t)t * DM + c0;
#pragma unroll
        for (int q = 0; q < 8; ++q) { const f32x4 w = *(const f32x4*)(nw + c0 + 4 * q), gt = *(const f32x4*)(mrow + c0 + 4 * q), xo = *(const f32x4*)(xr + 4 * q);
            f32x4 y; y.x = xo.x + gt.x * (f[4 * q] * r * w.x); y.y = xo.y + gt.y * (f[4 * q + 1] * r * w.y); y.z = xo.z + gt.z * (f[4 * q + 2] * r * w.z); y.w = xo.w + gt.w * (f[4 * q + 3] * r * w.w);
            if (!last) *(f32x4*)(xr + 4 * q) = y;
            else if (t >= TC) *(f32x4*)(A.out + (size_t)(t - TC) * DM + c0 + 4 * q) = y; }
    }
}

constexpr int NPH = 14;
constexpr int PER_PHASE_LAUNCH = MK_PER_PHASE;
#ifndef DBG_STOP
#define DBG_STOP 0
#endif

__global__ void __launch_bounds__(512, 2) hybrid_fwd(Args args) {
    extern __shared__ __attribute__((aligned(16))) unsigned char lds_raw[];
    LAS unsigned char* const lds = (LAS unsigned char*)lds_raw;
    volatile LAS unsigned* MISC = (volatile LAS unsigned*)(lds + LDS_MISC);
    if (threadIdx.x < 4) MISC[threadIdx.x] = 0u;
    __syncthreads();
    unsigned* ctl = (unsigned*)(args.ws + WS_CTL);
    XcdBarrier bar; bar.bar = ctl + CW_BAR; bar.x = 0; bar.st = nullptr;
    if (!PER_PHASE_LAUNCH) bar = xcd_barrier_post(ctl + CW_BAR, MISC);
    const int lo = args.ph_lo, hi = args.ph_hi;
#ifndef PHMASK
#define PHMASK 0xFFFF
#endif
#define IN(k) (((PHMASK >> ((k) % NPH)) & 1) && lo <= (k) && (k) < hi)
#define GETWS const Frame F = make_frame(lds); unsigned char* ws = args.ws; asm volatile("" : "+s"(ws)); bf16* Wb = (bf16*)(ws + WS_W)
#define SEAM(k) do { if (IN(k) && IN((k) + 1)) xcd_barrier(bar); } while (0)
#pragma unroll
    for (int layer = 0; layer < NLAYER; ++layer) {
        const int pb = layer * NPH;
        if (IN(pb + 0)) { const Frame F = make_frame(lds); ph_pre(args, F, layer); } SEAM(pb + 0);
        if (IN(pb + 1)) { const Frame F = make_frame(lds); ph_n1(args, F, layer); } SEAM(pb + 1);
        if (IN(pb + 2)) {
            GETWS;
            pg8::Gemm g{(const pg8::bf16_t*)(ws + WS_AB), Wb + WO_IN / 2, TT, NPAD, DM}; pg8::StaticOrder S; S.init(TT, NPAD, F.G, F.bx);
            EpiBf16Mod E{(bf16*)(ws + WS_B + WB_P), NPAD, 1 << 20};
            pg8::gemm_phase<EpiBf16Mod, pg8::StaticOrder>(F.lds, g, S, E, nullptr);
        } SEAM(pb + 2);
        if (IN(pb + 3)) { const Frame F = make_frame(lds); ph_prep(args, F, layer); } SEAM(pb + 3);
        if (IN(pb + 4)) { const Frame F = make_frame(lds); ph_scan(args, F, layer); } SEAM(pb + 4);
        if (IN(pb + 5)) { const Frame F = make_frame(lds); ph_post(args, F, layer); } SEAM(pb + 5);
        if (IN(pb + 6)) {
            GETWS;
            pg8::Gemm g{(const pg8::bf16_t*)(ws + WS_B + WB_G), Wb + WO_GLU / 2, TT, 1024, 1024}; pg8::StaticOrder S; S.init(TT, 1024, F.G, F.bx);
            EpiGlu E{(const bf16*)(ws + WS_B + WB_G), (bf16*)(ws + WS_B + WB_S5O)};
            pg8::gemm_phase<EpiGlu, pg8::StaticOrder>(F.lds, g, S, E, nullptr);
        } SEAM(pb + 6);
        if (IN(pb + 7)) { GETWS;
            { pg8::Gemm g{(const pg8::bf16_t*)(ws + WS_B + WB_S5O), Wb + WO_BRS / 2, TT, DM, 1024}; pg8::StaticOrder S; S.init(TT, DM, F.G, F.bx);
              EpiBr<false> E{(const bf16*)(ws + WS_B + WB_P), PC_GS5, (float*)(ws + WS_B + WB_M1), nullptr};
              pg8::gemm_phase<EpiBr<false>, pg8::StaticOrder>(F.lds, g, S, E, nullptr); }
            __syncthreads();
            { pg8::Gemm g{(const pg8::bf16_t*)(ws + WS_B + WB_DNO), Wb + WO_BRD / 2, TT, DM, 1024}; pg8::StaticOrder S; S.init(TT, DM, F.G, F.bx);
              EpiBr<true> E{(const bf16*)(ws + WS_B + WB_P), PC_GDN, (float*)(ws + WS_B + WB_M1), (bf16*)(ws + WS_B + WB_M)};
              pg8::gemm_phase<EpiBr<true>, pg8::StaticOrder>(F.lds, g, S, E, nullptr); }
        } SEAM(pb + 7);
        if (IN(pb + 8)) {
            GETWS;
            pg8::Gemm g{(const pg8::bf16_t*)(ws + WS_B + WB_M), Wb + WO_OUT / 2, TT, DM, DM}; pg8::StaticOrder S; S.init(TT, DM, F.G, F.bx);
            pg8::EpiF32 E{(float*)(ws + WS_B + WB_MIX), DM, nullptr};
            pg8::gemm_phase<pg8::EpiF32, pg8::StaticOrder>(F.lds, g, S, E, nullptr);
        } SEAM(pb + 8);
        if (IN(pb + 9)) { const Frame F = make_frame(lds); ph_row2(args, F, layer); } SEAM(pb + 9);
        if (IN(pb + 10)) { const Frame F = make_frame(lds); ph_fill(args, F, layer); } SEAM(pb + 10);
        if (IN(pb + 11)) {
            GETWS;
            const int* misc = (const int*)(ws + WS_MISC) + layer * 1024;
            const int ntiles = __builtin_amdgcn_readfirstlane((int)__hip_atomic_load(misc + 512, __ATOMIC_RELAXED, __HIP_MEMORY_SCOPE_AGENT));
            pg8::Gemm g{(const pg8::bf16_t*)(ws + WS_B + WB_HPERM), Wb + WO_GU / 2, ntiles * 256, 1024, DM}; MoeOrder S{ntiles, 4, F.G, F.bx, misc};
            EpiSwiglu E{(bf16*)(ws + WS_B + WB_ACT)};
            pg8::gemm_phase<EpiSwiglu, MoeOrder>(F.lds, g, S, E, nullptr);
        } SEAM(pb + 11);
        if (IN(pb + 12)) {
            GETWS;
            const int* misc = (const int*)(ws + WS_MISC) + layer * 1024;
            const int ntiles = __builtin_amdgcn_readfirstlane((int)__hip_atomic_load(misc + 512, __ATOMIC_RELAXED, __HIP_MEMORY_SCOPE_AGENT));
            pg8::Gemm g{(const pg8::bf16_t*)(ws + WS_B + WB_ACT), Wb + WO_DN / 2, ntiles * 256, DM, EDIM}; MoeOrder S{ntiles, 8, F.G, F.bx, misc};
            EpiBf16Mod E{(bf16*)(ws + WS_B + WB_HPERM), DM, 8};
            pg8::gemm_phase<EpiBf16Mod, MoeOrder>(F.lds, g, S, E, nullptr);
        } SEAM(pb + 12);
        if (IN(pb + 13)) { const Frame F = make_frame(lds); ph_comb(args, F, layer); } SEAM(pb + 13);
    }
    if (DBG_STOP && lo == 1000) {
        const float* xc = (const float*)(args.ws + WS_X) + (size_t)TC * DM;
        for (size_t i = (size_t)blockIdx.x * 512 + threadIdx.x; i < (size_t)TL * DM / 4; i += (size_t)gridDim.x * 512) ((f32x4*)args.out)[i] = ((const f32x4*)xc)[i];
    }
#undef IN
#undef SEAM
}

extern "C" void kernel_launch(void* const* d_in, const int* in_sizes, int n_in, void* d_out, int out_size, void* d_ws, size_t ws_size, hipStream_t stream) {
    static int grid = 0;
    if (grid == 0) {
        if (n_in != 35 || out_size != TL * DM || ws_size < WS_END) { fprintf(stderr, "kernel_launch: unexpected shapes (n_in %d out %d ws %zu need %zu)\n", n_in, out_size, ws_size, (size_t)WS_END); grid = -1; return; }
        int dev = 0, cus = 0;
        if (hipGetDevice(&dev) != hipSuccess || hipDeviceGetAttribute(&cus, hipDeviceAttributeMultiprocessorCount, dev) != hipSuccess) { grid = -1; return; }
        if (hipFuncSetAttribute((const void*)hybrid_fwd, hipFuncAttributeMaxDynamicSharedMemorySize, LDS_BYTES) != hipSuccess) { grid = -1; return; }
        int per_cu = 0;
        (void)hipOccupancyMaxActiveBlocksPerMultiprocessor(&per_cu, (const void*)hybrid_fwd, 512, LDS_BYTES);
        (void)hipGetLastError();
        if (per_cu < 1) { fprintf(stderr, "kernel_launch: occupancy query says %d blocks per CU\n", per_cu); }
        grid = cus;
    }
    if (grid < 0) return;
    (void)hipMemsetAsync((char*)d_ws + WS_CTL, 0, CTL_ZERO_BYTES, stream);
    Args a{};
    for (int i = 0; i < 35; ++i) a.in[i] = (const float*)d_in[i];
    a.out = (float*)d_out; a.ws = (unsigned char*)d_ws;
    if (PER_PHASE_LAUNCH) {
        for (int ph = 0; ph < (DBG_STOP ? DBG_STOP : NLAYER * NPH); ++ph) { a.ph_lo = ph; a.ph_hi = ph + 1; hipLaunchKernelGGL(hybrid_fwd, dim3(grid), dim3(512), LDS_BYTES, stream, a); }
        if (DBG_STOP) { a.ph_lo = 1000; a.ph_hi = 1001; hipLaunchKernelGGL(hybrid_fwd, dim3(grid), dim3(512), LDS_BYTES, stream, a); }
    } else {
        a.ph_lo = 0; a.ph_hi = NLAYER * NPH;
        hipLaunchKernelGGL(hybrid_fwd, dim3(grid), dim3(512), LDS_BYTES, stream, a);
    }
}
```

```cpp
#include <hip/hip_runtime.h>
#include <cstdio>
#include <cstdint>
#ifndef MK_PER_PHASE
#define MK_PER_PHASE 0
#endif
#define DBG_STOP 0
namespace pg8 {
#define PG8_LAS __attribute__((address_space(3)))
typedef unsigned short bf16_t;
typedef short bf16x8 __attribute__((ext_vector_type(8)));
typedef float f32x4 __attribute__((ext_vector_type(4)));
typedef unsigned u32x4 __attribute__((ext_vector_type(4)));
constexpr int BM = 256, BK = 64, HALF = 128, HTB = HALF * BK * 2  , STAGE_BYTES = 8 * HTB, NXCD = 8, WGM = 8;

__host__ __device__ __forceinline__ int lds_byte(int r, int c) { const int st = (r >> 4) * 2 + (c >> 5), rr = r & 15, cc = c & 31, ob = rr * 64 + cc * 2; return st * 1024 + (ob ^ (((ob >> 9) & 1) << 5)); }
__host__ __device__ __forceinline__ void stage_rc(int b, int& R, int& C) { const int st = b / 1024, sb = b % 1024, swz = sb ^ (((sb >> 9) & 1) << 5); R = (st >> 1) * 16 + swz / 64; C = (st & 1) * 32 + (swz % 64) / 2; }
__host__ __device__ __forceinline__ int perm32(int rho) { const int n = rho >> 4, i = rho & 15; return 8 * (i >> 2) + 4 * n + (i & 3); }

struct Unit { int pm, pn; };
struct Gemm { const bf16_t* A; const bf16_t* Bt; int M, N, K; };

struct StaticOrder {
    int nM, nN, nwg, G, c;
    __host__ __device__ void init(int M, int N, int G_, int c_) { nM = M / BM; nN = N / BM; nwg = nM * nN; G = G_; c = c_; }
    __host__ __device__ bool next(int i, Unit& u) const {
        const long L = (long)i * G + c; if (L >= nwg) return false;
        int wgid = (int)L; { const int q = nwg / NXCD, r = nwg % NXCD, xcd = wgid % NXCD, off = wgid / NXCD; wgid = (xcd < r ? xcd * (q + 1) : r * (q + 1) + (xcd - r) * q) + off; }
        const int nig = WGM * nN, gid = wgid / nig, fm = gid * WGM, gsz = (nM - fm) < WGM ? (nM - fm) : WGM;
        u.pm = fm + ((wgid % nig) % gsz); u.pn = (wgid % nig) / gsz; return true;
    }
    __device__ __forceinline__ void a_ready(const Unit&) const {}
    __device__ __forceinline__ void done(const Unit&) const {}
};
struct CountedOrder : StaticOrder {
    const unsigned* ready; unsigned need; unsigned* tmo;
    __device__ __forceinline__ void a_ready(const Unit& u) const {
        if (threadIdx.x < 64) {
            const unsigned long long t0 = __builtin_amdgcn_s_memrealtime(); unsigned polls = 0;
            while ((unsigned)__builtin_amdgcn_readfirstlane(__hip_atomic_load(ready + 64 * u.pm, __ATOMIC_RELAXED, __HIP_MEMORY_SCOPE_AGENT)) < need) {
                if ((++polls & 255u) == 0u && __builtin_amdgcn_readfirstlane(__hip_atomic_load(tmo, __ATOMIC_RELAXED, __HIP_MEMORY_SCOPE_AGENT)) != 0u) break;
                if (__builtin_amdgcn_s_memrealtime() - t0 > 2000000ull) {
                    if (threadIdx.x == 0) { unsigned expect = 0u; __hip_atomic_compare_exchange_strong(tmo + 1, &expect, 0x600u | (unsigned)(u.pm & 0xff), __ATOMIC_RELAXED, __ATOMIC_RELAXED, __HIP_MEMORY_SCOPE_AGENT); __hip_atomic_store(tmo, 1u, __ATOMIC_RELAXED, __HIP_MEMORY_SCOPE_AGENT); }
                    break; }
                __builtin_amdgcn_s_sleep(2); }
            __builtin_amdgcn_fence(__ATOMIC_ACQUIRE, "agent");
            asm volatile("s_waitcnt vmcnt(0)" ::: "memory");
        }
#if !defined(BROKEN_HOOK_NO_BARRIER)
        asm volatile("" ::: "memory"); __builtin_amdgcn_s_barrier(); asm volatile("" ::: "memory");
#endif
    }
};

__device__ __forceinline__ unsigned cvt_pk_bf16(float lo, float hi) { unsigned r; asm volatile("v_cvt_pk_bf16_f32 %0, %1, %2" : "=v"(r) : "v"(lo), "v"(hi)); return r; }
typedef float f32x2 __attribute__((ext_vector_type(2)));
__device__ __forceinline__ f32x2 gelu_pk(f32x2 v) {
    const f32x2 av = __builtin_elementwise_abs(v), d = av * 0.2316418882f + 1.0f;
    f32x2 t; t.x = __builtin_amdgcn_rcpf(d.x); t.y = __builtin_amdgcn_rcpf(d.y);
    f32x2 q = t * 0.5307027145f + (-0.7265760135f); q = q * t + 0.7107068705f; q = q * t + (-0.142248368f); q = q * t + 0.127414796f; q = q * t;
    const f32x2 s = (v * v) * (-0.72134752044f);
    f32x2 e; e.x = __builtin_amdgcn_exp2f(s.x); e.y = __builtin_amdgcn_exp2f(s.y);
    const f32x2 m = v * (q * e), r = v - m;
    f32x2 o; o.x = v.x < 0.f ? m.x : r.x; o.y = v.y < 0.f ? m.y : r.y; return o;
}

struct EpiF32 {
    static constexpr bool PERM = false, AFTER_DRAIN = false;
    float* C; int ldc; const float* bias;
    __device__ __forceinline__ void operator()(const f32x4 (&acc)[2][2][4][2], const Unit& u, int wr, int wc, int fr, int fq) const {
        const int row0 = u.pm * BM + wr * 64 + fr, col0 = u.pn * BM + wc * 32 + 4 * fq;
        f32x4 bv[2][2];
#pragma unroll
        for (int bj = 0; bj < 2; ++bj)
#pragma unroll
            for (int n = 0; n < 2; ++n) bv[bj][n] = bias ? *(const f32x4*)(bias + col0 + bj * HALF + n * 16) : (f32x4){0.f, 0.f, 0.f, 0.f};
#pragma unroll
        for (int ai = 0; ai < 2; ++ai)
#pragma unroll
            for (int m = 0; m < 4; ++m) { float* rowp = C + (size_t)(row0 + ai * HALF + m * 16) * ldc + col0;
#pragma unroll
                for (int bj = 0; bj < 2; ++bj)
#pragma unroll
                    for (int n = 0; n < 2; ++n) *(f32x4*)(rowp + bj * HALF + n * 16) = acc[ai][bj][m][n] + bv[bj][n]; }
    }
};
template <int ACT  > struct EpiBf16 {
    static constexpr bool PERM = true, AFTER_DRAIN = false;
    bf16_t* O; int ldc; const float* bias; int split_cols; size_t split_stride;
    __device__ __forceinline__ void operator()(const f32x4 (&acc)[2][2][4][2], const Unit& u, int wr, int wc, int fr, int fq) const {
        const int row0 = u.pm * BM + wr * 64 + fr; int colt = u.pn * BM; bf16_t* base = O;
        if (split_cols) { const int t = colt / split_cols; base += (size_t)t * split_stride; colt -= t * split_cols; }
        const int col0 = colt + wc * 32 + 8 * fq, bcol0 = u.pn * BM + wc * 32 + 8 * fq;
        f32x4 bv[2][2];
#pragma unroll
        for (int bj = 0; bj < 2; ++bj)
#pragma unroll
            for (int n = 0; n < 2; ++n) bv[bj][n] = bias ? *(const f32x4*)(bias + bcol0 + bj * HALF + 4 * n) : (f32x4){0.f, 0.f, 0.f, 0.f};
#pragma unroll
        for (int ai = 0; ai < 2; ++ai)
#pragma unroll
            for (int m = 0; m < 4; ++m) { bf16_t* rowp = base + (size_t)(row0 + ai * HALF + m * 16) * ldc + col0;
#pragma unroll
                for (int bj = 0; bj < 2; ++bj) { f32x4 v0 = acc[ai][bj][m][0] + bv[bj][0], v1 = acc[ai][bj][m][1] + bv[bj][1];
                    if (ACT == 1) { f32x2 a = gelu_pk((f32x2){v0[0], v0[1]}), b = gelu_pk((f32x2){v0[2], v0[3]}), c = gelu_pk((f32x2){v1[0], v1[1]}), d = gelu_pk((f32x2){v1[2], v1[3]});
                        v0 = (f32x4){a.x, a.y, b.x, b.y}; v1 = (f32x4){c.x, c.y, d.x, d.y}; }
                    if (ACT == 2) {
#pragma unroll
                        for (int j = 0; j < 4; ++j) { v0[j] = 0.5f * v0[j] * (1.0f + erff(v0[j] * 0.70710678f)); v1[j] = 0.5f * v1[j] * (1.0f + erff(v1[j] * 0.70710678f)); } }
                    u32x4 w; w.x = cvt_pk_bf16(v0[0], v0[1]); w.y = cvt_pk_bf16(v0[2], v0[3]); w.z = cvt_pk_bf16(v1[0], v1[1]); w.w = cvt_pk_bf16(v1[2], v1[3]);
                    *(u32x4*)(rowp + bj * HALF) = w; } }
    }
};

struct PanelStats {
    unsigned* xbuf;
    unsigned* cnt;
    unsigned* tmo;
    int ntn; float eps;
    unsigned code;
    __device__ __forceinline__ bool run(const f32x4 (&v)[2][2][4][2], const Unit& u, int wr, int wc, int fr, int fq, PG8_LAS unsigned char* lds, int wid, int lane) const {
        typedef float f32x2v __attribute__((ext_vector_type(2)));
        PG8_LAS f32x2v* P = (PG8_LAS f32x2v*)lds;
        PG8_LAS f32x2v* S = (PG8_LAS f32x2v*)(lds + 8192);
        PG8_LAS unsigned* flag = (PG8_LAS unsigned*)(lds + 8192 + 2048);
#pragma unroll
        for (int ai = 0; ai < 2; ++ai)
#pragma unroll
            for (int m = 0; m < 4; ++m) {
                float s = 0.f;
#pragma unroll
                for (int bj = 0; bj < 2; ++bj)
#pragma unroll
                    for (int n = 0; n < 2; ++n) { const f32x4 x = v[ai][bj][m][n]; s += (x[0] + x[1]) + (x[2] + x[3]); }
                s += __shfl_xor(s, 16); s += __shfl_xor(s, 32);
                const float mw = s * (1.0f / 64.0f); float q = 0.f;
#pragma unroll
                for (int bj = 0; bj < 2; ++bj)
#pragma unroll
                    for (int n = 0; n < 2; ++n) { const f32x4 d = v[ai][bj][m][n] - mw; q += (d[0] * d[0] + d[1] * d[1]) + (d[2] * d[2] + d[3] * d[3]); }
                q += __shfl_xor(q, 16); q += __shfl_xor(q, 32);
                if (fq == 0) P[(ai * HALF + wr * 64 + m * 16 + fr) * 4 + wc] = (f32x2v){mw, q};
            }
        asm volatile("s_waitcnt lgkmcnt(0)" ::: "memory"); __builtin_amdgcn_s_barrier(); asm volatile("" ::: "memory");
#if defined(BROKEN_NO_WAIT)
        if (blockIdx.x >= 64) { const long long t0 = clock64(); while (clock64() - t0 < 60000) __builtin_amdgcn_s_sleep(8); }
#endif
        const int row = wid * 32 + (lane & 31);
        if (lane < 32) {
            const f32x2v a = P[row * 4 + 0], b = P[row * 4 + 1], c = P[row * 4 + 2], d = P[row * 4 + 3];
            const float mt = (a.x + b.x + c.x + d.x) * 0.25f;
            const float da = a.x - mt, db = b.x - mt, dc = c.x - mt, dd = d.x - mt;
            const float m2 = (a.y + b.y) + (c.y + d.y) + 64.0f * ((da * da + db * db) + (dc * dc + dd * dd));
            unsigned long long* slot = (unsigned long long*)xbuf + ((size_t)(u.pm * BM + row) * 4 + u.pn);
            __hip_atomic_store(slot, ((unsigned long long)__float_as_uint(m2) << 32) | __float_as_uint(mt), __ATOMIC_RELAXED, __HIP_MEMORY_SCOPE_AGENT);
        }
        asm volatile("s_waitcnt vmcnt(0)" ::: "memory");
        if (lane == 0) __hip_atomic_fetch_add(cnt + 64 * u.pm, 1u, __ATOMIC_RELAXED, __HIP_MEMORY_SCOPE_AGENT);
        if (wid == 0) {
            bool dead = false; const unsigned long long t0 = __builtin_amdgcn_s_memrealtime(); const unsigned want = 8u * (unsigned)ntn;
            for (;;) {
#if defined(BROKEN_NO_WAIT)
                break;
#endif
                if ((unsigned)__builtin_amdgcn_readfirstlane(__hip_atomic_load(cnt + 64 * u.pm, __ATOMIC_RELAXED, __HIP_MEMORY_SCOPE_AGENT)) >= want) break;
                if (__builtin_amdgcn_s_memrealtime() - t0 > 2000000ull) {
                    if (lane == 0) { unsigned expect = 0u; __hip_atomic_compare_exchange_strong(tmo + 1, &expect, code | (unsigned)(u.pm & 0xff), __ATOMIC_RELAXED, __ATOMIC_RELAXED, __HIP_MEMORY_SCOPE_AGENT);
                                     __hip_atomic_store(tmo, 1u, __ATOMIC_RELAXED, __HIP_MEMORY_SCOPE_AGENT); }
                    dead = true; break; }
                __builtin_amdgcn_s_sleep(2);
            }
            __builtin_amdgcn_fence(__ATOMIC_ACQUIRE, "agent");
            if (lane == 0) flag[0] = dead ? 1u : 0u;
        }
        asm volatile("s_waitcnt vmcnt(0) lgkmcnt(0)" ::: "memory"); __builtin_amdgcn_s_barrier(); asm volatile("" ::: "memory");
        const bool bad = flag[0] != 0u;
        if (lane < 32) {
            const unsigned long long* slot = (const unsigned long long*)xbuf + (size_t)(u.pm * BM + row) * 4; float mt[4], m2[4]; float ms = 0.f;
#pragma unroll
            for (int t = 0; t < 4; ++t) { if (t < ntn) { const unsigned long long w = __hip_atomic_load(slot + t, __ATOMIC_RELAXED, __HIP_MEMORY_SCOPE_AGENT); mt[t] = __uint_as_float((unsigned)w); m2[t] = __uint_as_float((unsigned)(w >> 32)); } else { mt[t] = 0.f; m2[t] = 0.f; } ms += mt[t]; }
            const float mean = ms / (float)ntn; float q = 0.f;
#pragma unroll
            for (int t = 0; t < 4; ++t) if (t < ntn) { const float dm = mt[t] - mean; q += m2[t] + 256.0f * dm * dm; }
            S[row] = (f32x2v){mean, 1.0f / sqrtf(q / (256.0f * (float)ntn) + eps)};
        }
        asm volatile("s_waitcnt lgkmcnt(0)" ::: "memory"); __builtin_amdgcn_s_barrier(); asm volatile("" ::: "memory");
        return bad;
    }
};
struct EpiLnRes {
    static constexpr bool PERM = false, AFTER_DRAIN = true;
    const float* base; float* out; int ldc; const float* bias; PanelStats st; unsigned poison;
    __device__ __forceinline__ void refuse(size_t i0, size_t stride, int M, int N) const { const float q = __builtin_nanf(""); for (size_t i = i0; i < (size_t)M * N; i += stride) out[(i / N) * ldc + i % N] = q;
        if (i0 == 0) { unsigned expect = 0u; __hip_atomic_compare_exchange_strong(st.tmo + 1, &expect, 0x7f0u, __ATOMIC_RELAXED, __ATOMIC_RELAXED, __HIP_MEMORY_SCOPE_AGENT); __hip_atomic_store(st.tmo, 1u, __ATOMIC_RELAXED, __HIP_MEMORY_SCOPE_AGENT); } }
    __device__ __forceinline__ void fused(f32x4 (&acc)[2][2][4][2], const Unit& u, int wr, int wc, int fr, int fq, PG8_LAS unsigned char* lds, int wid, int lane) const {
        typedef float f32x2v __attribute__((ext_vector_type(2)));
        const PG8_LAS f32x2v* S = (const PG8_LAS f32x2v*)(lds + 8192);
        const int col0 = u.pn * BM + wc * 32 + 4 * fq;
#pragma unroll
        for (int bj = 0; bj < 2; ++bj)
#pragma unroll
            for (int n = 0; n < 2; ++n) { const f32x4 bv = bias ? *(const f32x4*)(bias + col0 + bj * HALF + n * 16) : (f32x4){0.f, 0.f, 0.f, 0.f};
#pragma unroll
                for (int ai = 0; ai < 2; ++ai)
#pragma unroll
                    for (int m = 0; m < 4; ++m) acc[ai][bj][m][n] += bv; }
        const bool bad = st.run(acc, u, wr, wc, fr, fq, lds, wid, lane) || poison != 0u;
        const float qnan = __builtin_nanf("");
#pragma unroll
        for (int ai = 0; ai < 2; ++ai)
#pragma unroll
            for (int m = 0; m < 4; ++m) { const int r = ai * HALF + wr * 64 + m * 16 + fr; const f32x2v sr = S[r]; const size_t off = (size_t)(u.pm * BM + r) * ldc + col0;
#pragma unroll
                for (int bj = 0; bj < 2; ++bj)
#pragma unroll
                    for (int n = 0; n < 2; ++n) { const f32x4 bs = *(const f32x4*)(base + off + bj * HALF + n * 16); f32x4 o = bs + (acc[ai][bj][m][n] - sr.x) * sr.y;
                        if (bad) o = (f32x4){qnan, qnan, qnan, qnan}; *(f32x4*)(out + off + bj * HALF + n * 16) = o; }
                asm volatile("" ::: "memory"); }
    }
};
struct EpiLnResLn {
    static constexpr bool PERM = false, AFTER_DRAIN = true;
    const float* base; float* out; bf16_t* xn; int ldc; const float* bias; PanelStats st1, st2; unsigned poison;
    __device__ __forceinline__ void refuse(size_t i0, size_t stride, int M, int N) const { const float q = __builtin_nanf(""); for (size_t i = i0; i < (size_t)M * N; i += stride) { const size_t o = (i / N) * ldc + i % N; out[o] = q; xn[o] = (bf16_t)0x7fc0u; }
        if (i0 == 0) { unsigned expect = 0u; __hip_atomic_compare_exchange_strong(st1.tmo + 1, &expect, 0x7f0u, __ATOMIC_RELAXED, __ATOMIC_RELAXED, __HIP_MEMORY_SCOPE_AGENT); __hip_atomic_store(st1.tmo, 1u, __ATOMIC_RELAXED, __HIP_MEMORY_SCOPE_AGENT); } }
    __device__ __forceinline__ void fused(f32x4 (&acc)[2][2][4][2], const Unit& u, int wr, int wc, int fr, int fq, PG8_LAS unsigned char* lds, int wid, int lane) const {
        typedef float f32x2v __attribute__((ext_vector_type(2))); typedef unsigned u32x2v __attribute__((ext_vector_type(2)));
        const PG8_LAS f32x2v* S = (const PG8_LAS f32x2v*)(lds + 8192);
        const int col0 = u.pn * BM + wc * 32 + 4 * fq;
#pragma unroll
        for (int bj = 0; bj < 2; ++bj)
#pragma unroll
            for (int n = 0; n < 2; ++n) { const f32x4 bv = bias ? *(const f32x4*)(bias + col0 + bj * HALF + n * 16) : (f32x4){0.f, 0.f, 0.f, 0.f};
#pragma unroll
                for (int ai = 0; ai < 2; ++ai)
#pragma unroll
                    for (int m = 0; m < 4; ++m) acc[ai][bj][m][n] += bv; }
        bool bad = st1.run(acc, u, wr, wc, fr, fq, lds, wid, lane) || poison != 0u;
        const float qnan = __builtin_nanf("");
#pragma unroll
        for (int ai = 0; ai < 2; ++ai)
#pragma unroll
            for (int m = 0; m < 4; ++m) { const int r = ai * HALF + wr * 64 + m * 16 + fr; const f32x2v sr = S[r]; const size_t off = (size_t)(u.pm * BM + r) * ldc + col0;
#pragma unroll
                for (int bj = 0; bj < 2; ++bj)
#pragma unroll
                    for (int n = 0; n < 2; ++n) { const f32x4 bs = *(const f32x4*)(base + off + bj * HALF + n * 16); acc[ai][bj][m][n] = bs + (acc[ai][bj][m][n] - sr.x) * sr.y; }
                asm volatile("" : "+v"(acc[ai][0][m][0]), "+v"(acc[ai][0][m][1]), "+v"(acc[ai][1][m][0]), "+v"(acc[ai][1][m][1]));
                if (m & 1) asm volatile("" ::: "memory"); }
        const bool bad1 = bad;
        bad = st2.run(acc, u, wr, wc, fr, fq, lds, wid, lane) || bad;
#pragma unroll
        for (int ai = 0; ai < 2; ++ai)
#pragma unroll
            for (int m = 0; m < 4; ++m) { const int r = ai * HALF + wr * 64 + m * 16 + fr; const f32x2v sr = S[r]; const size_t off = (size_t)(u.pm * BM + r) * ldc + col0;
#pragma unroll
                for (int bj = 0; bj < 2; ++bj)
#pragma unroll
                    for (int n = 0; n < 2; ++n) { const f32x4 x1 = acc[ai][bj][m][n]; *(f32x4*)(out + off + bj * HALF + n * 16) = bad1 ? (f32x4){qnan, qnan, qnan, qnan} : x1;
                        const f32x4 o = (x1 - sr.x) * sr.y; u32x2v w; w.x = cvt_pk_bf16(o[0], o[1]); w.y = cvt_pk_bf16(o[2], o[3]);
                        if (bad) { w.x = 0x7fc07fc0u; w.y = 0x7fc07fc0u; } *(u32x2v*)(xn + off + bj * HALF + n * 16) = w; }
                asm volatile("" ::: "memory"); }
    }
};

template <class Epi, class Sched, bool STAMP = false>
__device__ __forceinline__ void gemm_phase(PG8_LAS unsigned char* lds, const Gemm g, const Sched& S, const Epi& E, unsigned long long* stamps, int tid_in) {
    int tid_ = tid_in; asm volatile("" : "+v"(tid_));
    const int tid = tid_, wid = __builtin_amdgcn_readfirstlane(tid >> 6), lane = tid & 63, wr = wid >> 2, wc = wid & 3, fr = lane & 15, fq = lane >> 4;
    const int K = g.K, nt = K / BK;
    int ts_lo = 0, ts_hi = 0, nts = 0; const unsigned long long rt_entry = STAMP ? (unsigned long long)wall_clock64() : 0ull;
#define PG8_STAMP() do { if (STAMP && wid == 0 && nts < 64) { const unsigned long long _c = (unsigned long long)clock64(); \
        ts_lo = (lane == nts) ? (int)(unsigned)_c : ts_lo; ts_hi = (lane == nts) ? (int)(unsigned)(_c >> 32) : ts_hi; ++nts; } } while (0)
    PG8_STAMP();
    unsigned voffA[2], voffB[2];
#pragma unroll
    for (int i = 0; i < 2; ++i) { int R, C; stage_rc(tid * 16 + i * 8192, R, C); const int Rb = Epi::PERM ? ((R & ~31) + perm32(R & 31)) : R;
        voffA[i] = (unsigned)(R * K + C) * 2u; voffB[i] = (unsigned)(Rb * K + C) * 2u; }
    const size_t kstep = (size_t)(BK * 2);
    const size_t hstep = (size_t)HALF * K * 2;
    const size_t tstep = 2 * hstep;
    const unsigned ldsw = (unsigned)wid * 1024u;
    const int aoff = lds_byte(wr * 64 + fr, fq * 8), boff = lds_byte(wc * 32 + fr, fq * 8);
#define PG8_SA(b, h) (((b) * 2 + (h)) * HTB)
#define PG8_SB(b, h) ((4 + (b) * 2 + (h)) * HTB)
#define PG8_STAGE(bufoff, gbase, voff) do { _Pragma("unroll") for (int _i = 0; _i < 2; ++_i) \
        __builtin_amdgcn_global_load_lds((const unsigned*)((const char*)(gbase) + (voff)[_i]), (PG8_LAS unsigned*)(lds + (bufoff) + ldsw + _i * 8192), 16, 0, 0); } while (0)
#define PG8_LDA(dst, b, h) do { _Pragma("unroll") for (int m = 0; m < 4; ++m) _Pragma("unroll") for (int k = 0; k < 2; ++k) dst[m][k] = *(const PG8_LAS bf16x8*)(lds + PG8_SA(b, h) + aoff + m * 2048 + k * 1024); } while (0)
#define PG8_LDB(dst, b, h) do { _Pragma("unroll") for (int n = 0; n < 2; ++n) _Pragma("unroll") for (int k = 0; k < 2; ++k) dst[n][k] = *(const PG8_LAS bf16x8*)(lds + PG8_SB(b, h) + boff + n * 2048 + k * 1024); } while (0)
#define PG8_MMA(ai, bj, At, Bt) do { __builtin_amdgcn_s_setprio(1); _Pragma("unroll") for (int m = 0; m < 4; ++m) _Pragma("unroll") for (int n = 0; n < 2; ++n) _Pragma("unroll") for (int k = 0; k < 2; ++k) \
        acc[ai][bj][m][n] = __builtin_amdgcn_mfma_f32_16x16x32_bf16(Bt[n][k], At[m][k], acc[ai][bj][m][n], 0, 0, 0); __builtin_amdgcn_s_setprio(0); } while (0)
#define PG8_WAIT_V(n) asm volatile("s_waitcnt vmcnt(" #n ")" ::: "memory")
#define PG8_WAIT_L(n) asm volatile("s_waitcnt lgkmcnt(" #n ")" ::: "memory")
#define PG8_BAR __builtin_amdgcn_s_barrier()
#define PG8_SCHED __builtin_amdgcn_sched_barrier(0)
    Unit cur, nxt; int ui = 0;
    if (!S.next(0, cur)) return;
    f32x4 acc[2][2][4][2];
#pragma unroll
    for (int a = 0; a < 2; ++a)
#pragma unroll
        for (int b = 0; b < 2; ++b)
#pragma unroll
            for (int m = 0; m < 4; ++m)
#pragma unroll
                for (int n = 0; n < 2; ++n) acc[a][b][m][n] = (f32x4){0.f, 0.f, 0.f, 0.f};
    bf16x8 At[4][2], B0[2][2], B1[2][2];
    const char* cA = (const char*)g.A + (size_t)cur.pm * tstep; const char* cB = (const char*)g.Bt + (size_t)cur.pn * tstep;
    S.a_ready(cur);
    PG8_STAGE(PG8_SB(0, 0), cB, voffB); PG8_STAGE(PG8_SA(0, 0), cA, voffA); PG8_STAGE(PG8_SB(0, 1), cB + hstep, voffB); PG8_STAGE(PG8_SA(0, 1), cA + hstep, voffA);
    if (wr == 1) PG8_BAR;
    PG8_WAIT_V(4); PG8_BAR;
    PG8_STAGE(PG8_SB(1, 0), cB + kstep, voffB); PG8_STAGE(PG8_SA(1, 0), cA + kstep, voffA); PG8_STAGE(PG8_SB(1, 1), cB + hstep + kstep, voffB);
    PG8_WAIT_V(6); PG8_BAR;
    PG8_STAMP();
    for (;;) {
        const bool has_next = S.next(ui + 1, nxt);
        const char* nA = has_next ? (const char*)g.A + (size_t)nxt.pm * tstep : cA; const char* nB = has_next ? (const char*)g.Bt + (size_t)nxt.pn * tstep : cB;
        for (int t = 0; t < nt; t += 2) {
            const bool last = (t == nt - 2);
            const char* a1 = cA + (size_t)(t + 1) * kstep;
            const char* a2 = last ? nA : cA + (size_t)(t + 2) * kstep; const char* b2 = last ? nB : cB + (size_t)(t + 2) * kstep;
            const char* a3 = a2 + kstep; const char* b3 = b2 + kstep;
            if (last && has_next) S.a_ready(nxt);
            PG8_LDB(B0, 0, 0); PG8_SCHED; PG8_LDA(At, 0, 0); PG8_STAGE(PG8_SA(1, 1), a1 + hstep, voffA);
            PG8_WAIT_L(8); PG8_BAR; PG8_WAIT_L(0); PG8_MMA(0, 0, At, B0); PG8_BAR; PG8_SCHED;
            PG8_LDB(B1, 0, 1); PG8_STAGE(PG8_SB(0, 0), b2, voffB);
            PG8_BAR; PG8_WAIT_L(0); PG8_MMA(0, 1, At, B1); PG8_BAR;
            PG8_LDA(At, 0, 1); PG8_STAGE(PG8_SA(0, 0), a2, voffA);
            PG8_BAR; PG8_WAIT_L(0); PG8_MMA(1, 0, At, B0); PG8_BAR; PG8_SCHED;
            PG8_STAGE(PG8_SB(0, 1), b2 + hstep, voffB);
            PG8_WAIT_V(6); PG8_BAR; PG8_MMA(1, 1, At, B1); PG8_BAR;
            PG8_LDB(B0, 1, 0); PG8_SCHED; PG8_LDA(At, 1, 0); PG8_STAGE(PG8_SA(0, 1), a2 + hstep, voffA);
            PG8_WAIT_L(8); PG8_BAR; PG8_WAIT_L(0); PG8_MMA(0, 0, At, B0); PG8_BAR; PG8_SCHED;
            PG8_LDB(B1, 1, 1); PG8_STAGE(PG8_SB(1, 0), b3, voffB);
            PG8_BAR; PG8_WAIT_L(0); PG8_MMA(0, 1, At, B1); PG8_BAR;
            PG8_LDA(At, 1, 1); PG8_STAGE(PG8_SA(1, 0), a3, voffA);
            PG8_BAR; PG8_WAIT_L(0); PG8_MMA(1, 0, At, B0); PG8_BAR; PG8_SCHED;
            PG8_STAGE(PG8_SB(1, 1), b3 + hstep, voffB);
            PG8_WAIT_V(6); PG8_BAR; PG8_MMA(1, 1, At, B1); PG8_BAR;
        }
        PG8_STAMP();
        if constexpr (!Epi::AFTER_DRAIN) { E(acc, cur, wr, wc, fr, fq); S.done(cur); }
        PG8_STAMP();
        if (!has_next) break;
#pragma unroll
        for (int a = 0; a < 2; ++a)
#pragma unroll
            for (int b = 0; b < 2; ++b)
#pragma unroll
                for (int m = 0; m < 4; ++m)
#pragma unroll
                    for (int n = 0; n < 2; ++n) acc[a][b][m][n] = (f32x4){0.f, 0.f, 0.f, 0.f};
        cur = nxt; cA = nA; cB = nB; ++ui;
    }
    PG8_WAIT_V(0);
    if (wr == 0) PG8_BAR;
    PG8_BAR;
    if constexpr (Epi::AFTER_DRAIN) { E.fused(acc, cur, wr, wc, fr, fq, lds, wid, lane); S.done(cur); }
    PG8_STAMP();
    if (STAMP && wid == 0) { stamps[lane] = lane < nts ? (((unsigned long long)(unsigned)ts_hi << 32) | (unsigned)ts_lo) : 0ull;
        if (lane == 62) stamps[62] = rt_entry; if (lane == 63) stamps[63] = (unsigned long long)wall_clock64(); }
#undef PG8_STAMP
#undef PG8_SA
#undef PG8_SB
#undef PG8_STAGE
#undef PG8_LDA
#undef PG8_LDB
#undef PG8_MMA
#undef PG8_WAIT_V
#undef PG8_WAIT_L
#undef PG8_BAR
#undef PG8_SCHED
}
}

constexpr int DM = 2048, NBATCH = 4, SEQ = 2048, CTXL = 256;
constexpr int TC = NBATCH * CTXL;
constexpr int TL = NBATCH * SEQ;
constexpr int TT = TC + TL;
constexpr int NLAYER = 2;
constexpr int NPAD = 9472;
constexpr int PC_U = 0, PC_QKV = 1024, PC_Z = 4096, PC_GS5 = 5120, PC_GDN = 7168, PC_BA = 9216;
constexpr int NE = 64, NEX = 65, EDIM = 512;
constexpr int MAXTILES = 388, MAXSLOT = MAXTILES * 256;
constexpr float EPS = 1e-6f;
constexpr int MODW = 12288;

constexpr size_t MiB = 1u << 20;
constexpr size_t WS_CTL = 0, CTL_ZERO_BYTES = 2 * MiB;
constexpr int CW_BAR = 4096;
constexpr int CW_CNT = 16384;
constexpr int CW_FILL = 16384 + 256;
constexpr size_t WS_MODS = 1 * MiB;
constexpr size_t WS_MISC = 2 * MiB;
constexpr size_t WS_W = 4 * MiB;
constexpr size_t WO_IN = 0, WO_GLU = 37 * MiB, WO_BRS = 39 * MiB, WO_BRD = 43 * MiB, WO_OUT = 47 * MiB, WO_GU = 55 * MiB, WO_DN = (55 + 260) * MiB, W_BYTES = (55 + 260 + 130) * MiB;
constexpr size_t WS_X = WS_W + W_BYTES;
constexpr size_t WS_EIDX = WS_X + 72 * MiB;
constexpr size_t WS_WTS = WS_EIDX + 1 * MiB;
constexpr size_t WS_SLOT = WS_WTS + 1 * MiB;
constexpr size_t WS_AB = WS_SLOT + 1 * MiB;
constexpr size_t WS_B = WS_AB + 36 * MiB;
constexpr size_t WB_P = 0;
constexpr size_t WB_QKV = 167 * MiB;
constexpr size_t WB_BG = WB_QKV + 108 * MiB;
constexpr size_t WB_Y = WB_BG + 2 * MiB;
constexpr size_t WB_O = WB_Y + 72 * MiB;
constexpr size_t WB_G = WB_O + 72 * MiB;
constexpr size_t WB_DNO = WB_G + 18 * MiB;
constexpr size_t WB_S5O = WB_DNO + 18 * MiB;
constexpr size_t WB_M1 = WB_S5O + 18 * MiB;
constexpr size_t WB_M = WB_M1 + 72 * MiB;
constexpr size_t WB_MIX = WB_M + 36 * MiB;
constexpr size_t WB_DNU = WB_MIX + 72 * MiB;
constexpr int DN_UNITS = 4 * 8 * 2 * 36;
constexpr size_t DNU_W = 0, DNU_UT = (size_t)DN_UNITS * 16384, DNU_KT = 2 * DNU_UT, DNU_QK = 3 * DNU_UT, DNU_SC = DNU_QK + (size_t)DN_UNITS * 8192;
constexpr size_t WB_END = WB_DNU + 132 * MiB;
constexpr size_t WB_HPERM = 0;
constexpr size_t WB_ACT = 388 * MiB;
static_assert(WB_ACT + 97 * MiB <= WB_END, "moe scratch fits");
constexpr size_t WS_END = WS_B + WB_END;

constexpr int LDS_BYTES = 147456;
constexpr int LDS_MISC = LDS_BYTES - 256;

#define LAS __attribute__((address_space(3)))
typedef unsigned short bf16;
typedef float f32x4 __attribute__((ext_vector_type(4)));
typedef float f32x2 __attribute__((ext_vector_type(2)));
typedef unsigned u32x4 __attribute__((ext_vector_type(4)));
typedef unsigned u32x2 __attribute__((ext_vector_type(2)));

#define LDS_WAIT() asm volatile("s_waitcnt lgkmcnt(0)" ::: "memory")
#define VM_WAIT() asm volatile("s_waitcnt vmcnt(0)" ::: "memory")

__device__ __forceinline__ unsigned f2bf(float f) { unsigned u = __float_as_uint(f); return (u + 0x7fffu + ((u >> 16) & 1u)) >> 16; }
__device__ __forceinline__ unsigned pk2(float lo, float hi) { return f2bf(lo) | (f2bf(hi) << 16); }
__device__ __forceinline__ float bflo(unsigned w) { return __uint_as_float(w << 16); }
__device__ __forceinline__ float bfhi(unsigned w) { return __uint_as_float(w & 0xffff0000u); }
__device__ __forceinline__ float bf2f(bf16 b) { return __uint_as_float(((unsigned)b) << 16); }
__device__ __forceinline__ float sigmoidf_(float x) { return 1.f / (1.f + __expf(-x)); }
__device__ __forceinline__ float siluf_(float x) { return x / (1.f + __expf(-x)); }
__device__ __forceinline__ float gelu_tanh(float x) { const float t = tanhf(0.7978845608028654f * (x + 0.044715f * x * x * x)); return 0.5f * x * (1.f + t); }
__device__ __forceinline__ int lane_id() { int l; asm volatile("v_mbcnt_lo_u32_b32 %0, -1, 0\n\tv_mbcnt_hi_u32_b32 %0, -1, %0" : "=v"(l)); return l; }
__device__ __forceinline__ float wave_sum(float v) {
#pragma unroll
    for (int o = 1; o < 64; o <<= 1) v += __shfl_xor(v, o);
    return v;
}

#define XB_TMO      128
#define XB_XCNT(j)  (256  + 64 * (j))
#define XB_XSUB(j)  (1280 + 64 * (j))
#define XB_XGEN(j)  (2304 + 64 * (j))
#define XB_TOP      3328
#define XB_TOPGEN   3392
#define XCD_BAR_WORDS 3456
#define XB_SPIN_CAP (1u << 20)

__device__ __forceinline__ unsigned xb_ld(unsigned* p)              { return __hip_atomic_load(p, __ATOMIC_RELAXED, __HIP_MEMORY_SCOPE_AGENT); }
__device__ __forceinline__ unsigned xb_add(unsigned* p, unsigned v) { return __hip_atomic_fetch_add(p, v, __ATOMIC_RELAXED, __HIP_MEMORY_SCOPE_AGENT); }
__device__ __forceinline__ unsigned xb_xcc_id() { return (unsigned)__builtin_amdgcn_s_getreg((3 << 11) | 20) & 0xFu; }
#define XB_SPIN(cond, bar) do { unsigned _sp = 0; while (cond) { __builtin_amdgcn_s_sleep(1); \
    if ((++_sp & 255u) == 0u) { if (xb_ld(&(bar)[XB_TMO])) break; if (_sp > XB_SPIN_CAP) { atomicAdd(&(bar)[XB_TMO], 1u); break; } } } } while (0)

struct XcdBarrier { unsigned* bar; unsigned x; volatile LAS unsigned* st; };

__device__ __forceinline__ XcdBarrier xcd_barrier_post(unsigned* bar, volatile LAS unsigned* st) {
    XcdBarrier b; b.bar = bar; b.x = xb_xcc_id(); b.st = st;
    if (threadIdx.x == 0) (void)xb_add(&bar[XB_XCNT(b.x)], 1u);
    return b;
}
__device__ __forceinline__ void xcd_barrier_complete(unsigned* bar, unsigned x, unsigned& nloc, unsigned& nx) {
    const unsigned G = gridDim.x * gridDim.y * gridDim.z;
    unsigned sum, cnt, mine, sp = 0u;
    for (;;) {
        sum = 0u; cnt = 0u; mine = 0u;
#pragma unroll
        for (unsigned j = 0; j < 16; ++j) { const unsigned c = xb_ld(&bar[XB_XCNT(j)]); sum += c; cnt += (c > 0u) ? 1u : 0u; mine = (j == x) ? c : mine; }
        if (sum == G) break;
        __builtin_amdgcn_s_sleep(1);
        if ((++sp & 255u) == 0u) { if (xb_ld(&bar[XB_TMO])) break; if (sp > XB_SPIN_CAP) { atomicAdd(&bar[XB_TMO], 1u); break; } }
    }
    nloc = mine > 0u ? mine : 1u; nx = cnt > 0u ? cnt : 1u;
}
__device__ __forceinline__ void xcd_barrier(const XcdBarrier& b, int wave_s) {
    asm volatile("s_waitcnt vmcnt(0)" ::: "memory");
    __syncthreads();
    asm volatile("" : "+s"(wave_s));
    if (wave_s == 0 && lane_id() == 0) {
        unsigned* bar = b.bar; asm volatile("" : "+s"(bar));
        __builtin_amdgcn_s_waitcnt(0);
        unsigned nloc = b.st[0], nx = b.st[1];
        unsigned bx_ = b.x; asm volatile("" : "+s"(bx_));
        if (nloc == 0u) { xcd_barrier_complete(bar, bx_, nloc, nx); b.st[0] = nloc; b.st[1] = nx; }
        const unsigned old = xb_add(&bar[XB_XSUB(bx_)], 1u);
        const unsigned gen = old / nloc;
        if (old + 1u == (gen + 1u) * nloc) {
            __builtin_amdgcn_fence(__ATOMIC_RELEASE, "agent");
            asm volatile("s_waitcnt vmcnt(0)" ::: "memory");
            const unsigned og = xb_add(&bar[XB_TOP], 1u);
            const unsigned tg = og / nx;
            if (og + 1u == (tg + 1u) * nx) xb_add(&bar[XB_TOPGEN], 1u);
            else XB_SPIN(xb_ld(&bar[XB_TOPGEN]) == tg, bar);
            __builtin_amdgcn_fence(__ATOMIC_ACQUIRE, "agent");
            xb_add(&bar[XB_XGEN(bx_)], 1u);
            asm volatile("s_waitcnt vmcnt(0)" ::: "memory");
        } else {
            XB_SPIN(xb_ld(&bar[XB_XGEN(bx_)]) == gen, bar);
            __builtin_amdgcn_fence(__ATOMIC_ACQUIRE, "agent");
            asm volatile("s_waitcnt vmcnt(0)" ::: "memory");
        }
    }
    __syncthreads();
}

struct Args { const float* in[35]; float* out; unsigned char* ws; int ph_lo, ph_hi; };
struct Frame { LAS unsigned char* lds; int tid, lane, wave, G, bx, vcu, gw, NGW; };
__device__ __forceinline__ Frame make_frame(LAS unsigned char* lds, int wave_s) {
    asm volatile("" : "+s"(wave_s));
    Frame F; int tid = wave_s * 64 + lane_id(); asm volatile("" : "+v"(tid)); int bx = blockIdx.x; asm volatile("" : "+s"(bx));
    F.lds = lds; F.tid = tid; F.lane = tid & 63; F.wave = __builtin_amdgcn_readfirstlane(tid >> 6); F.G = gridDim.x; F.bx = bx;
    F.vcu = (F.G % 8 == 0) ? (bx % 8) * (F.G / 8) + bx / 8 : bx; F.gw = F.vcu * 8 + F.wave; F.NGW = F.G * 8; return F;
}
#define CAS __attribute__((address_space(4)))
__device__ __forceinline__ const float* inp(int i) {
    asm volatile("" : "+s"(i));
    const CAS char* ka = (const CAS char*)__builtin_amdgcn_kernarg_segment_ptr();
    return *(const float* const CAS*)(ka + 8 * i);
}

enum { I_X = 0, I_C, I_CTX, I_CCTX, I_WMOD, I_BMOD, I_NMPRE, I_NMPOST, I_NFPRE, I_NFPOST, I_WIN, I_LAMRE, I_LAMIM, I_LOGSTEP, I_BRE, I_BIM, I_CRE, I_CIM,
       I_S5D, I_WGLU, I_CONV, I_ALOG, I_DTB, I_DNNORM, I_WBRS, I_WBRD, I_WOUT, I_ROUTER, I_MBIAS, I_MGATE, I_MUP, I_MDOWN, I_SGATE, I_SUP, I_SDOWN };

struct MoeOrder {
    int ntiles, npn, G, c; const int* tile_e;
    __device__ __forceinline__ bool next(int i, pg8::Unit& u) const {
        const long L = (long)i * G + c; if (L >= (long)ntiles * npn) return false;
        const int tile = (int)(L / npn), pl = (int)(L % npn);
        const int e = __builtin_amdgcn_readfirstlane((int)__hip_atomic_load(tile_e + tile, __ATOMIC_RELAXED, __HIP_MEMORY_SCOPE_AGENT));
        u.pm = tile; u.pn = e * npn + pl; return true;
    }
    __device__ __forceinline__ void a_ready(const pg8::Unit&) const {}
    __device__ __forceinline__ void done(const pg8::Unit&) const {}
};

struct EpiBf16Mod {
    static constexpr bool PERM = true, AFTER_DRAIN = false;
    bf16* O; int ldc; int npn;
    __device__ __forceinline__ void operator()(const pg8::f32x4 (&acc)[2][2][4][2], const pg8::Unit& u, int wr, int wc, int fr, int fq) const {
        const int row0 = u.pm * 256 + wr * 64 + fr, col0 = (u.pn % npn) * 256 + wc * 32 + 8 * fq;
#pragma unroll
        for (int ai = 0; ai < 2; ++ai)
#pragma unroll
            for (int m = 0; m < 4; ++m) { bf16* rowp = O + (size_t)(row0 + ai * 128 + m * 16) * ldc + col0;
#pragma unroll
                for (int bj = 0; bj < 2; ++bj) { const pg8::f32x4 v0 = acc[ai][bj][m][0], v1 = acc[ai][bj][m][1];
                    u32x4 w; w.x = pk2(v0[0], v0[1]); w.y = pk2(v0[2], v0[3]); w.z = pk2(v1[0], v1[1]); w.w = pk2(v1[2], v1[3]);
                    *(u32x4*)(rowp + bj * 128) = w; } }
    }
};
struct EpiGlu {
    static constexpr bool PERM = true, AFTER_DRAIN = false;
    const bf16* Gb; bf16* O;
    __device__ __forceinline__ void operator()(const pg8::f32x4 (&acc)[2][2][4][2], const pg8::Unit& u, int wr, int wc, int fr, int fq) const {
        const int row0 = u.pm * 256 + wr * 64 + fr, col0 = u.pn * 256 + wc * 32 + 8 * fq;
#pragma unroll
        for (int ai = 0; ai < 2; ++ai)
#pragma unroll
            for (int m = 0; m < 4; ++m) { const size_t ro = (size_t)(row0 + ai * 128 + m * 16) * 1024 + col0;
#pragma unroll
                for (int bj = 0; bj < 2; ++bj) { const pg8::f32x4 v0 = acc[ai][bj][m][0], v1 = acc[ai][bj][m][1];
                    const u32x4 gq = *(const u32x4*)(Gb + ro + bj * 128);
                    u32x4 w;
                    w.x = pk2(bflo(gq.x) * sigmoidf_(v0[0]), bfhi(gq.x) * sigmoidf_(v0[1]));
                    w.y = pk2(bflo(gq.y) * sigmoidf_(v0[2]), bfhi(gq.y) * sigmoidf_(v0[3]));
                    w.z = pk2(bflo(gq.z) * sigmoidf_(v1[0]), bfhi(gq.z) * sigmoidf_(v1[1]));
                    w.w = pk2(bflo(gq.w) * sigmoidf_(v1[2]), bfhi(gq.w) * sigmoidf_(v1[3]));
                    *(u32x4*)(O + ro + bj * 128) = w; } }
    }
};
template <bool SECOND> struct EpiBr {
    static constexpr bool PERM = true, AFTER_DRAIN = false;
    const bf16* P; int gcol; float* M1; bf16* Mo;
    __device__ __forceinline__ void operator()(const pg8::f32x4 (&acc)[2][2][4][2], const pg8::Unit& u, int wr, int wc, int fr, int fq) const {
        const int row0 = u.pm * 256 + wr * 64 + fr, col0 = u.pn * 256 + wc * 32 + 8 * fq;
#pragma unroll
        for (int ai = 0; ai < 2; ++ai)
#pragma unroll
            for (int m = 0; m < 4; ++m) { const size_t row = (size_t)(row0 + ai * 128 + m * 16);
#pragma unroll
                for (int bj = 0; bj < 2; ++bj) { const pg8::f32x4 v0 = acc[ai][bj][m][0], v1 = acc[ai][bj][m][1];
                    const int col = col0 + bj * 128;
                    const u32x4 gq = *(const u32x4*)(P + row * NPAD + gcol + col);
                    f32x4 r0, r1;
                    r0[0] = sigmoidf_(bflo(gq.x)) * v0[0]; r0[1] = sigmoidf_(bfhi(gq.x)) * v0[1]; r0[2] = sigmoidf_(bflo(gq.y)) * v0[2]; r0[3] = sigmoidf_(bfhi(gq.y)) * v0[3];
                    r1[0] = sigmoidf_(bflo(gq.z)) * v1[0]; r1[1] = sigmoidf_(bfhi(gq.z)) * v1[1]; r1[2] = sigmoidf_(bflo(gq.w)) * v1[2]; r1[3] = sigmoidf_(bfhi(gq.w)) * v1[3];
                    float* mp = M1 + row * DM + col;
                    if (!SECOND) { *(f32x4*)mp = r0; *(f32x4*)(mp + 4) = r1; }
                    else { const f32x4 a0 = *(const f32x4*)mp, a1 = *(const f32x4*)(mp + 4); r0 += a0; r1 += a1;
                        u32x4 w; w.x = pk2(r0[0], r0[1]); w.y = pk2(r0[2], r0[3]); w.z = pk2(r1[0], r1[1]); w.w = pk2(r1[2], r1[3]);
                        *(u32x4*)(Mo + row * DM + col) = w; } }
                asm volatile("" ::: "memory"); }
    }
};
struct EpiSwiglu {
    static constexpr bool PERM = true, AFTER_DRAIN = false;
    bf16* O;
    __device__ __forceinline__ void operator()(const pg8::f32x4 (&acc)[2][2][4][2], const pg8::Unit& u, int wr, int wc, int fr, int fq) const {
        const int row0 = u.pm * 256 + wr * 64 + fr, col0 = (u.pn & 3) * 128 + wc * 32 + 8 * fq;
#pragma unroll
        for (int ai = 0; ai < 2; ++ai)
#pragma unroll
            for (int m = 0; m < 4; ++m) { bf16* rowp = O + (size_t)(row0 + ai * 128 + m * 16) * EDIM + col0;
                const pg8::f32x4 g0 = acc[ai][0][m][0], g1 = acc[ai][0][m][1], u0 = acc[ai][1][m][0], u1 = acc[ai][1][m][1];
                u32x4 w; w.x = pk2(siluf_(g0[0]) * u0[0], siluf_(g0[1]) * u0[1]); w.y = pk2(siluf_(g0[2]) * u0[2], siluf_(g0[3]) * u0[3]);
                w.z = pk2(siluf_(g1[0]) * u1[0], siluf_(g1[1]) * u1[1]); w.w = pk2(siluf_(g1[2]) * u1[2], siluf_(g1[3]) * u1[3]);
                *(u32x4*)rowp = w; }
    }
};

__device__ __forceinline__ const float* xrow_ptr(const unsigned char* ws, int layer, int t) {
    if (layer == 0) return t < TC ? inp(I_CTX) + (size_t)t * DM : inp(I_X) + (size_t)(t - TC) * DM;
    return (const float*)(ws + WS_X) + (size_t)t * DM;
}
__device__ __forceinline__ int mods_row(int t) { return t < TC ? 4 : (t - TC) / SEQ; }
__device__ __forceinline__ void tr_item(const float* src, size_t ld, bf16* dst, int K, LAS float* scr, int lane) {
#pragma unroll 8
    for (int i = 0; i < 32; ++i) { const int kk = 2 * i + (lane >> 5); scr[kk * 33 + (lane & 31)] = src[(size_t)kk * ld + (lane & 31)]; }
    LDS_WAIT();
    const int c = lane & 7;
#pragma unroll
    for (int j = 0; j < 4; ++j) { const int n = (lane >> 3) + 8 * j; const LAS float* s = scr + (8 * c) * 33 + n;
        u32x4 o; o.x = pk2(s[0 * 33], s[1 * 33]); o.y = pk2(s[2 * 33], s[3 * 33]); o.z = pk2(s[4 * 33], s[5 * 33]); o.w = pk2(s[6 * 33], s[7 * 33]);
        *(u32x4*)(dst + (size_t)n * K + 8 * c) = o; }
    LDS_WAIT();
}

__device__ __forceinline__ void ph_pre(const Args& A, const Frame& F, int layer) {
    unsigned char* ws = A.ws; asm volatile("" : "+s"(ws));
    if (layer == 0) {
        LAS float* sil = (LAS float*)F.lds;
        for (int i = F.tid; i < 5 * DM; i += 512) { const int r = i / DM, k = i % DM; const float c = (r < 4) ? inp(I_C)[r * DM + k] : inp(I_CCTX)[k]; sil[i] = c / (1.f + expf(-c)); }
        __syncthreads();
        float* mods = (float*)(ws + WS_MODS);
        LAS float* part = (LAS float*)(F.lds + 5 * DM * 4);
        for (int it = F.vcu; it < NLAYER * 96; it += F.G) {
            const int l = it / 96, nb = it % 96;
            const float* W = inp(I_WMOD) + (size_t)l * DM * MODW + (size_t)(F.wave * 256) * MODW + nb * 128 + F.lane * 2;
            f32x2 acc[5];
#pragma unroll
            for (int r = 0; r < 5; ++r) acc[r] = (f32x2){0.f, 0.f};
#pragma unroll 8
            for (int k = 0; k < 256; ++k) { const f32x2 w = *(const f32x2*)(W + (size_t)k * MODW);
#pragma unroll
                for (int r = 0; r < 5; ++r) acc[r] += sil[r * DM + F.wave * 256 + k] * w; }
#pragma unroll
            for (int r = 0; r < 5; ++r) *(LAS f32x2*)(part + (F.wave * 5 + r) * 128 + F.lane * 2) = acc[r];
            __syncthreads();
            for (int o = F.tid; o < 5 * 128; o += 512) { const int r = o / 128, c = o % 128; float sum = inp(I_BMOD)[(size_t)l * MODW + nb * 128 + c];
#pragma unroll
                for (int w8 = 0; w8 < 8; ++w8) sum += part[(w8 * 5 + r) * 128 + c];
                mods[((size_t)l * 5 + r) * MODW + nb * 128 + c] = sum; }
            __syncthreads();
        }
        __syncthreads();
    }
    LAS float* scr = (LAS float*)(F.lds + F.wave * 16384);
    bf16* Wb = (bf16*)(ws + WS_W);
    constexpr int S_IN = 296 * 32, S_GLU = 512, S_BR = 1024, S_OUT = 2048, S_GU = NEX * 1024, S_DN = NEX * 512;
    constexpr int NITEMS = S_IN + S_GLU + 2 * S_BR + S_OUT + S_GU + S_DN;
    for (int it = F.gw; it < NITEMS; it += F.NGW) {
        int r = it;
        if (r < S_IN) {
            const int kb = r / 296, nb = r % 296, n0 = nb * 32, k0 = kb * 64;
            bf16* dst = Wb + WO_IN / 2 + (size_t)n0 * DM + k0;
            if (n0 >= 9248) { const int c = F.lane & 7;
#pragma unroll
                for (int j = 0; j < 4; ++j) { const int n = (F.lane >> 3) + 8 * j; *(u32x4*)(dst + (size_t)n * DM + 8 * c) = (u32x4){0u, 0u, 0u, 0u}; } }
            else { const int no = n0 < 5120 ? n0 : (n0 < 9216 ? n0 + 32 : n0 - 9216 + 5120);
                tr_item(inp(I_WIN) + (size_t)layer * DM * 9248 + (size_t)k0 * 9248 + no, 9248, dst, DM, scr, F.lane); }
            continue; }
        r -= S_IN;
        if (r < S_GLU) { const int kb = r / 32, nb = r % 32;
            tr_item(inp(I_WGLU) + (size_t)layer * 1024 * 1024 + (size_t)(kb * 64) * 1024 + nb * 32, 1024, Wb + WO_GLU / 2 + (size_t)(nb * 32) * 1024 + kb * 64, 1024, scr, F.lane); continue; }
        r -= S_GLU;
        if (r < 2 * S_BR) { const int which = r / S_BR, rr = r % S_BR, kb = rr / 64, nb = rr % 64;
            const float* src = inp(which ? I_WBRD : I_WBRS) + (size_t)layer * 1024 * DM + (size_t)(kb * 64) * DM + nb * 32;
            tr_item(src, DM, Wb + (which ? WO_BRD : WO_BRS) / 2 + (size_t)(nb * 32) * 1024 + kb * 64, 1024, scr, F.lane); continue; }
        r -= 2 * S_BR;
        if (r < S_OUT) { const int kb = r / 64, nb = r % 64;
            tr_item(inp(I_WOUT) + (size_t)layer * DM * DM + (size_t)(kb * 64) * DM + nb * 32, DM, Wb + WO_OUT / 2 + (size_t)(nb * 32) * DM + kb * 64, DM, scr, F.lane); continue; }
        r -= S_OUT;
        if (r < S_GU) { const int e = r / 1024, rr = r % 1024, kb = rr / 32, nb = rr % 32, nd0 = nb * 32;
            const int pn = nd0 / 256, half = (nd0 % 256) / 128, j0 = pn * 128 + (nd0 % 128);
            const float* base = (e < NE) ? (inp(half ? I_MUP : I_MGATE) + ((size_t)layer * NE + e) * DM * EDIM) : (inp(half ? I_SUP : I_SGATE) + (size_t)layer * DM * EDIM);
            tr_item(base + (size_t)(kb * 64) * EDIM + j0, EDIM, Wb + WO_GU / 2 + ((size_t)e * 1024 + nd0) * DM + kb * 64, DM, scr, F.lane); continue; }
        r -= S_GU;
        { const int e = r / 512, rr = r % 512, kb = rr / 64, nb = rr % 64;
            const float* base = (e < NE) ? (inp(I_MDOWN) + ((size_t)layer * NE + e) * EDIM * DM) : (inp(I_SDOWN) + (size_t)layer * EDIM * DM);
            tr_item(base + (size_t)(kb * 64) * DM + nb * 32, DM, Wb + WO_DN / 2 + ((size_t)e * DM + nb * 32) * EDIM + kb * 64, EDIM, scr, F.lane); }
    }
}

__device__ __forceinline__ void ph_n1(const Args& A, const Frame& F, int layer) {
    unsigned char* ws = A.ws; asm volatile("" : "+s"(ws));
    const float* mods = (const float*)(ws + WS_MODS) + (size_t)layer * 5 * MODW;
    const float* nw = inp(I_NMPRE) + (size_t)layer * DM;
    bf16* ab = (bf16*)(ws + WS_AB);
    for (int t = F.gw; t < TT; t += F.NGW) {
        const f32x4* xr = (const f32x4*)xrow_ptr(ws, layer, t) + F.lane;
        f32x4 v[8]; float ss = 0.f;
#pragma unroll
        for (int j = 0; j < 8; ++j) { v[j] = xr[64 * j]; ss += (v[j].x * v[j].x + v[j].y * v[j].y) + (v[j].z * v[j].z + v[j].w * v[j].w); }
        const float r = rsqrtf(wave_sum(ss) * (1.f / DM) + EPS);
        const float* mr = mods + (size_t)mods_row(t) * MODW;
        u32x2* o = (u32x2*)(ab + (size_t)t * DM) + F.lane;
#pragma unroll
        for (int j = 0; j < 8; ++j) { const int col = 4 * (F.lane + 64 * j);
            const f32x4 w = *(const f32x4*)(nw + col), sh = *(const f32x4*)(mr + col), sc = *(const f32x4*)(mr + DM + col);
            const f32x4 y = (v[j] * r * w) * (1.f + sc) + sh;
            u32x2 q; q.x = pk2(y.x, y.y); q.y = pk2(y.z, y.w); o[64 * j] = q; }
    }
}

__device__ __forceinline__ void ph_prep(const Args& A, const Frame& F, int layer) {
    unsigned char* ws = A.ws; asm volatile("" : "+s"(ws));
    const bf16* P = (const bf16*)(ws + WS_B + WB_P);
    bf16* qkv = (bf16*)(ws + WS_B + WB_QKV);
    float* bg = (float*)(ws + WS_B + WB_BG);
    const float* cw = inp(I_CONV) + (size_t)layer * 3 * 3072;
    for (int it = F.gw; it < TT * 8; it += F.NGW) {
        const int t = it >> 3, h = it & 7;
        bool hp, hn;
        if (t < TC) { const int i = t & 255; hp = i > 0; hn = i < 255; } else { const int l = (t - TC) & 2047; hp = l > 0; hn = l < 2047; }
        float val[3][2];
#pragma unroll
        for (int part = 0; part < 3; ++part) {
            const int ch = part * 1024 + h * 128 + 2 * F.lane;
            const bf16* pc = P + (size_t)t * NPAD + PC_QKV + ch;
            const unsigned x0 = *(const unsigned*)pc;
            const unsigned xm = hp ? *(const unsigned*)(pc - NPAD) : 0u;
            const unsigned xp = hn ? *(const unsigned*)(pc + NPAD) : 0u;
            const f32x2 w0 = *(const f32x2*)(cw + ch), w1 = *(const f32x2*)(cw + 3072 + ch), w2 = *(const f32x2*)(cw + 2 * 3072 + ch);
            val[part][0] = siluf_(w0.x * bflo(xm) + w1.x * bflo(x0) + w2.x * bflo(xp));
            val[part][1] = siluf_(w0.y * bfhi(xm) + w1.y * bfhi(x0) + w2.y * bfhi(xp));
        }
        const float qs = rsqrtf(wave_sum(val[0][0] * val[0][0] + val[0][1] * val[0][1]) + EPS) * 0.08838834764831845f;
        const float ks = rsqrtf(wave_sum(val[1][0] * val[1][0] + val[1][1] * val[1][1]) + EPS);
        bf16* o = qkv + (size_t)t * 3072 + h * 128 + 2 * F.lane;
        *(unsigned*)o = pk2(val[0][0] * qs, val[0][1] * qs);
        *(unsigned*)(o + 1024) = pk2(val[1][0] * ks, val[1][1] * ks);
        *(unsigned*)(o + 2048) = pk2(val[2][0], val[2][1]);
        if (h == 0 && F.lane < 32) {
            const int idx = F.lane, kind = idx >> 4, dh = idx & 15;
            const float raw = bf2f(P[(size_t)t * NPAD + PC_BA + idx]);
            float o2;
            if (kind == 0) o2 = 1.f / (1.f + expf(-raw));
            else { const float xx = raw + inp(I_DTB)[layer * 16 + dh]; const float sp = xx > 20.f ? xx : log1pf(expf(xx)); o2 = -expf(inp(I_ALOG)[layer * 16 + dh]) * sp; }
            bg[(size_t)t * 32 + idx] = o2;
        }
    }
}


typedef short bf16x8v __attribute__((ext_vector_type(8)));
typedef unsigned short u16x4v __attribute__((ext_vector_type(4)));
__device__ __forceinline__ int dn_tok(int b, int dir, int s) {
    if (s < CTXL) return b * CTXL + (dir ? (CTXL - 1 - s) : s);
    const int m = s - CTXL; return TC + b * SEQ + (dir ? (SEQ - 1 - m) : m);
}
__device__ __forceinline__ pg8::f32x4 mfma16(bf16x8v a, bf16x8v b, pg8::f32x4 c) { return __builtin_amdgcn_mfma_f32_16x16x32_bf16(a, b, c, 0, 0, 0); }
__device__ __forceinline__ bf16x8v frag_tr(unsigned lds_base, int pitch, int r0, int c0, int lane) {
    const int g = lane >> 4, q = (lane & 15) >> 2, p = lane & 3;
    const unsigned a0 = lds_base + (unsigned)((r0 + 8 * g + q) * pitch + (c0 + 4 * p) * 2);
    u16x4v lo, hi;
    asm volatile("ds_read_b64_tr_b16 %0, %2\n\tds_read_b64_tr_b16 %1, %3\n\ts_waitcnt lgkmcnt(0)" : "=&v"(lo), "=&v"(hi) : "v"(a0), "v"(a0 + 4u * (unsigned)pitch) : "memory");
    bf16x8v r; r[0] = (short)lo[0]; r[1] = (short)lo[1]; r[2] = (short)lo[2]; r[3] = (short)lo[3]; r[4] = (short)hi[0]; r[5] = (short)hi[1]; r[6] = (short)hi[2]; r[7] = (short)hi[3];
    return r;
}
__device__ __forceinline__ void ph_dn_a(const Args& A, const Frame& F, int layer, unsigned char* ws_in) {
    if (F.gw < 512) return;
    const int nw = F.NGW - 512;
    for (int unit = F.gw - 512; unit < DN_UNITS; unit += nw) {
        int lane = F.lane; asm volatile("" : "+v"(lane));
        unsigned char* ws = ws_in; asm volatile("" : "+s"(ws));
        const bf16* qkv = (const bf16*)(ws + WS_B + WB_QKV);
        const float* bg = (const float*)(ws + WS_B + WB_BG);
        unsigned char* dnu = ws + WS_B + WB_DNU;
        const int l15 = lane & 15, g4 = lane >> 4;
        LAS unsigned char* wl = F.lds + F.wave * 17408;
        LAS float* XA = (LAS float*)wl;
        LAS unsigned char* XK = wl;
        LAS unsigned char* TL = wl + 8704;
        LAS float* tab = (LAS float*)(wl + 8704 + 8192);
        const int c = unit % 36, dir = (unit / 36) & 1, h = (unit / 72) & 7, b = unit / 576;
        const int ti = dn_tok(b, dir, 64 * c + lane);
        const float beta = bg[(size_t)ti * 32 + dir * 8 + h], gi = bg[(size_t)ti * 32 + 16 + dir * 8 + h];
        float gc = gi;
#pragma unroll
        for (int o = 1; o < 64; o <<= 1) { const float t = __int_as_float(__builtin_amdgcn_ds_bpermute(((lane - o) & 63) << 2, __float_as_int(gc))); if (lane >= o) gc += t; }
        const float glast = __int_as_float(__builtin_amdgcn_readlane(__float_as_int(gc), 63));
        tab[lane] = gc; tab[64 + lane] = beta;
        float* SC = (float*)(dnu + DNU_SC) + (size_t)unit * 256;
        SC[lane] = __expf(gc); SC[64 + lane] = __expf(glast - gc); if (lane == 0) SC[128] = __expf(glast);
        LDS_WAIT();
        bf16x8v KF[4][4];
        int tokr[4];
#pragma unroll
        for (int rt = 0; rt < 4; ++rt) { tokr[rt] = dn_tok(b, dir, 64 * c + 16 * rt + l15);
#pragma unroll
            for (int ks = 0; ks < 4; ++ks) KF[rt][ks] = *(const bf16x8v*)(qkv + (size_t)tokr[rt] * 3072 + 1024 + h * 128 + 32 * ks + 8 * g4); }
        bf16* QKo = (bf16*)(dnu + DNU_QK) + (size_t)unit * 4096;
#pragma unroll
        for (int it = 0; it < 4; ++it) {
            bf16x8v QF[4];
#pragma unroll
            for (int ks = 0; ks < 4; ++ks) QF[ks] = *(const bf16x8v*)(qkv + (size_t)tokr[it] * 3072 + h * 128 + 32 * ks + 8 * g4);
            const int i = 16 * it + l15; const float gci = tab[i];
#pragma unroll
            for (int jt = 0; jt < 4; ++jt) {
                u32x2 w = (u32x2){0u, 0u};
                if (jt <= it) {
                    pg8::f32x4 acc = (pg8::f32x4){0.f, 0.f, 0.f, 0.f};
#pragma unroll
                    for (int ks = 0; ks < 4; ++ks) acc = mfma16(KF[jt][ks], QF[ks], acc);
                    const int j0 = 16 * jt + 4 * g4; const f32x4 gcj = *(const LAS f32x4*)(tab + j0);
                    float v[4];
#pragma unroll
                    for (int r = 0; r < 4; ++r) v[r] = (j0 + r <= i) ? acc[r] * __expf(gci - gcj[r]) : 0.f;
                    w.x = pk2(v[0], v[1]); w.y = pk2(v[2], v[3]);
                }
                *(u32x2*)(QKo + (size_t)i * 64 + 16 * jt + 4 * g4) = w;
            }
            asm volatile("" ::: "memory");
        }
        float Tc[64];
#pragma unroll
        for (int hf = 0; hf < 2; ++hf) {
#pragma unroll
            for (int it2 = 0; it2 < 2; ++it2) { const int it = 2 * hf + it2; const int i = 16 * it + l15; const float gci = tab[i], bi = tab[64 + i];
#pragma unroll
                for (int jt = 0; jt < 4; ++jt) if (jt <= it) {
                    pg8::f32x4 acc = (pg8::f32x4){0.f, 0.f, 0.f, 0.f};
#pragma unroll
                    for (int ks = 0; ks < 4; ++ks) acc = mfma16(KF[jt][ks], KF[it][ks], acc);
                    const int j0 = 16 * jt + 4 * g4; const f32x4 gcj = *(const LAS f32x4*)(tab + j0);
                    f32x4 o;
#pragma unroll
                    for (int r = 0; r < 4; ++r) o[r] = bi * acc[r] * __expf(fminf(gci - gcj[r], 0.f));
                    *(LAS f32x4*)(XA + (16 * it2 + l15) * 68 + j0) = o;
                } }
            LDS_WAIT();
#pragma unroll
            for (int ii = 0; ii < 32; ++ii) { const int i = 32 * hf + ii;
                float t = (i == lane) ? 1.f : 0.f;
#pragma unroll
                for (int q = 0; q < (i + 3) / 4; ++q) { const f32x4 a = *(const LAS f32x4*)(XA + ii * 68 + 4 * q);
#pragma unroll
                    for (int r = 0; r < 4; ++r) if (4 * q + r < i) t -= a[r] * Tc[4 * q + r]; }
                Tc[i] = t; asm volatile("" ::: "memory"); }
            LDS_WAIT();
        }
#pragma unroll
        for (int i = 0; i < 64; ++i) *(LAS bf16*)(TL + i * 128 + lane * 2) = (bf16)f2bf(Tc[i] * beta);
        LDS_WAIT();
        const unsigned xk_addr = (unsigned)(size_t)XK;
        bf16* Wo = (bf16*)(dnu + DNU_W) + (size_t)unit * 8192;
        bf16* KTo = (bf16*)(dnu + DNU_KT) + (size_t)unit * 8192;
        bf16* UTo = (bf16*)(dnu + DNU_UT) + (size_t)unit * 8192;
#pragma unroll
        for (int pass = 0; pass < 2; ++pass) {
#pragma unroll
          for (int chf = 0; chf < 2; ++chf) {
            pg8::f32x4 acc[4][4];
#pragma unroll
            for (int a = 0; a < 4; ++a)
#pragma unroll
                for (int bq = 0; bq < 4; ++bq) acc[a][bq] = (pg8::f32x4){0.f, 0.f, 0.f, 0.f};
#pragma unroll
            for (int ks = 0; ks < 2; ++ks) {
#pragma unroll
                for (int q = 0; q < 8; ++q) { const int n = lane + 64 * q, row = n >> 4, ch = n & 15;
                    const int tk = dn_tok(b, dir, 64 * c + 32 * ks + row);
                    const u32x4 d = *(const u32x4*)(qkv + (size_t)tk * 3072 + (pass ? 2048 : 1024) + h * 128 + 8 * ch);
                    *(LAS u32x4*)(XK + row * 272 + 16 * ch) = d; }
                LDS_WAIT();
                bf16x8v TF[4];
#pragma unroll
                for (int it = 0; it < 4; ++it) { u32x4 t = *(const LAS u32x4*)(TL + (16 * it + l15) * 128 + (32 * ks + 8 * g4) * 2);
                    if (pass == 0) { const f32x4 g0 = *(const LAS f32x4*)(tab + 32 * ks + 8 * g4), g1 = *(const LAS f32x4*)(tab + 32 * ks + 8 * g4 + 4);
                        t.x = pk2(bflo(t.x) * __expf(g0[0]), bfhi(t.x) * __expf(g0[1])); t.y = pk2(bflo(t.y) * __expf(g0[2]), bfhi(t.y) * __expf(g0[3]));
                        t.z = pk2(bflo(t.z) * __expf(g1[0]), bfhi(t.z) * __expf(g1[1])); t.w = pk2(bflo(t.w) * __expf(g1[2]), bfhi(t.w) * __expf(g1[3])); }
                    TF[it] = __builtin_bit_cast(bf16x8v, t); }
#pragma unroll
                for (int c4 = 0; c4 < 4; ++c4) { const int ct = 4 * chf + c4;
                    const bf16x8v XF = frag_tr(xk_addr, 272, 0, 16 * ct, lane);
                    if (pass == 0) { *(bf16x8v*)(KTo + (size_t)(16 * ct + l15) * 64 + 32 * ks + 8 * g4) = XF;
#pragma unroll
                        for (int it = 0; it < 4; ++it) acc[c4][it] = mfma16(XF, TF[it], acc[c4][it]); }
                    else {
#pragma unroll
                        for (int it = 0; it < 4; ++it) acc[c4][it] = mfma16(TF[it], XF, acc[c4][it]); }
                }
                LDS_WAIT();
            }
#pragma unroll
            for (int c4 = 0; c4 < 4; ++c4)
#pragma unroll
                for (int it = 0; it < 4; ++it) { const int ct = 4 * chf + c4; const pg8::f32x4 a = acc[c4][it]; u32x2 w; w.x = pk2(a[0], a[1]); w.y = pk2(a[2], a[3]);
                    if (pass == 0) *(u32x2*)(Wo + (size_t)(16 * it + l15) * 128 + 16 * ct + 4 * g4) = w;
                    else *(u32x2*)(UTo + (size_t)(16 * ct + l15) * 64 + 16 * it + 4 * g4) = w; }
            asm volatile("" ::: "memory");
          }
        }
    }
}

__device__ __forceinline__ void ph_dn_b(const Args& A, const Frame& F, int layer) {
    unsigned char* ws = A.ws; asm volatile("" : "+s"(ws));
    const bf16* qkv = (const bf16*)(ws + WS_B + WB_QKV);
    const unsigned char* dnu = ws + WS_B + WB_DNU;
    float* obase = (float*)(ws + WS_B + WB_O);
    const int lane = F.lane, l15 = lane & 15, g4 = lane >> 4, w = F.wave, mt = w >> 1, nt = w & 1, kt = w;
    LAS unsigned char* ST = F.lds;
    LAS unsigned char* VN = F.lds + 8704;
    LAS unsigned char* VS = F.lds + 8704 + 4608;
    for (int item = F.vcu; item < 256; item += F.G) {
        const int seq = item >> 2, vd0 = (item & 3) * 32, dir = seq & 1, h = (seq >> 1) & 7, b = seq >> 4;
        float* ob = obase + (size_t)dir * TT * 1024;
        for (int i = F.tid; i < 8704 / 4; i += 512) ((LAS unsigned*)ST)[i] = 0u;
        pg8::f32x4 accS[2]; accS[0] = (pg8::f32x4){0.f, 0.f, 0.f, 0.f}; accS[1] = accS[0];
        __syncthreads();
        bf16x8v WF[4], QF[4], QKF[2], KTF[2]; u32x2 Uc; f32x4 gam, ee; float glast;
        {   const size_t unit = (size_t)seq * 36;
            const int tq = dn_tok(b, dir, 16 * mt + l15);
#pragma unroll
            for (int ks = 0; ks < 4; ++ks) { WF[ks] = *(const bf16x8v*)((const bf16*)(dnu + DNU_W) + unit * 8192 + (size_t)(16 * mt + l15) * 128 + 32 * ks + 8 * g4);
                QF[ks] = *(const bf16x8v*)(qkv + (size_t)tq * 3072 + h * 128 + 32 * ks + 8 * g4); }
#pragma unroll
            for (int ks = 0; ks < 2; ++ks) { QKF[ks] = *(const bf16x8v*)((const bf16*)(dnu + DNU_QK) + unit * 4096 + (size_t)(16 * mt + l15) * 64 + 32 * ks + 8 * g4);
                KTF[ks] = *(const bf16x8v*)((const bf16*)(dnu + DNU_KT) + unit * 8192 + (size_t)(16 * kt + l15) * 64 + 32 * ks + 8 * g4); }
            Uc = *(const u32x2*)((const bf16*)(dnu + DNU_UT) + unit * 8192 + (size_t)(vd0 + 16 * nt + l15) * 64 + 16 * mt + 4 * g4);
            const float* SC = (const float*)(dnu + DNU_SC) + unit * 256;
            gam = *(const f32x4*)(SC + 16 * mt + 4 * g4); ee = *(const f32x4*)(SC + 64 + 16 * mt + 4 * g4); glast = SC[128]; }
        for (int c = 0; c < 36; ++c) {
            bf16x8v cW[4], cQ[4], cQK[2], cKT[2]; const u32x2 cU = Uc; const f32x4 cgam = gam, cee = ee; const float cgl = glast;
#pragma unroll
            for (int ks = 0; ks < 4; ++ks) { cW[ks] = WF[ks]; cQ[ks] = QF[ks]; }
#pragma unroll
            for (int ks = 0; ks < 2; ++ks) { cQK[ks] = QKF[ks]; cKT[ks] = KTF[ks]; }
            if (c + 1 < 36) { const size_t unit = (size_t)seq * 36 + c + 1;
                const int tq = dn_tok(b, dir, 64 * (c + 1) + 16 * mt + l15);
#pragma unroll
                for (int ks = 0; ks < 4; ++ks) { WF[ks] = *(const bf16x8v*)((const bf16*)(dnu + DNU_W) + unit * 8192 + (size_t)(16 * mt + l15) * 128 + 32 * ks + 8 * g4);
                    QF[ks] = *(const bf16x8v*)(qkv + (size_t)tq * 3072 + h * 128 + 32 * ks + 8 * g4); }
#pragma unroll
                for (int ks = 0; ks < 2; ++ks) { QKF[ks] = *(const bf16x8v*)((const bf16*)(dnu + DNU_QK) + unit * 4096 + (size_t)(16 * mt + l15) * 64 + 32 * ks + 8 * g4);
                    KTF[ks] = *(const bf16x8v*)((const bf16*)(dnu + DNU_KT) + unit * 8192 + (size_t)(16 * kt + l15) * 64 + 32 * ks + 8 * g4); }
                Uc = *(const u32x2*)((const bf16*)(dnu + DNU_UT) + unit * 8192 + (size_t)(vd0 + 16 * nt + l15) * 64 + 16 * mt + 4 * g4);
                const float* SC = (const float*)(dnu + DNU_SC) + unit * 256;
                gam = *(const f32x4*)(SC + 16 * mt + 4 * g4); ee = *(const f32x4*)(SC + 64 + 16 * mt + 4 * g4); glast = SC[128]; }
            pg8::f32x4 P = (pg8::f32x4){0.f, 0.f, 0.f, 0.f}, O1 = P;
#pragma unroll
            for (int ks = 0; ks < 4; ++ks) { const bf16x8v SF = *(const LAS bf16x8v*)(ST + (16 * nt + l15) * 272 + (32 * ks + 8 * g4) * 2);
                P = mfma16(cW[ks], SF, P); O1 = mfma16(cQ[ks], SF, O1); }
            float vn[4];
            vn[0] = bflo(cU.x) - P[0]; vn[1] = bfhi(cU.x) - P[1]; vn[2] = bflo(cU.y) - P[2]; vn[3] = bfhi(cU.y) - P[3];
            { u32x2 a; a.x = pk2(vn[0], vn[1]); a.y = pk2(vn[2], vn[3]); *(LAS u32x2*)(VN + (16 * nt + l15) * 144 + (16 * mt + 4 * g4) * 2) = a;
              u32x2 e; e.x = pk2(vn[0] * cee[0], vn[1] * cee[1]); e.y = pk2(vn[2] * cee[2], vn[3] * cee[3]); *(LAS u32x2*)(VS + (16 * nt + l15) * 144 + (16 * mt + 4 * g4) * 2) = e; }
            __syncthreads();
            pg8::f32x4 O2 = (pg8::f32x4){0.f, 0.f, 0.f, 0.f};
#pragma unroll
            for (int ks = 0; ks < 2; ++ks) { const bf16x8v VF = *(const LAS bf16x8v*)(VN + (16 * nt + l15) * 144 + (32 * ks + 8 * g4) * 2); O2 = mfma16(cQK[ks], VF, O2); }
#pragma unroll
            for (int r = 0; r < 4; ++r) { const int tk = dn_tok(b, dir, 64 * c + 16 * mt + 4 * g4 + r); ob[(size_t)tk * 1024 + h * 128 + vd0 + 16 * nt + l15] = cgam[r] * O1[r] + O2[r]; }
#pragma unroll
            for (int n2 = 0; n2 < 2; ++n2) { pg8::f32x4 a = accS[n2] * cgl;
#pragma unroll
                for (int ks = 0; ks < 2; ++ks) { const bf16x8v VF = *(const LAS bf16x8v*)(VS + (16 * n2 + l15) * 144 + (32 * ks + 8 * g4) * 2); a = mfma16(cKT[ks], VF, a); }
                accS[n2] = a;
                u32x2 sw; sw.x = pk2(a[0], a[1]); sw.y = pk2(a[2], a[3]); *(LAS u32x2*)(ST + (16 * n2 + l15) * 272 + (16 * kt + 4 * g4) * 2) = sw; }
            __syncthreads();
        }
    }
}

__device__ __forceinline__ int s5_tok(int b, int dir, int s) {
    if (s < CTXL) return b * CTXL + (dir ? (CTXL - 1 - s) : s);
    const int m = s - CTXL, cm = dir ? (SEQ - 1 - m) : m, col = cm >> 5, row = cm & 31;
    return TC + b * SEQ + row * 64 + col;
}
__device__ __forceinline__ void ph_scan(const Args& A, const Frame& F, int layer) {
    unsigned char* ws = A.ws; asm volatile("" : "+s"(ws));
    const bf16* P = (const bf16*)(ws + WS_B + WB_P);
#ifndef NO_S5
    if (F.gw < 512) {
        const int dir = F.gw & 1, g = (F.gw >> 1) & 63, b = F.gw >> 7, p = F.lane;
        const size_t pg = (size_t)(layer * 2 + dir) * 64 + g;
        const float lr = inp(I_LAMRE)[pg * 64 + p], li = inp(I_LAMIM)[pg * 64 + p], step = expf(inp(I_LOGSTEP)[pg]);
        const float mag = expf(lr * step), abr = mag * cosf(li * step), abi = mag * sinf(li * step);
        const float den = lr * lr + li * li, nr = abr - 1.f, cr = (nr * lr + abi * li) / den, ci = (abi * lr - nr * li) / den;
        float bbr[16], bbi[16], cre[16], cim[16];
#pragma unroll
        for (int j = 0; j < 16; ++j) { const float br = inp(I_BRE)[(pg * 64 + p) * 16 + j], bi = inp(I_BIM)[(pg * 64 + p) * 16 + j];
            bbr[j] = cr * br - ci * bi; bbi[j] = cr * bi + ci * br;
            cre[j] = inp(I_CRE)[(pg * 16 + j) * 64 + p]; cim[j] = inp(I_CIM)[(pg * 16 + j) * 64 + p]; }
        float* yb = (float*)(ws + WS_B + WB_Y) + (size_t)dir * TT * 1024;
        LAS u32x4* ust = (LAS u32x4*)(F.lds + F.wave * 2048);
        float hr = 0.f, hi = 0.f;
        u32x4 nx = *(const u32x4*)(P + (size_t)s5_tok(b, dir, F.lane >> 1) * NPAD + g * 16 + (F.lane & 1) * 8);
        for (int blk = 0; blk < 72; ++blk) {
            const int buf = blk & 1;
            ust[buf * 64 + F.lane] = nx;
            if (blk + 1 < 72) nx = *(const u32x4*)(P + (size_t)s5_tok(b, dir, (blk + 1) * 32 + (F.lane >> 1)) * NPAD + g * 16 + (F.lane & 1) * 8);
            LDS_WAIT();
            for (int ss = 0; ss < 32; ++ss) {
                const u32x4 ua = ust[buf * 64 + ss * 2], ub = ust[buf * 64 + ss * 2 + 1];
                float u[16];
                u[0] = bflo(ua.x); u[1] = bfhi(ua.x); u[2] = bflo(ua.y); u[3] = bfhi(ua.y); u[4] = bflo(ua.z); u[5] = bfhi(ua.z); u[6] = bflo(ua.w); u[7] = bfhi(ua.w);
                u[8] = bflo(ub.x); u[9] = bfhi(ub.x); u[10] = bflo(ub.y); u[11] = bfhi(ub.y); u[12] = bflo(ub.z); u[13] = bfhi(ub.z); u[14] = bflo(ub.w); u[15] = bfhi(ub.w);
                float bur = 0.f, bui = 0.f;
#pragma unroll
                for (int j = 0; j < 16; ++j) { bur += bbr[j] * u[j]; bui += bbi[j] * u[j]; }
                const float nhr = abr * hr - abi * hi + bur, nhi = abr * hi + abi * hr + bui;
                hr = nhr; hi = nhi;
                float z[16];
#pragma unroll
                for (int j = 0; j < 16; ++j) z[j] = cre[j] * hr - cim[j] * hi;
                const bool b5 = F.lane & 32, b4 = F.lane & 16, b3 = F.lane & 8, b2 = F.lane & 4;
                float a8[8], a4[4], a2[2];
#pragma unroll
                for (int j = 0; j < 8; ++j) { const float keep = b5 ? z[j + 8] : z[j], send = b5 ? z[j] : z[j + 8]; a8[j] = keep + __shfl_xor(send, 32); }
#pragma unroll
                for (int j = 0; j < 4; ++j) { const float keep = b4 ? a8[j + 4] : a8[j], send = b4 ? a8[j] : a8[j + 4]; a4[j] = keep + __shfl_xor(send, 16); }
#pragma unroll
                for (int j = 0; j < 2; ++j) { const float keep = b3 ? a4[j + 2] : a4[j], send = b3 ? a4[j] : a4[j + 2]; a2[j] = keep + __shfl_xor(send, 8); }
                float a1 = (b2 ? a2[1] : a2[0]) + __shfl_xor(b2 ? a2[0] : a2[1], 4);
                a1 += __shfl_xor(a1, 2); a1 += __shfl_xor(a1, 1);
                if ((F.lane & 3) == 0) yb[(size_t)s5_tok(b, dir, blk * 32 + ss) * 1024 + g * 16 + (F.lane >> 2)] = a1;
            }
        }
    }
#endif
    ph_dn_a(A, F, layer, ws);
}

__device__ __forceinline__ void ph_post(const Args& A, const Frame& F, int layer) {
    unsigned char* ws = A.ws; asm volatile("" : "+s"(ws));
    const bf16* P = (const bf16*)(ws + WS_B + WB_P);
    const float* yb = (const float*)(ws + WS_B + WB_Y);
    const float* ob = (const float*)(ws + WS_B + WB_O);
    bf16* gb = (bf16*)(ws + WS_B + WB_G);
    bf16* dno = (bf16*)(ws + WS_B + WB_DNO);
    const int c0 = 16 * F.lane;
    for (int t = F.gw; t < TT; t += F.NGW) {
        {
            const u32x4 ua = *(const u32x4*)(P + (size_t)t * NPAD + PC_U + c0), ub = *(const u32x4*)(P + (size_t)t * NPAD + PC_U + c0 + 8);
            float u[16];
            u[0] = bflo(ua.x); u[1] = bfhi(ua.x); u[2] = bflo(ua.y); u[3] = bfhi(ua.y); u[4] = bflo(ua.z); u[5] = bfhi(ua.z); u[6] = bflo(ua.w); u[7] = bfhi(ua.w);
            u[8] = bflo(ub.x); u[9] = bfhi(ub.x); u[10] = bflo(ub.y); u[11] = bfhi(ub.y); u[12] = bflo(ub.z); u[13] = bfhi(ub.z); u[14] = bflo(ub.w); u[15] = bfhi(ub.w);
            float gg[16];
#pragma unroll
            for (int q = 0; q < 4; ++q) { const f32x4 y0 = *(const f32x4*)(yb + (size_t)t * 1024 + c0 + 4 * q), y1 = *(const f32x4*)(yb + (size_t)(TT + t) * 1024 + c0 + 4 * q);
                const f32x4 d = *(const f32x4*)(inp(I_S5D) + (size_t)layer * 1024 + c0 + 4 * q);
#pragma unroll
                for (int j = 0; j < 4; ++j) gg[4 * q + j] = gelu_tanh(d[j] * u[4 * q + j] + y0[j] + y1[j]); }
            u32x4 w0, w1;
            w0.x = pk2(gg[0], gg[1]); w0.y = pk2(gg[2], gg[3]); w0.z = pk2(gg[4], gg[5]); w0.w = pk2(gg[6], gg[7]);
            w1.x = pk2(gg[8], gg[9]); w1.y = pk2(gg[10], gg[11]); w1.z = pk2(gg[12], gg[13]); w1.w = pk2(gg[14], gg[15]);
            *(u32x4*)(gb + (size_t)t * 1024 + c0) = w0; *(u32x4*)(gb + (size_t)t * 1024 + c0 + 8) = w1;
        }
        {
            float o[16]; float ss = 0.f;
#pragma unroll
            for (int q = 0; q < 4; ++q) { const f32x4 a = *(const f32x4*)(ob + (size_t)t * 1024 + c0 + 4 * q), bq = *(const f32x4*)(ob + (size_t)(TT + t) * 1024 + c0 + 4 * q);
#pragma unroll
                for (int j = 0; j < 4; ++j) { o[4 * q + j] = a[j] + bq[j]; ss += o[4 * q + j] * o[4 * q + j]; } }
            ss += __shfl_xor(ss, 1); ss += __shfl_xor(ss, 2); ss += __shfl_xor(ss, 4);
            const float r = rsqrtf(ss * (1.f / 128.f) + EPS);
            const u32x4 za = *(const u32x4*)(P + (size_t)t * NPAD + PC_Z + c0), zb = *(const u32x4*)(P + (size_t)t * NPAD + PC_Z + c0 + 8);
            float z[16];
            z[0] = bflo(za.x); z[1] = bfhi(za.x); z[2] = bflo(za.y); z[3] = bfhi(za.y); z[4] = bflo(za.z); z[5] = bfhi(za.z); z[6] = bflo(za.w); z[7] = bfhi(za.w);
            z[8] = bflo(zb.x); z[9] = bfhi(zb.x); z[10] = bflo(zb.y); z[11] = bfhi(zb.y); z[12] = bflo(zb.z); z[13] = bfhi(zb.z); z[14] = bflo(zb.w); z[15] = bfhi(zb.w);
            const float* nw = inp(I_DNNORM) + (size_t)layer * 128 + (c0 & 127);
            float e[16];
#pragma unroll
            for (int j = 0; j < 16; ++j) e[j] = o[j] * r * nw[j] * siluf_(z[j]);
            u32x4 w0, w1;
            w0.x = pk2(e[0], e[1]); w0.y = pk2(e[2], e[3]); w0.z = pk2(e[4], e[5]); w0.w = pk2(e[6], e[7]);
            w1.x = pk2(e[8], e[9]); w1.y = pk2(e[10], e[11]); w1.z = pk2(e[12], e[13]); w1.w = pk2(e[14], e[15]);
            *(u32x4*)(dno + (size_t)t * 1024 + c0) = w0; *(u32x4*)(dno + (size_t)t * 1024 + c0 + 8) = w1;
        }
    }
}

__device__ __forceinline__ void ph_row2(const Args& A, const Frame& F, int layer) {
    unsigned char* ws = A.ws; asm volatile("" : "+s"(ws));
    const float* mods = (const float*)(ws + WS_MODS) + (size_t)layer * 5 * MODW;
    const float* mix = (const float*)(ws + WS_B + WB_MIX);
    float* xc = (float*)(ws + WS_X);
    bf16* hb = (bf16*)(ws + WS_AB);
    const float* nwp = inp(I_NMPOST) + (size_t)layer * DM;
    const float* nwf = inp(I_NFPRE) + (size_t)layer * DM;
    const float* wr = inp(I_ROUTER) + (size_t)layer * DM * NE;
    int* eidx = (int*)(ws + WS_EIDX); float* wts = (float*)(ws + WS_WTS);
    unsigned* cnt = (unsigned*)(ws + WS_CTL) + CW_CNT + layer * 128;
    LAS float* hrow = (LAS float*)(F.lds + F.wave * 8192);
    const float ebias = inp(I_MBIAS)[layer * NE + F.lane];
    for (int t = F.gw; t < TT; t += F.NGW) {
        const f32x4* mr4 = (const f32x4*)(mix + (size_t)t * DM) + F.lane;
        const f32x4* xr4 = (const f32x4*)xrow_ptr(ws, layer, t) + F.lane;
        const float* mrow = mods + (size_t)mods_row(t) * MODW;
        f32x4 v[8]; float ss = 0.f;
#pragma unroll
        for (int j = 0; j < 8; ++j) { v[j] = mr4[64 * j]; ss += (v[j].x * v[j].x + v[j].y * v[j].y) + (v[j].z * v[j].z + v[j].w * v[j].w); }
        const float r = rsqrtf(wave_sum(ss) * (1.f / DM) + EPS);
        float ss2 = 0.f;
#pragma unroll
        for (int j = 0; j < 8; ++j) { const int col = 4 * (F.lane + 64 * j);
            const f32x4 w = *(const f32x4*)(nwp + col), gt = *(const f32x4*)(mrow + 2 * DM + col), xo = xr4[64 * j];
            v[j] = xo + gt * (v[j] * r * w);
            *((f32x4*)(xc + (size_t)t * DM) + F.lane + 64 * j) = v[j];
            ss2 += (v[j].x * v[j].x + v[j].y * v[j].y) + (v[j].z * v[j].z + v[j].w * v[j].w); }
        const float r2 = rsqrtf(wave_sum(ss2) * (1.f / DM) + EPS);
        u32x2* ho = (u32x2*)(hb + (size_t)t * DM) + F.lane;
#pragma unroll
        for (int j = 0; j < 8; ++j) { const int col = 4 * (F.lane + 64 * j);
            const f32x4 w = *(const f32x4*)(nwf + col), sh = *(const f32x4*)(mrow + 3 * DM + col), sc = *(const f32x4*)(mrow + 4 * DM + col);
            const f32x4 y = (v[j] * r2 * w) * (1.f + sc) + sh;
            u32x2 q; q.x = pk2(y.x, y.y); q.y = pk2(y.z, y.w); ho[64 * j] = q;
            *((LAS f32x4*)hrow + F.lane + 64 * j) = y; }
        LDS_WAIT();
        float logit = 0.f;
#pragma unroll 4
        for (int d4 = 0; d4 < DM / 4; ++d4) { const f32x4 h4 = *((const LAS f32x4*)hrow + d4);
            const float* wp = wr + (size_t)(4 * d4) * NE + F.lane;
            logit += h4.x * wp[0]; logit += h4.y * wp[NE]; logit += h4.z * wp[2 * NE]; logit += h4.w * wp[3 * NE]; }
        const float score = 1.f / (1.f + expf(-logit));
        const float sel = score + ebias;
        float m1 = sel;
        m1 = fmaxf(m1, __shfl_xor(m1, 1)); m1 = fmaxf(m1, __shfl_xor(m1, 2)); m1 = fmaxf(m1, __shfl_xor(m1, 4));
        const unsigned long long eqm = __ballot(sel == m1);
        const int gbase = F.lane & ~7;
        const unsigned gm = (unsigned)((eqm >> gbase) & 0xffull);
        const int amax = gbase + __builtin_ctz(gm);
        float s2 = (F.lane == amax) ? -__builtin_inff() : sel;
        s2 = fmaxf(s2, __shfl_xor(s2, 1)); s2 = fmaxf(s2, __shfl_xor(s2, 2)); s2 = fmaxf(s2, __shfl_xor(s2, 4));
        const float gs = m1 + s2;
        int grank = 0; const int myg = F.lane >> 3;
#pragma unroll
        for (int g2 = 0; g2 < 8; ++g2) { const float og = __shfl(gs, g2 * 8); grank += (og > gs || (og == gs && g2 < myg)) ? 1 : 0; }
        const float selm = (grank < 4) ? sel : -__builtin_inff();
        int rank = 0;
#pragma unroll 8
        for (int e2 = 0; e2 < 64; ++e2) { const float os = __shfl(selm, e2); rank += (os > selm || (os == selm && e2 < F.lane)) ? 1 : 0; }
        const bool chosen = (grank < 4) && (rank < 8);
        const float wsum = wave_sum(chosen ? score : 0.f);
        if (chosen) { eidx[(size_t)t * 8 + rank] = F.lane; wts[(size_t)t * 8 + rank] = score / wsum * 2.5f; atomicAdd(cnt + F.lane, 1u); }
        LDS_WAIT();
    }
}

__device__ __forceinline__ void ph_fill(const Args& A, const Frame& F, int layer) {
    unsigned char* ws = A.ws; asm volatile("" : "+s"(ws));
    unsigned* ctl = (unsigned*)(ws + WS_CTL);
    LAS int* off = (LAS int*)(F.lds);
    LAS int* cn = (LAS int*)(F.lds + 1024);
    if (F.tid < NEX) cn[F.tid] = (F.tid < NE) ? (int)__hip_atomic_load(ctl + CW_CNT + layer * 128 + F.tid, __ATOMIC_RELAXED, __HIP_MEMORY_SCOPE_AGENT) : TT;
    __syncthreads();
    if (F.tid == 0) {
        int o = 0;
        for (int e = 0; e < NEX; ++e) { off[e] = o; o += (cn[e] + 255) & ~255; }
        off[NEX] = o;
    }
    __syncthreads();
    int* misc = (int*)(ws + WS_MISC) + layer * 1024;
    if (blockIdx.x == 0) {
        const int ntiles = off[NEX] >> 8;
        for (int tl = F.tid; tl < ntiles; tl += 512) { int e = 0; for (int q = 0; q < NEX; ++q) if ((off[q] >> 8) <= tl) e = q; misc[tl] = e; }
        if (F.tid == 0) misc[512] = ntiles;
    }
    {
        bf16* hpz = (bf16*)(ws + WS_B + WB_HPERM);
        for (int e = 0; e < NE; ++e) { const int r0 = off[e] + cn[e], r1 = off[e + 1];
            for (int r = r0 + F.gw; r < r1; r += F.NGW) { u32x4* d = (u32x4*)(hpz + (size_t)r * DM) + F.lane;
#pragma unroll
                for (int j = 0; j < 4; ++j) d[64 * j] = (u32x4){0u, 0u, 0u, 0u}; } }
    }
    const int* eidx = (const int*)(ws + WS_EIDX);
    int* slot_of = (int*)(ws + WS_SLOT);
    const bf16* hb = (const bf16*)(ws + WS_AB);
    bf16* hp = (bf16*)(ws + WS_B + WB_HPERM);
    for (int it = F.gw; it < TT * 9; it += F.NGW) {
        const int t = it / 9, k = it % 9;
        int slot;
        if (k < 8) { const int e = eidx[(size_t)t * 8 + k]; int pos = 0;
            if (F.lane == 0) pos = (int)atomicAdd(ctl + CW_FILL + layer * 128 + e, 1u);
            pos = __builtin_amdgcn_readfirstlane(pos); slot = off[e] + pos; }
        else slot = off[NE] + t;
        if (F.lane == 0) slot_of[(size_t)t * 9 + k] = slot;
        const u32x4* s = (const u32x4*)(hb + (size_t)t * DM) + F.lane; u32x4* d = (u32x4*)(hp + (size_t)slot * DM) + F.lane;
#pragma unroll
        for (int j = 0; j < 4; ++j) d[64 * j] = s[64 * j];
    }
}

__device__ __forceinline__ void ph_comb(const Args& A, const Frame& F, int layer) {
    unsigned char* ws = A.ws; asm volatile("" : "+s"(ws));
    const float* mods = (const float*)(ws + WS_MODS) + (size_t)layer * 5 * MODW;
    const bf16* ys = (const bf16*)(ws + WS_B + WB_HPERM);
    const int* slot_of = (const int*)(ws + WS_SLOT);
    const float* wts = (const float*)(ws + WS_WTS);
    float* xc = (float*)(ws + WS_X);
    const float* nw = inp(I_NFPOST) + (size_t)layer * DM;
    const bool last = (layer == NLAYER - 1);
    for (int t = F.gw; t < TT; t += F.NGW) {
        float f[32];
#pragma unroll
        for (int j = 0; j < 32; ++j) f[j] = 0.f;
#pragma unroll
        for (int k = 0; k < 9; ++k) {
            const int slot = slot_of[(size_t)t * 9 + k]; const float w = (k < 8) ? wts[(size_t)t * 8 + k] : 1.f;
            const u32x4* yr = (const u32x4*)(ys + (size_t)slot * DM + 32 * F.lane);
#pragma unroll
            for (int q = 0; q < 4; ++q) { const u32x4 y = yr[q];
                f[8 * q + 0] += w * bflo(y.x); f[8 * q + 1] += w * bfhi(y.x); f[8 * q + 2] += w * bflo(y.y); f[8 * q + 3] += w * bfhi(y.y);
                f[8 * q + 4] += w * bflo(y.z); f[8 * q + 5] += w * bfhi(y.z); f[8 * q + 6] += w * bflo(y.w); f[8 * q + 7] += w * bfhi(y.w); }
            if (k % 3 == 2) asm volatile("" ::: "memory");
        }
        float ss = 0.f;
#pragma unroll
        for (int j = 0; j < 32; ++j) ss += f[j] * f[j];
        const float r = rsqrtf(wave_sum(ss) * (1.f / DM) + EPS);
        const float* mrow = mods + (size_t)mods_row(t) * MODW + 5 * DM;
        const int c0 = 32 * F.lane;
        float* xr = xc + (size_t)t * DM + c0;
#pragma unroll
        for (int q = 0; q < 8; ++q) { const f32x4 w = *(const f32x4*)(nw + c0 + 4 * q), gt = *(const f32x4*)(mrow + c0 + 4 * q), xo = *(const f32x4*)(xr + 4 * q);
            f32x4 y; y.x = xo.x + gt.x * (f[4 * q] * r * w.x); y.y = xo.y + gt.y * (f[4 * q + 1] * r * w.y); y.z = xo.z + gt.z * (f[4 * q + 2] * r * w.z); y.w = xo.w + gt.w * (f[4 * q + 3] * r * w.w);
            if (!last) *(f32x4*)(xr + 4 * q) = y;
            else if (t >= TC) *(f32x4*)(A.out + (size_t)(t - TC) * DM + c0 + 4 * q) = y; }
    }
}

constexpr int NPH = 15;
__device__ __forceinline__ bool ph_in(int lo, int hi, int k) { asm volatile("" : "+s"(lo), "+s"(hi)); return lo <= k && k < hi; }
constexpr int PER_PHASE_LAUNCH = MK_PER_PHASE;
#ifndef DBG_STOP
#define DBG_STOP 0
#endif

#ifndef PHMASK
#define PHMASK 0xFFFF
#endif
#define IN(k) (((PHMASK >> ((k) % NPH)) & 1) && ph_in(lo, hi, (k)))
#define GETWS const Frame F = make_frame(lds, wave_s); unsigned char* ws = args.ws; asm volatile("" : "+s"(ws)); bf16* Wb = (bf16*)(ws + WS_W)
#define SEAM(k) do { if (IN(k) && IN((k) + 1)) xcd_barrier(bar, wave_s); } while (0)
template <int LAYER>
__device__ __forceinline__ void layer_body(const Args& args, LAS unsigned char* lds, const XcdBarrier& bar, int wave_s, int lo, int hi) {
    constexpr int layer = LAYER;
        const int pb = layer * NPH;
        if (IN(pb + 0)) { const Frame F = make_frame(lds, wave_s); ph_pre(args, F, layer); } SEAM(pb + 0);
        if (IN(pb + 1)) { const Frame F = make_frame(lds, wave_s); ph_n1(args, F, layer); } SEAM(pb + 1);
        if (IN(pb + 2)) {
            GETWS;
            pg8::Gemm g{(const pg8::bf16_t*)(ws + WS_AB), Wb + WO_IN / 2, TT, NPAD, DM}; pg8::StaticOrder S; S.init(TT, NPAD, F.G, F.bx);
            EpiBf16Mod E{(bf16*)(ws + WS_B + WB_P), NPAD, 1 << 20};
            pg8::gemm_phase<EpiBf16Mod, pg8::StaticOrder>(F.lds, g, S, E, nullptr, F.tid);
        } SEAM(pb + 2);
        if (IN(pb + 3)) { const Frame F = make_frame(lds, wave_s); ph_prep(args, F, layer); } SEAM(pb + 3);
        if (IN(pb + 4)) { const Frame F = make_frame(lds, wave_s); ph_scan(args, F, layer); } SEAM(pb + 4);
        if (IN(pb + 5)) { const Frame F = make_frame(lds, wave_s); ph_dn_b(args, F, layer); } SEAM(pb + 5);
        if (IN(pb + 6)) { const Frame F = make_frame(lds, wave_s); ph_post(args, F, layer); } SEAM(pb + 6);
        if (IN(pb + 7)) {
            GETWS;
            pg8::Gemm g{(const pg8::bf16_t*)(ws + WS_B + WB_G), Wb + WO_GLU / 2, TT, 1024, 1024}; pg8::StaticOrder S; S.init(TT, 1024, F.G, F.bx);
            EpiGlu E{(const bf16*)(ws + WS_B + WB_G), (bf16*)(ws + WS_B + WB_S5O)};
            pg8::gemm_phase<EpiGlu, pg8::StaticOrder>(F.lds, g, S, E, nullptr, F.tid);
        } SEAM(pb + 7);
        if (IN(pb + 8)) { GETWS;
            { pg8::Gemm g{(const pg8::bf16_t*)(ws + WS_B + WB_S5O), Wb + WO_BRS / 2, TT, DM, 1024}; pg8::StaticOrder S; S.init(TT, DM, F.G, F.bx);
              EpiBr<false> E{(const bf16*)(ws + WS_B + WB_P), PC_GS5, (float*)(ws + WS_B + WB_M1), nullptr};
              pg8::gemm_phase<EpiBr<false>, pg8::StaticOrder>(F.lds, g, S, E, nullptr, F.tid); }
            __syncthreads();
            { pg8::Gemm g{(const pg8::bf16_t*)(ws + WS_B + WB_DNO), Wb + WO_BRD / 2, TT, DM, 1024}; pg8::StaticOrder S; S.init(TT, DM, F.G, F.bx);
              EpiBr<true> E{(const bf16*)(ws + WS_B + WB_P), PC_GDN, (float*)(ws + WS_B + WB_M1), (bf16*)(ws + WS_B + WB_M)};
              pg8::gemm_phase<EpiBr<true>, pg8::StaticOrder>(F.lds, g, S, E, nullptr, F.tid); }
        } SEAM(pb + 8);
        if (IN(pb + 9)) {
            GETWS;
            pg8::Gemm g{(const pg8::bf16_t*)(ws + WS_B + WB_M), Wb + WO_OUT / 2, TT, DM, DM}; pg8::StaticOrder S; S.init(TT, DM, F.G, F.bx);
            pg8::EpiF32 E{(float*)(ws + WS_B + WB_MIX), DM, nullptr};
            pg8::gemm_phase<pg8::EpiF32, pg8::StaticOrder>(F.lds, g, S, E, nullptr, F.tid);
        } SEAM(pb + 9);
        if (IN(pb + 10)) { const Frame F = make_frame(lds, wave_s); ph_row2(args, F, layer); } SEAM(pb + 10);
        if (IN(pb + 11)) { const Frame F = make_frame(lds, wave_s); ph_fill(args, F, layer); } SEAM(pb + 11);
        if (IN(pb + 12)) {
            GETWS;
            const int* misc = (const int*)(ws + WS_MISC) + layer * 1024;
            const int ntiles = __builtin_amdgcn_readfirstlane((int)__hip_atomic_load(misc + 512, __ATOMIC_RELAXED, __HIP_MEMORY_SCOPE_AGENT));
            pg8::Gemm g{(const pg8::bf16_t*)(ws + WS_B + WB_HPERM), Wb + WO_GU / 2, ntiles * 256, 1024, DM}; MoeOrder S{ntiles, 4, F.G, F.bx, misc};
            EpiSwiglu E{(bf16*)(ws + WS_B + WB_ACT)};
            pg8::gemm_phase<EpiSwiglu, MoeOrder>(F.lds, g, S, E, nullptr, F.tid);
        } SEAM(pb + 12);
        if (IN(pb + 13)) {
            GETWS;
            const int* misc = (const int*)(ws + WS_MISC) + layer * 1024;
            const int ntiles = __builtin_amdgcn_readfirstlane((int)__hip_atomic_load(misc + 512, __ATOMIC_RELAXED, __HIP_MEMORY_SCOPE_AGENT));
            pg8::Gemm g{(const pg8::bf16_t*)(ws + WS_B + WB_ACT), Wb + WO_DN / 2, ntiles * 256, DM, EDIM}; MoeOrder S{ntiles, 8, F.G, F.bx, misc};
            EpiBf16Mod E{(bf16*)(ws + WS_B + WB_HPERM), DM, 8};
            pg8::gemm_phase<EpiBf16Mod, MoeOrder>(F.lds, g, S, E, nullptr, F.tid);
        } SEAM(pb + 13);
        if (IN(pb + 14)) { const Frame F = make_frame(lds, wave_s); ph_comb(args, F, layer); } SEAM(pb + 14);
    }

__global__ void __launch_bounds__(512, 2) hybrid_fwd(Args args) {
    extern __shared__ __attribute__((aligned(16))) unsigned char lds_raw[];
    LAS unsigned char* const lds = (LAS unsigned char*)lds_raw;
    volatile LAS unsigned* MISC = (volatile LAS unsigned*)(lds + LDS_MISC);
    const int wave_s = __builtin_amdgcn_readfirstlane((int)(threadIdx.x >> 6));
    if (threadIdx.x < 4) MISC[threadIdx.x] = 0u;
    __syncthreads();
    unsigned* ctl = (unsigned*)(args.ws + WS_CTL);
    XcdBarrier bar; bar.bar = ctl + CW_BAR; bar.x = 0; bar.st = nullptr;
    if (!PER_PHASE_LAUNCH) { bar.bar = ctl + CW_BAR; bar.x = xb_xcc_id(); bar.st = MISC; if (threadIdx.x == 0) (void)xb_add(&bar.bar[XB_XCNT(bar.x)], 1u); }
    const int lo = args.ph_lo, hi = args.ph_hi;
    layer_body<0>(args, lds, bar, wave_s, lo, hi);
    layer_body<1>(args, lds, bar, wave_s, lo, hi);
    if (DBG_STOP && lo == 1000) {
        const float* xc = (const float*)(args.ws + WS_X) + (size_t)TC * DM;
        for (size_t i = (size_t)blockIdx.x * 512 + threadIdx.x; i < (size_t)TL * DM / 4; i += (size_t)gridDim.x * 512) ((f32x4*)args.out)[i] = ((const f32x4*)xc)[i];
    }
#undef IN
#undef SEAM
}

extern "C" void kernel_launch(void* const* d_in, const int* in_sizes, int n_in, void* d_out, int out_size, void* d_ws, size_t ws_size, hipStream_t stream) {
    static int grid = 0;
    if (grid == 0) {
        if (n_in != 35 || out_size != TL * DM || ws_size < WS_END) { fprintf(stderr, "kernel_launch: unexpected shapes (n_in %d out %d ws %zu need %zu)\n", n_in, out_size, ws_size, (size_t)WS_END); grid = -1; return; }
        int dev = 0, cus = 0;
        if (hipGetDevice(&dev) != hipSuccess || hipDeviceGetAttribute(&cus, hipDeviceAttributeMultiprocessorCount, dev) != hipSuccess) { grid = -1; return; }
        if (hipFuncSetAttribute((const void*)hybrid_fwd, hipFuncAttributeMaxDynamicSharedMemorySize, LDS_BYTES) != hipSuccess) { grid = -1; return; }
        int per_cu = 0;
        (void)hipOccupancyMaxActiveBlocksPerMultiprocessor(&per_cu, (const void*)hybrid_fwd, 512, LDS_BYTES);
        (void)hipGetLastError();
        if (per_cu < 1) { fprintf(stderr, "kernel_launch: occupancy query says %d blocks per CU\n", per_cu); }
        grid = cus;
    }
    if (grid < 0) return;
    (void)hipMemsetAsync((char*)d_ws + WS_CTL, 0, CTL_ZERO_BYTES, stream);
    Args a{};
    for (int i = 0; i < 35; ++i) a.in[i] = (const float*)d_in[i];
    a.out = (float*)d_out; a.ws = (unsigned char*)d_ws;
    if (PER_PHASE_LAUNCH) {
        for (int ph = 0; ph < (DBG_STOP ? DBG_STOP : NLAYER * NPH); ++ph) { a.ph_lo = ph; a.ph_hi = ph + 1; hipLaunchKernelGGL(hybrid_fwd, dim3(grid), dim3(512), LDS_BYTES, stream, a); }
        if (DBG_STOP) { a.ph_lo = 1000; a.ph_hi = 1001; hipLaunchKernelGGL(hybrid_fwd, dim3(grid), dim3(512), LDS_BYTES, stream, a); }
    } else {
        a.ph_lo = 0; a.ph_hi = NLAYER * NPH;
        hipLaunchKernelGGL(hybrid_fwd, dim3(grid), dim3(512), LDS_BYTES, stream, a);
    }
}
```

```cpp
#include <hip/hip_runtime.h>
#include <cstdio>
#include <cstdint>
#ifndef MK_PER_PHASE
#define MK_PER_PHASE 0
#endif
#define DBG_STOP 0
namespace pg8 {
#define PG8_LAS __attribute__((address_space(3)))
typedef unsigned short bf16_t;
typedef short bf16x8 __attribute__((ext_vector_type(8)));
typedef float f32x4 __attribute__((ext_vector_type(4)));
typedef unsigned u32x4 __attribute__((ext_vector_type(4)));
constexpr int BM = 256, BK = 64, HALF = 128, HTB = HALF * BK * 2  , STAGE_BYTES = 8 * HTB, NXCD = 8, WGM = 8;

__host__ __device__ __forceinline__ int lds_byte(int r, int c) { const int st = (r >> 4) * 2 + (c >> 5), rr = r & 15, cc = c & 31, ob = rr * 64 + cc * 2; return st * 1024 + (ob ^ (((ob >> 9) & 1) << 5)); }
__host__ __device__ __forceinline__ void stage_rc(int b, int& R, int& C) { const int st = b / 1024, sb = b % 1024, swz = sb ^ (((sb >> 9) & 1) << 5); R = (st >> 1) * 16 + swz / 64; C = (st & 1) * 32 + (swz % 64) / 2; }
__host__ __device__ __forceinline__ int perm32(int rho) { const int n = rho >> 4, i = rho & 15; return 8 * (i >> 2) + 4 * n + (i & 3); }

struct Unit { int pm, pn; };
struct Gemm { const bf16_t* A; const bf16_t* Bt; int M, N, K; };

struct StaticOrder {
    int nM, nN, nwg, G, c;
    __host__ __device__ void init(int M, int N, int G_, int c_) { nM = M / BM; nN = N / BM; nwg = nM * nN; G = G_; c = c_; }
    __host__ __device__ bool next(int i, Unit& u) const {
        const long L = (long)i * G + c; if (L >= nwg) return false;
        int wgid = (int)L; { const int q = nwg / NXCD, r = nwg % NXCD, xcd = wgid % NXCD, off = wgid / NXCD; wgid = (xcd < r ? xcd * (q + 1) : r * (q + 1) + (xcd - r) * q) + off; }
        const int nig = WGM * nN, gid = wgid / nig, fm = gid * WGM, gsz = (nM - fm) < WGM ? (nM - fm) : WGM;
        u.pm = fm + ((wgid % nig) % gsz); u.pn = (wgid % nig) / gsz; return true;
    }
    __device__ __forceinline__ void a_ready(const Unit&) const {}
    __device__ __forceinline__ void done(const Unit&) const {}
};
struct CountedOrder : StaticOrder {
    const unsigned* ready; unsigned need; unsigned* tmo;
    __device__ __forceinline__ void a_ready(const Unit& u) const {
        if (threadIdx.x < 64) {
            const unsigned long long t0 = __builtin_amdgcn_s_memrealtime(); unsigned polls = 0;
            while ((unsigned)__builtin_amdgcn_readfirstlane(__hip_atomic_load(ready + 64 * u.pm, __ATOMIC_RELAXED, __HIP_MEMORY_SCOPE_AGENT)) < need) {
                if ((++polls & 255u) == 0u && __builtin_amdgcn_readfirstlane(__hip_atomic_load(tmo, __ATOMIC_RELAXED, __HIP_MEMORY_SCOPE_AGENT)) != 0u) break;
                if (__builtin_amdgcn_s_memrealtime() - t0 > 2000000ull) {
                    if (threadIdx.x == 0) { unsigned expect = 0u; __hip_atomic_compare_exchange_strong(tmo + 1, &expect, 0x600u | (unsigned)(u.pm & 0xff), __ATOMIC_RELAXED, __ATOMIC_RELAXED, __HIP_MEMORY_SCOPE_AGENT); __hip_atomic_store(tmo, 1u, __ATOMIC_RELAXED, __HIP_MEMORY_SCOPE_AGENT); }
                    break; }
                __builtin_amdgcn_s_sleep(2); }
            __builtin_amdgcn_fence(__ATOMIC_ACQUIRE, "agent");
            asm volatile("s_waitcnt vmcnt(0)" ::: "memory");
        }
#if !defined(BROKEN_HOOK_NO_BARRIER)
        asm volatile("" ::: "memory"); __builtin_amdgcn_s_barrier(); asm volatile("" ::: "memory");
#endif
    }
};

__device__ __forceinline__ unsigned cvt_pk_bf16(float lo, float hi) { unsigned r; asm volatile("v_cvt_pk_bf16_f32 %0, %1, %2" : "=v"(r) : "v"(lo), "v"(hi)); return r; }
typedef float f32x2 __attribute__((ext_vector_type(2)));
__device__ __forceinline__ f32x2 gelu_pk(f32x2 v) {
    const f32x2 av = __builtin_elementwise_abs(v), d = av * 0.2316418882f + 1.0f;
    f32x2 t; t.x = __builtin_amdgcn_rcpf(d.x); t.y = __builtin_amdgcn_rcpf(d.y);
    f32x2 q = t * 0.5307027145f + (-0.7265760135f); q = q * t + 0.7107068705f; q = q * t + (-0.142248368f); q = q * t + 0.127414796f; q = q * t;
    const f32x2 s = (v * v) * (-0.72134752044f);
    f32x2 e; e.x = __builtin_amdgcn_exp2f(s.x); e.y = __builtin_amdgcn_exp2f(s.y);
    const f32x2 m = v * (q * e), r = v - m;
    f32x2 o; o.x = v.x < 0.f ? m.x : r.x; o.y = v.y < 0.f ? m.y : r.y; return o;
}

struct EpiF32 {
    static constexpr bool PERM = false, AFTER_DRAIN = false;
    float* C; int ldc; const float* bias;
    __device__ __forceinline__ void operator()(const f32x4 (&acc)[2][2][4][2], const Unit& u, int wr, int wc, int fr, int fq) const {
        const int row0 = u.pm * BM + wr * 64 + fr, col0 = u.pn * BM + wc * 32 + 4 * fq;
        f32x4 bv[2][2];
#pragma unroll
        for (int bj = 0; bj < 2; ++bj)
#pragma unroll
            for (int n = 0; n < 2; ++n) bv[bj][n] = bias ? *(const f32x4*)(bias + col0 + bj * HALF + n * 16) : (f32x4){0.f, 0.f, 0.f, 0.f};
#pragma unroll
        for (int ai = 0; ai < 2; ++ai)
#pragma unroll
            for (int m = 0; m < 4; ++m) { float* rowp = C + (size_t)(row0 + ai * HALF + m * 16) * ldc + col0;
#pragma unroll
                for (int bj = 0; bj < 2; ++bj)
#pragma unroll
                    for (int n = 0; n < 2; ++n) *(f32x4*)(rowp + bj * HALF + n * 16) = acc[ai][bj][m][n] + bv[bj][n]; }
    }
};
template <int ACT  > struct EpiBf16 {
    static constexpr bool PERM = true, AFTER_DRAIN = false;
    bf16_t* O; int ldc; const float* bias; int split_cols; size_t split_stride;
    __device__ __forceinline__ void operator()(const f32x4 (&acc)[2][2][4][2], const Unit& u, int wr, int wc, int fr, int fq) const {
        const int row0 = u.pm * BM + wr * 64 + fr; int colt = u.pn * BM; bf16_t* base = O;
        if (split_cols) { const int t = colt / split_cols; base += (size_t)t * split_stride; colt -= t * split_cols; }
        const int col0 = colt + wc * 32 + 8 * fq, bcol0 = u.pn * BM + wc * 32 + 8 * fq;
        f32x4 bv[2][2];
#pragma unroll
        for (int bj = 0; bj < 2; ++bj)
#pragma unroll
            for (int n = 0; n < 2; ++n) bv[bj][n] = bias ? *(const f32x4*)(bias + bcol0 + bj * HALF + 4 * n) : (f32x4){0.f, 0.f, 0.f, 0.f};
#pragma unroll
        for (int ai = 0; ai < 2; ++ai)
#pragma unroll
            for (int m = 0; m < 4; ++m) { bf16_t* rowp = base + (size_t)(row0 + ai * HALF + m * 16) * ldc + col0;
#pragma unroll
                for (int bj = 0; bj < 2; ++bj) { f32x4 v0 = acc[ai][bj][m][0] + bv[bj][0], v1 = acc[ai][bj][m][1] + bv[bj][1];
                    if (ACT == 1) { f32x2 a = gelu_pk((f32x2){v0[0], v0[1]}), b = gelu_pk((f32x2){v0[2], v0[3]}), c = gelu_pk((f32x2){v1[0], v1[1]}), d = gelu_pk((f32x2){v1[2], v1[3]});
                        v0 = (f32x4){a.x, a.y, b.x, b.y}; v1 = (f32x4){c.x, c.y, d.x, d.y}; }
                    if (ACT == 2) {
#pragma unroll
                        for (int j = 0; j < 4; ++j) { v0[j] = 0.5f * v0[j] * (1.0f + erff(v0[j] * 0.70710678f)); v1[j] = 0.5f * v1[j] * (1.0f + erff(v1[j] * 0.70710678f)); } }
                    u32x4 w; w.x = cvt_pk_bf16(v0[0], v0[1]); w.y = cvt_pk_bf16(v0[2], v0[3]); w.z = cvt_pk_bf16(v1[0], v1[1]); w.w = cvt_pk_bf16(v1[2], v1[3]);
                    *(u32x4*)(rowp + bj * HALF) = w; } }
    }
};

struct PanelStats {
    unsigned* xbuf;
    unsigned* cnt;
    unsigned* tmo;
    int ntn; float eps;
    unsigned code;
    __device__ __forceinline__ bool run(const f32x4 (&v)[2][2][4][2], const Unit& u, int wr, int wc, int fr, int fq, PG8_LAS unsigned char* lds, int wid, int lane) const {
        typedef float f32x2v __attribute__((ext_vector_type(2)));
        PG8_LAS f32x2v* P = (PG8_LAS f32x2v*)lds;
        PG8_LAS f32x2v* S = (PG8_LAS f32x2v*)(lds + 8192);
        PG8_LAS unsigned* flag = (PG8_LAS unsigned*)(lds + 8192 + 2048);
#pragma unroll
        for (int ai = 0; ai < 2; ++ai)
#pragma unroll
            for (int m = 0; m < 4; ++m) {
                float s = 0.f;
#pragma unroll
                for (int bj = 0; bj < 2; ++bj)
#pragma unroll
                    for (int n = 0; n < 2; ++n) { const f32x4 x = v[ai][bj][m][n]; s += (x[0] + x[1]) + (x[2] + x[3]); }
                s += __shfl_xor(s, 16); s += __shfl_xor(s, 32);
                const float mw = s * (1.0f / 64.0f); float q = 0.f;
#pragma unroll
                for (int bj = 0; bj < 2; ++bj)
#pragma unroll
                    for (int n = 0; n < 2; ++n) { const f32x4 d = v[ai][bj][m][n] - mw; q += (d[0] * d[0] + d[1] * d[1]) + (d[2] * d[2] + d[3] * d[3]); }
                q += __shfl_xor(q, 16); q += __shfl_xor(q, 32);
                if (fq == 0) P[(ai * HALF + wr * 64 + m * 16 + fr) * 4 + wc] = (f32x2v){mw, q};
            }
        asm volatile("s_waitcnt lgkmcnt(0)" ::: "memory"); __builtin_amdgcn_s_barrier(); asm volatile("" ::: "memory");
#if defined(BROKEN_NO_WAIT)
        if (blockIdx.x >= 64) { const long long t0 = clock64(); while (clock64() - t0 < 60000) __builtin_amdgcn_s_sleep(8); }
#endif
        const int row = wid * 32 + (lane & 31);
        if (lane < 32) {
            const f32x2v a = P[row * 4 + 0], b = P[row * 4 + 1], c = P[row * 4 + 2], d = P[row * 4 + 3];
            const float mt = (a.x + b.x + c.x + d.x) * 0.25f;
            const float da = a.x - mt, db = b.x - mt, dc = c.x - mt, dd = d.x - mt;
            const float m2 = (a.y + b.y) + (c.y + d.y) + 64.0f * ((da * da + db * db) + (dc * dc + dd * dd));
            unsigned long long* slot = (unsigned long long*)xbuf + ((size_t)(u.pm * BM + row) * 4 + u.pn);
            __hip_atomic_store(slot, ((unsigned long long)__float_as_uint(m2) << 32) | __float_as_uint(mt), __ATOMIC_RELAXED, __HIP_MEMORY_SCOPE_AGENT);
        }
        asm volatile("s_waitcnt vmcnt(0)" ::: "memory");
        if (lane == 0) __hip_atomic_fetch_add(cnt + 64 * u.pm, 1u, __ATOMIC_RELAXED, __HIP_MEMORY_SCOPE_AGENT);
        if (wid == 0) {
            bool dead = false; const unsigned long long t0 = __builtin_amdgcn_s_memrealtime(); const unsigned want = 8u * (unsigned)ntn;
            for (;;) {
#if defined(BROKEN_NO_WAIT)
                break;
#endif
                if ((unsigned)__builtin_amdgcn_readfirstlane(__hip_atomic_load(cnt + 64 * u.pm, __ATOMIC_RELAXED, __HIP_MEMORY_SCOPE_AGENT)) >= want) break;
                if (__builtin_amdgcn_s_memrealtime() - t0 > 2000000ull) {
                    if (lane == 0) { unsigned expect = 0u; __hip_atomic_compare_exchange_strong(tmo + 1, &expect, code | (unsigned)(u.pm & 0xff), __ATOMIC_RELAXED, __ATOMIC_RELAXED, __HIP_MEMORY_SCOPE_AGENT);
                                     __hip_atomic_store(tmo, 1u, __ATOMIC_RELAXED, __HIP_MEMORY_SCOPE_AGENT); }
                    dead = true; break; }
                __builtin_amdgcn_s_sleep(2);
            }
            __builtin_amdgcn_fence(__ATOMIC_ACQUIRE, "agent");
            if (lane == 0) flag[0] = dead ? 1u : 0u;
        }
        asm volatile("s_waitcnt vmcnt(0) lgkmcnt(0)" ::: "memory"); __builtin_amdgcn_s_barrier(); asm volatile("" ::: "memory");
        const bool bad = flag[0] != 0u;
        if (lane < 32) {
            const unsigned long long* slot = (const unsigned long long*)xbuf + (size_t)(u.pm * BM + row) * 4; float mt[4], m2[4]; float ms = 0.f;
#pragma unroll
            for (int t = 0; t < 4; ++t) { if (t < ntn) { const unsigned long long w = __hip_atomic_load(slot + t, __ATOMIC_RELAXED, __HIP_MEMORY_SCOPE_AGENT); mt[t] = __uint_as_float((unsigned)w); m2[t] = __uint_as_float((unsigned)(w >> 32)); } else { mt[t] = 0.f; m2[t] = 0.f; } ms += mt[t]; }
            const float mean = ms / (float)ntn; float q = 0.f;
#pragma unroll
            for (int t = 0; t < 4; ++t) if (t < ntn) { const float dm = mt[t] - mean; q += m2[t] + 256.0f * dm * dm; }
            S[row] = (f32x2v){mean, 1.0f / sqrtf(q / (256.0f * (float)ntn) + eps)};
        }
        asm volatile("s_waitcnt lgkmcnt(0)" ::: "memory"); __builtin_amdgcn_s_barrier(); asm volatile("" ::: "memory");
        return bad;
    }
};
struct EpiLnRes {
    static constexpr bool PERM = false, AFTER_DRAIN = true;
    const float* base; float* out; int ldc; const float* bias; PanelStats st; unsigned poison;
    __device__ __forceinline__ void refuse(size_t i0, size_t stride, int M, int N) const { const float q = __builtin_nanf(""); for (size_t i = i0; i < (size_t)M * N; i += stride) out[(i / N) * ldc + i % N] = q;
        if (i0 == 0) { unsigned expect = 0u; __hip_atomic_compare_exchange_strong(st.tmo + 1, &expect, 0x7f0u, __ATOMIC_RELAXED, __ATOMIC_RELAXED, __HIP_MEMORY_SCOPE_AGENT); __hip_atomic_store(st.tmo, 1u, __ATOMIC_RELAXED, __HIP_MEMORY_SCOPE_AGENT); } }
    __device__ __forceinline__ void fused(f32x4 (&acc)[2][2][4][2], const Unit& u, int wr, int wc, int fr, int fq, PG8_LAS unsigned char* lds, int wid, int lane) const {
        typedef float f32x2v __attribute__((ext_vector_type(2)));
        const PG8_LAS f32x2v* S = (const PG8_LAS f32x2v*)(lds + 8192);
        const int col0 = u.pn * BM + wc * 32 + 4 * fq;
#pragma unroll
        for (int bj = 0; bj < 2; ++bj)
#pragma unroll
            for (int n = 0; n < 2; ++n) { const f32x4 bv = bias ? *(const f32x4*)(bias + col0 + bj * HALF + n * 16) : (f32x4){0.f, 0.f, 0.f, 0.f};
#pragma unroll
                for (int ai = 0; ai < 2; ++ai)
#pragma unroll
                    for (int m = 0; m < 4; ++m) acc[ai][bj][m][n] += bv; }
        const bool bad = st.run(acc, u, wr, wc, fr, fq, lds, wid, lane) || poison != 0u;
        const float qnan = __builtin_nanf("");
#pragma unroll
        for (int ai = 0; ai < 2; ++ai)
#pragma unroll
            for (int m = 0; m < 4; ++m) { const int r = ai * HALF + wr * 64 + m * 16 + fr; const f32x2v sr = S[r]; const size_t off = (size_t)(u.pm * BM + r) * ldc + col0;
#pragma unroll
                for (int bj = 0; bj < 2; ++bj)
#pragma unroll
                    for (int n = 0; n < 2; ++n) { const f32x4 bs = *(const f32x4*)(base + off + bj * HALF + n * 16); f32x4 o = bs + (acc[ai][bj][m][n] - sr.x) * sr.y;
                        if (bad) o = (f32x4){qnan, qnan, qnan, qnan}; *(f32x4*)(out + off + bj * HALF + n * 16) = o; }
                asm volatile("" ::: "memory"); }
    }
};
struct EpiLnResLn {
    static constexpr bool PERM = false, AFTER_DRAIN = true;
    const float* base; float* out; bf16_t* xn; int ldc; const float* bias; PanelStats st1, st2; unsigned poison;
    __device__ __forceinline__ void refuse(size_t i0, size_t stride, int M, int N) const { const float q = __builtin_nanf(""); for (size_t i = i0; i < (size_t)M * N; i += stride) { const size_t o = (i / N) * ldc + i % N; out[o] = q; xn[o] = (bf16_t)0x7fc0u; }
        if (i0 == 0) { unsigned expect = 0u; __hip_atomic_compare_exchange_strong(st1.tmo + 1, &expect, 0x7f0u, __ATOMIC_RELAXED, __ATOMIC_RELAXED, __HIP_MEMORY_SCOPE_AGENT); __hip_atomic_store(st1.tmo, 1u, __ATOMIC_RELAXED, __HIP_MEMORY_SCOPE_AGENT); } }
    __device__ __forceinline__ void fused(f32x4 (&acc)[2][2][4][2], const Unit& u, int wr, int wc, int fr, int fq, PG8_LAS unsigned char* lds, int wid, int lane) const {
        typedef float f32x2v __attribute__((ext_vector_type(2))); typedef unsigned u32x2v __attribute__((ext_vector_type(2)));
        const PG8_LAS f32x2v* S = (const PG8_LAS f32x2v*)(lds + 8192);
        const int col0 = u.pn * BM + wc * 32 + 4 * fq;
#pragma unroll
        for (int bj = 0; bj < 2; ++bj)
#pragma unroll
            for (int n = 0; n < 2; ++n) { const f32x4 bv = bias ? *(const f32x4*)(bias + col0 + bj * HALF + n * 16) : (f32x4){0.f, 0.f, 0.f, 0.f};
#pragma unroll
                for (int ai = 0; ai < 2; ++ai)
#pragma unroll
                    for (int m = 0; m < 4; ++m) acc[ai][bj][m][n] += bv; }
        bool bad = st1.run(acc, u, wr, wc, fr, fq, lds, wid, lane) || poison != 0u;
        const float qnan = __builtin_nanf("");
#pragma unroll
        for (int ai = 0; ai < 2; ++ai)
#pragma unroll
            for (int m = 0; m < 4; ++m) { const int r = ai * HALF + wr * 64 + m * 16 + fr; const f32x2v sr = S[r]; const size_t off = (size_t)(u.pm * BM + r) * ldc + col0;
#pragma unroll
                for (int bj = 0; bj < 2; ++bj)
#pragma unroll
                    for (int n = 0; n < 2; ++n) { const f32x4 bs = *(const f32x4*)(base + off + bj * HALF + n * 16); acc[ai][bj][m][n] = bs + (acc[ai][bj][m][n] - sr.x) * sr.y; }
                asm volatile("" : "+v"(acc[ai][0][m][0]), "+v"(acc[ai][0][m][1]), "+v"(acc[ai][1][m][0]), "+v"(acc[ai][1][m][1]));
                if (m & 1) asm volatile("" ::: "memory"); }
        const bool bad1 = bad;
        bad = st2.run(acc, u, wr, wc, fr, fq, lds, wid, lane) || bad;
#pragma unroll
        for (int ai = 0; ai < 2; ++ai)
#pragma unroll
            for (int m = 0; m < 4; ++m) { const int r = ai * HALF + wr * 64 + m * 16 + fr; const f32x2v sr = S[r]; const size_t off = (size_t)(u.pm * BM + r) * ldc + col0;
#pragma unroll
                for (int bj = 0; bj < 2; ++bj)
#pragma unroll
                    for (int n = 0; n < 2; ++n) { const f32x4 x1 = acc[ai][bj][m][n]; *(f32x4*)(out + off + bj * HALF + n * 16) = bad1 ? (f32x4){qnan, qnan, qnan, qnan} : x1;
                        const f32x4 o = (x1 - sr.x) * sr.y; u32x2v w; w.x = cvt_pk_bf16(o[0], o[1]); w.y = cvt_pk_bf16(o[2], o[3]);
                        if (bad) { w.x = 0x7fc07fc0u; w.y = 0x7fc07fc0u; } *(u32x2v*)(xn + off + bj * HALF + n * 16) = w; }
                asm volatile("" ::: "memory"); }
    }
};

template <class Epi, class Sched, bool STAMP = false>
__device__ __forceinline__ void gemm_phase(PG8_LAS unsigned char* lds, const Gemm g, const Sched& S, const Epi& E, unsigned long long* stamps, int tid_in) {
    int tid_ = tid_in; asm volatile("" : "+v"(tid_));
    const int tid = tid_, wid = __builtin_amdgcn_readfirstlane(tid >> 6), lane = tid & 63, wr = wid >> 2, wc = wid & 3, fr = lane & 15, fq = lane >> 4;
    const int K = g.K, nt = K / BK;
    int ts_lo = 0, ts_hi = 0, nts = 0; const unsigned long long rt_entry = STAMP ? (unsigned long long)wall_clock64() : 0ull;
#define PG8_STAMP() do { if (STAMP && wid == 0 && nts < 64) { const unsigned long long _c = (unsigned long long)clock64(); \
        ts_lo = (lane == nts) ? (int)(unsigned)_c : ts_lo; ts_hi = (lane == nts) ? (int)(unsigned)(_c >> 32) : ts_hi; ++nts; } } while (0)
    PG8_STAMP();
    unsigned voffA[2], voffB[2];
#pragma unroll
    for (int i = 0; i < 2; ++i) { int R, C; stage_rc(tid * 16 + i * 8192, R, C); const int Rb = Epi::PERM ? ((R & ~31) + perm32(R & 31)) : R;
        voffA[i] = (unsigned)(R * K + C) * 2u; voffB[i] = (unsigned)(Rb * K + C) * 2u; }
    const size_t kstep = (size_t)(BK * 2);
    const size_t hstep = (size_t)HALF * K * 2;
    const size_t tstep = 2 * hstep;
    const unsigned ldsw = (unsigned)wid * 1024u;
    const int aoff = lds_byte(wr * 64 + fr, fq * 8), boff = lds_byte(wc * 32 + fr, fq * 8);
#define PG8_SA(b, h) (((b) * 2 + (h)) * HTB)
#define PG8_SB(b, h) ((4 + (b) * 2 + (h)) * HTB)
#define PG8_STAGE(bufoff, gbase, voff) do { _Pragma("unroll") for (int _i = 0; _i < 2; ++_i) \
        __builtin_amdgcn_global_load_lds((const unsigned*)((const char*)(gbase) + (voff)[_i]), (PG8_LAS unsigned*)(lds + (bufoff) + ldsw + _i * 8192), 16, 0, 0); } while (0)
#define PG8_LDA(dst, b, h) do { _Pragma("unroll") for (int m = 0; m < 4; ++m) _Pragma("unroll") for (int k = 0; k < 2; ++k) dst[m][k] = *(const PG8_LAS bf16x8*)(lds + PG8_SA(b, h) + aoff + m * 2048 + k * 1024); } while (0)
#define PG8_LDB(dst, b, h) do { _Pragma("unroll") for (int n = 0; n < 2; ++n) _Pragma("unroll") for (int k = 0; k < 2; ++k) dst[n][k] = *(const PG8_LAS bf16x8*)(lds + PG8_SB(b, h) + boff + n * 2048 + k * 1024); } while (0)
#define PG8_MMA(ai, bj, At, Bt) do { __builtin_amdgcn_s_setprio(1); _Pragma("unroll") for (int m = 0; m < 4; ++m) _Pragma("unroll") for (int n = 0; n < 2; ++n) _Pragma("unroll") for (int k = 0; k < 2; ++k) \
        acc[ai][bj][m][n] = __builtin_amdgcn_mfma_f32_16x16x32_bf16(Bt[n][k], At[m][k], acc[ai][bj][m][n], 0, 0, 0); __builtin_amdgcn_s_setprio(0); } while (0)
#define PG8_WAIT_V(n) asm volatile("s_waitcnt vmcnt(" #n ")" ::: "memory")
#define PG8_WAIT_L(n) asm volatile("s_waitcnt lgkmcnt(" #n ")" ::: "memory")
#define PG8_BAR __builtin_amdgcn_s_barrier()
#define PG8_SCHED __builtin_amdgcn_sched_barrier(0)
    Unit cur, nxt; int ui = 0;
    if (!S.next(0, cur)) return;
    f32x4 acc[2][2][4][2];
#pragma unroll
    for (int a = 0; a < 2; ++a)
#pragma unroll
        for (int b = 0; b < 2; ++b)
#pragma unroll
            for (int m = 0; m < 4; ++m)
#pragma unroll
                for (int n = 0; n < 2; ++n) acc[a][b][m][n] = (f32x4){0.f, 0.f, 0.f, 0.f};
    bf16x8 At[4][2], B0[2][2], B1[2][2];
    const char* cA = (const char*)g.A + (size_t)cur.pm * tstep; const char* cB = (const char*)g.Bt + (size_t)cur.pn * tstep;
    S.a_ready(cur);
    PG8_STAGE(PG8_SB(0, 0), cB, voffB); PG8_STAGE(PG8_SA(0, 0), cA, voffA); PG8_STAGE(PG8_SB(0, 1), cB + hstep, voffB); PG8_STAGE(PG8_SA(0, 1), cA + hstep, voffA);
    if (wr == 1) PG8_BAR;
    PG8_WAIT_V(4); PG8_BAR;
    PG8_STAGE(PG8_SB(1, 0), cB + kstep, voffB); PG8_STAGE(PG8_SA(1, 0), cA + kstep, voffA); PG8_STAGE(PG8_SB(1, 1), cB + hstep + kstep, voffB);
    PG8_WAIT_V(6); PG8_BAR;
    PG8_STAMP();
    for (;;) {
        const bool has_next = S.next(ui + 1, nxt);
        const char* nA = has_next ? (const char*)g.A + (size_t)nxt.pm * tstep : cA; const char* nB = has_next ? (const char*)g.Bt + (size_t)nxt.pn * tstep : cB;
        for (int t = 0; t < nt; t += 2) {
            const bool last = (t == nt - 2);
            const char* a1 = cA + (size_t)(t + 1) * kstep;
            const char* a2 = last ? nA : cA + (size_t)(t + 2) * kstep; const char* b2 = last ? nB : cB + (size_t)(t + 2) * kstep;
            const char* a3 = a2 + kstep; const char* b3 = b2 + kstep;
            if (last && has_next) S.a_ready(nxt);
            PG8_LDB(B0, 0, 0); PG8_SCHED; PG8_LDA(At, 0, 0); PG8_STAGE(PG8_SA(1, 1), a1 + hstep, voffA);
            PG8_WAIT_L(8); PG8_BAR; PG8_WAIT_L(0); PG8_MMA(0, 0, At, B0); PG8_BAR; PG8_SCHED;
            PG8_LDB(B1, 0, 1); PG8_STAGE(PG8_SB(0, 0), b2, voffB);
            PG8_BAR; PG8_WAIT_L(0); PG8_MMA(0, 1, At, B1); PG8_BAR;
            PG8_LDA(At, 0, 1); PG8_STAGE(PG8_SA(0, 0), a2, voffA);
            PG8_BAR; PG8_WAIT_L(0); PG8_MMA(1, 0, At, B0); PG8_BAR; PG8_SCHED;
            PG8_STAGE(PG8_SB(0, 1), b2 + hstep, voffB);
            PG8_WAIT_V(6); PG8_BAR; PG8_MMA(1, 1, At, B1); PG8_BAR;
            PG8_LDB(B0, 1, 0); PG8_SCHED; PG8_LDA(At, 1, 0); PG8_STAGE(PG8_SA(0, 1), a2 + hstep, voffA);
            PG8_WAIT_L(8); PG8_BAR; PG8_WAIT_L(0); PG8_MMA(0, 0, At, B0); PG8_BAR; PG8_SCHED;
            PG8_LDB(B1, 1, 1); PG8_STAGE(PG8_SB(1, 0), b3, voffB);
            PG8_BAR; PG8_WAIT_L(0); PG8_MMA(0, 1, At, B1); PG8_BAR;
            PG8_LDA(At, 1, 1); PG8_STAGE(PG8_SA(1, 0), a3, voffA);
            PG8_BAR; PG8_WAIT_L(0); PG8_MMA(1, 0, At, B0); PG8_BAR; PG8_SCHED;
            PG8_STAGE(PG8_SB(1, 1), b3 + hstep, voffB);
            PG8_WAIT_V(6); PG8_BAR; PG8_MMA(1, 1, At, B1); PG8_BAR;
        }
        PG8_STAMP();
        if constexpr (!Epi::AFTER_DRAIN) { E(acc, cur, wr, wc, fr, fq); S.done(cur); }
        PG8_STAMP();
        if (!has_next) break;
#pragma unroll
        for (int a = 0; a < 2; ++a)
#pragma unroll
            for (int b = 0; b < 2; ++b)
#pragma unroll
                for (int m = 0; m < 4; ++m)
#pragma unroll
                    for (int n = 0; n < 2; ++n) acc[a][b][m][n] = (f32x4){0.f, 0.f, 0.f, 0.f};
        cur = nxt; cA = nA; cB = nB; ++ui;
    }
    PG8_WAIT_V(0);
    if (wr == 0) PG8_BAR;
    PG8_BAR;
    if constexpr (Epi::AFTER_DRAIN) { E.fused(acc, cur, wr, wc, fr, fq, lds, wid, lane); S.done(cur); }
    PG8_STAMP();
    if (STAMP && wid == 0) { stamps[lane] = lane < nts ? (((unsigned long long)(unsigned)ts_hi << 32) | (unsigned)ts_lo) : 0ull;
        if (lane == 62) stamps[62] = rt_entry; if (lane == 63) stamps[63] = (unsigned long long)wall_clock64(); }
#undef PG8_STAMP
#undef PG8_SA
#undef PG8_SB
#undef PG8_STAGE
#undef PG8_LDA
#undef PG8_LDB
#undef PG8_MMA
#undef PG8_WAIT_V
#undef PG8_WAIT_L
#undef PG8_BAR
#undef PG8_SCHED
}
}

constexpr int DM = 2048, NBATCH = 4, SEQ = 2048, CTXL = 256;
constexpr int TC = NBATCH * CTXL;
constexpr int TL = NBATCH * SEQ;
constexpr int TT = TC + TL;
constexpr int NLAYER = 2;
constexpr int NPAD = 9472;
constexpr int PC_U = 0, PC_QKV = 1024, PC_Z = 4096, PC_GS5 = 5120, PC_GDN = 7168, PC_BA = 9216;
constexpr int NE = 64, NEX = 65, EDIM = 512;
constexpr int MAXTILES = 388, MAXSLOT = MAXTILES * 256;
constexpr float EPS = 1e-6f;
constexpr int MODW = 12288;

constexpr size_t MiB = 1u << 20;
constexpr size_t WS_CTL = 0, CTL_ZERO_BYTES = 2 * MiB;
constexpr int CW_BAR = 4096;
constexpr int CW_CNT = 16384;
constexpr int CW_FILL = 16384 + 256;
constexpr size_t WS_MODS = 1 * MiB;
constexpr size_t WS_MISC = 2 * MiB;
constexpr size_t WS_W = 4 * MiB;
constexpr size_t WO_IN = 0, WO_GLU = 37 * MiB, WO_BRS = 39 * MiB, WO_BRD = 43 * MiB, WO_OUT = 47 * MiB, WO_GU = 55 * MiB, WO_DN = (55 + 260) * MiB, W_BYTES = (55 + 260 + 130) * MiB;
constexpr size_t WS_X = WS_W + W_BYTES;
constexpr size_t WS_EIDX = WS_X + 72 * MiB;
constexpr size_t WS_WTS = WS_EIDX + 1 * MiB;
constexpr size_t WS_SLOT = WS_WTS + 1 * MiB;
constexpr size_t WS_AB = WS_SLOT + 1 * MiB;
constexpr size_t WS_B = WS_AB + 36 * MiB;
constexpr size_t WB_P = 0;
constexpr size_t WB_QKV = 167 * MiB;
constexpr size_t WB_BG = WB_QKV + 108 * MiB;
constexpr size_t WB_Y = WB_BG + 2 * MiB;
constexpr size_t WB_O = WB_Y + 72 * MiB;
constexpr size_t WB_G = WB_O + 72 * MiB;
constexpr size_t WB_DNO = WB_G + 18 * MiB;
constexpr size_t WB_S5O = WB_DNO + 18 * MiB;
constexpr size_t WB_M1 = WB_S5O + 18 * MiB;
constexpr size_t WB_M = WB_M1 + 72 * MiB;
constexpr size_t WB_MIX = WB_M + 36 * MiB;
constexpr size_t WB_DNU = WB_MIX + 72 * MiB;
constexpr int DN_UNITS = 4 * 8 * 2 * 36;
constexpr size_t DNU_W = 0, DNU_UT = (size_t)DN_UNITS * 16384, DNU_KT = 2 * DNU_UT, DNU_QK = 3 * DNU_UT, DNU_SC = DNU_QK + (size_t)DN_UNITS * 8192;
constexpr size_t WB_S5 = WB_DNU + 132 * MiB;
constexpr int S5N = 288;
constexpr size_t S5_KC = 0, S5_WST = 4 * MiB, S5_WOUT = 20 * MiB, S5_L32 = 36 * MiB, S5_UG = 37 * MiB, S5_SLOC = 55 * MiB, S5_HIN = 73 * MiB;
constexpr size_t WB_END = WB_S5 + 82 * MiB;
constexpr size_t WB_HPERM = 0;
constexpr size_t WB_ACT = 388 * MiB;
static_assert(WB_ACT + 97 * MiB <= WB_END, "moe scratch fits");
constexpr size_t WS_END = WS_B + WB_END;

constexpr int LDS_BYTES = 147456;
constexpr int LDS_MISC = LDS_BYTES - 256;

#define LAS __attribute__((address_space(3)))
typedef unsigned short bf16;
typedef float f32x4 __attribute__((ext_vector_type(4)));
typedef float f32x2 __attribute__((ext_vector_type(2)));
typedef unsigned u32x4 __attribute__((ext_vector_type(4)));
typedef unsigned u32x2 __attribute__((ext_vector_type(2)));

#define LDS_WAIT() asm volatile("s_waitcnt lgkmcnt(0)" ::: "memory")
#define VM_WAIT() asm volatile("s_waitcnt vmcnt(0)" ::: "memory")

__device__ __forceinline__ unsigned f2bf(float f) { unsigned u = __float_as_uint(f); return (u + 0x7fffu + ((u >> 16) & 1u)) >> 16; }
__device__ __forceinline__ unsigned pk2(float lo, float hi) { return f2bf(lo) | (f2bf(hi) << 16); }
__device__ __forceinline__ float bflo(unsigned w) { return __uint_as_float(w << 16); }
__device__ __forceinline__ float bfhi(unsigned w) { return __uint_as_float(w & 0xffff0000u); }
__device__ __forceinline__ float bf2f(bf16 b) { return __uint_as_float(((unsigned)b) << 16); }
__device__ __forceinline__ float sigmoidf_(float x) { return 1.f / (1.f + __expf(-x)); }
__device__ __forceinline__ float siluf_(float x) { return x / (1.f + __expf(-x)); }
__device__ __forceinline__ float gelu_tanh(float x) { const float t = tanhf(0.7978845608028654f * (x + 0.044715f * x * x * x)); return 0.5f * x * (1.f + t); }
__device__ __forceinline__ int lane_id() { int l; asm volatile("v_mbcnt_lo_u32_b32 %0, -1, 0\n\tv_mbcnt_hi_u32_b32 %0, -1, %0" : "=v"(l)); return l; }
__device__ __forceinline__ float wave_sum(float v) {
#pragma unroll
    for (int o = 1; o < 64; o <<= 1) v += __shfl_xor(v, o);
    return v;
}

#define XB_TMO      128
#define XB_XCNT(j)  (256  + 64 * (j))
#define XB_XSUB(j)  (1280 + 64 * (j))
#define XB_XGEN(j)  (2304 + 64 * (j))
#define XB_TOP      3328
#define XB_TOPGEN   3392
#define XCD_BAR_WORDS 3456
#define XB_SPIN_CAP (1u << 20)

__device__ __forceinline__ unsigned xb_ld(unsigned* p)              { return __hip_atomic_load(p, __ATOMIC_RELAXED, __HIP_MEMORY_SCOPE_AGENT); }
__device__ __forceinline__ unsigned xb_add(unsigned* p, unsigned v) { return __hip_atomic_fetch_add(p, v, __ATOMIC_RELAXED, __HIP_MEMORY_SCOPE_AGENT); }
__device__ __forceinline__ unsigned xb_xcc_id() { return (unsigned)__builtin_amdgcn_s_getreg((3 << 11) | 20) & 0xFu; }
#define XB_SPIN(cond, bar) do { unsigned _sp = 0; while (cond) { __builtin_amdgcn_s_sleep(1); \
    if ((++_sp & 255u) == 0u) { if (xb_ld(&(bar)[XB_TMO])) break; if (_sp > XB_SPIN_CAP) { atomicAdd(&(bar)[XB_TMO], 1u); break; } } } } while (0)

struct XcdBarrier { unsigned* bar; unsigned x; volatile LAS unsigned* st; };

__device__ __forceinline__ XcdBarrier xcd_barrier_post(unsigned* bar, volatile LAS unsigned* st) {
    XcdBarrier b; b.bar = bar; b.x = xb_xcc_id(); b.st = st;
    if (threadIdx.x == 0) (void)xb_add(&bar[XB_XCNT(b.x)], 1u);
    return b;
}
__device__ __forceinline__ void xcd_barrier_complete(unsigned* bar, unsigned x, unsigned& nloc, unsigned& nx) {
    const unsigned G = gridDim.x * gridDim.y * gridDim.z;
    unsigned sum, cnt, mine, sp = 0u;
    for (;;) {
        sum = 0u; cnt = 0u; mine = 0u;
#pragma unroll
        for (unsigned j = 0; j < 16; ++j) { const unsigned c = xb_ld(&bar[XB_XCNT(j)]); sum += c; cnt += (c > 0u) ? 1u : 0u; mine = (j == x) ? c : mine; }
        if (sum == G) break;
        __builtin_amdgcn_s_sleep(1);
        if ((++sp & 255u) == 0u) { if (xb_ld(&bar[XB_TMO])) break; if (sp > XB_SPIN_CAP) { atomicAdd(&bar[XB_TMO], 1u); break; } }
    }
    nloc = mine > 0u ? mine : 1u; nx = cnt > 0u ? cnt : 1u;
}
__device__ __forceinline__ void xcd_barrier(const XcdBarrier& b, int wave_s) {
    asm volatile("s_waitcnt vmcnt(0)" ::: "memory");
    __syncthreads();
    asm volatile("" : "+s"(wave_s));
    if (wave_s == 0 && lane_id() == 0) {
        unsigned* bar = b.bar; asm volatile("" : "+s"(bar));
        __builtin_amdgcn_s_waitcnt(0);
        unsigned nloc = b.st[0], nx = b.st[1];
        unsigned bx_ = b.x; asm volatile("" : "+s"(bx_));
        if (nloc == 0u) { xcd_barrier_complete(bar, bx_, nloc, nx); b.st[0] = nloc; b.st[1] = nx; }
        const unsigned old = xb_add(&bar[XB_XSUB(bx_)], 1u);
        const unsigned gen = old / nloc;
        if (old + 1u == (gen + 1u) * nloc) {
            __builtin_amdgcn_fence(__ATOMIC_RELEASE, "agent");
            asm volatile("s_waitcnt vmcnt(0)" ::: "memory");
            const unsigned og = xb_add(&bar[XB_TOP], 1u);
            const unsigned tg = og / nx;
            if (og + 1u == (tg + 1u) * nx) xb_add(&bar[XB_TOPGEN], 1u);
            else XB_SPIN(xb_ld(&bar[XB_TOPGEN]) == tg, bar);
            __builtin_amdgcn_fence(__ATOMIC_ACQUIRE, "agent");
            xb_add(&bar[XB_XGEN(bx_)], 1u);
            asm volatile("s_waitcnt vmcnt(0)" ::: "memory");
        } else {
            XB_SPIN(xb_ld(&bar[XB_XGEN(bx_)]) == gen, bar);
            __builtin_amdgcn_fence(__ATOMIC_ACQUIRE, "agent");
            asm volatile("s_waitcnt vmcnt(0)" ::: "memory");
        }
    }
    __syncthreads();
}

struct Args { const float* in[35]; float* out; unsigned char* ws; int ph_lo, ph_hi; };
struct Frame { LAS unsigned char* lds; int tid, lane, wave, G, bx, vcu, gw, NGW; };
__device__ __forceinline__ Frame make_frame(LAS unsigned char* lds, int wave_s) {
    asm volatile("" : "+s"(wave_s));
    Frame F; int tid = wave_s * 64 + lane_id(); asm volatile("" : "+v"(tid)); int bx = blockIdx.x; asm volatile("" : "+s"(bx));
    F.lds = lds; F.tid = tid; F.lane = tid & 63; F.wave = __builtin_amdgcn_readfirstlane(tid >> 6); F.G = gridDim.x; F.bx = bx;
    F.vcu = (F.G % 8 == 0) ? (bx % 8) * (F.G / 8) + bx / 8 : bx; F.gw = F.vcu * 8 + F.wave; F.NGW = F.G * 8; return F;
}
#define CAS __attribute__((address_space(4)))
__device__ __forceinline__ const float* inp(int i) {
    asm volatile("" : "+s"(i));
    const CAS char* ka = (const CAS char*)__builtin_amdgcn_kernarg_segment_ptr();
    return *(const float* const CAS*)(ka + 8 * i);
}

enum { I_X = 0, I_C, I_CTX, I_CCTX, I_WMOD, I_BMOD, I_NMPRE, I_NMPOST, I_NFPRE, I_NFPOST, I_WIN, I_LAMRE, I_LAMIM, I_LOGSTEP, I_BRE, I_BIM, I_CRE, I_CIM,
       I_S5D, I_WGLU, I_CONV, I_ALOG, I_DTB, I_DNNORM, I_WBRS, I_WBRD, I_WOUT, I_ROUTER, I_MBIAS, I_MGATE, I_MUP, I_MDOWN, I_SGATE, I_SUP, I_SDOWN };

struct MoeOrder {
    int ntiles, npn, G, c; const int* tile_e;
    __device__ __forceinline__ bool next(int i, pg8::Unit& u) const {
        const long L = (long)i * G + c; if (L >= (long)ntiles * npn) return false;
        const int tile = (int)(L / npn), pl = (int)(L % npn);
        const int e = __builtin_amdgcn_readfirstlane((int)__hip_atomic_load(tile_e + tile, __ATOMIC_RELAXED, __HIP_MEMORY_SCOPE_AGENT));
        u.pm = tile; u.pn = e * npn + pl; return true;
    }
    __device__ __forceinline__ void a_ready(const pg8::Unit&) const {}
    __device__ __forceinline__ void done(const pg8::Unit&) const {}
};

struct EpiBf16Mod {
    static constexpr bool PERM = true, AFTER_DRAIN = false;
    bf16* O; int ldc; int npn;
    __device__ __forceinline__ void operator()(const pg8::f32x4 (&acc)[2][2][4][2], const pg8::Unit& u, int wr, int wc, int fr, int fq) const {
        const int row0 = u.pm * 256 + wr * 64 + fr, col0 = (u.pn % npn) * 256 + wc * 32 + 8 * fq;
#pragma unroll
        for (int ai = 0; ai < 2; ++ai)
#pragma unroll
            for (int m = 0; m < 4; ++m) { bf16* rowp = O + (size_t)(row0 + ai * 128 + m * 16) * ldc + col0;
#pragma unroll
                for (int bj = 0; bj < 2; ++bj) { const pg8::f32x4 v0 = acc[ai][bj][m][0], v1 = acc[ai][bj][m][1];
                    u32x4 w; w.x = pk2(v0[0], v0[1]); w.y = pk2(v0[2], v0[3]); w.z = pk2(v1[0], v1[1]); w.w = pk2(v1[2], v1[3]);
                    *(u32x4*)(rowp + bj * 128) = w; } }
    }
};

struct EpiInProj {
    static constexpr bool PERM = true, AFTER_DRAIN = false;
    bf16* P; bf16* Ug;
    __device__ __forceinline__ void operator()(const pg8::f32x4 (&acc)[2][2][4][2], const pg8::Unit& u, int wr, int wc, int fr, int fq) const {
        const int row0 = u.pm * 256 + wr * 64 + fr, col0 = u.pn * 256 + wc * 32 + 8 * fq;
#pragma unroll
        for (int ai = 0; ai < 2; ++ai)
#pragma unroll
            for (int m = 0; m < 4; ++m) { const int t = row0 + ai * 128 + m * 16;
                int n, r;
                if (t < TC) { n = (t >> 8) * 72 + ((t & 255) >> 5); r = t & 31; } else { const int tt = t - TC, l = tt & 2047; n = (tt >> 11) * 72 + 8 + (l & 63); r = l >> 6; }
#pragma unroll
                for (int bj = 0; bj < 2; ++bj) { const pg8::f32x4 v0 = acc[ai][bj][m][0], v1 = acc[ai][bj][m][1]; const int col = col0 + bj * 128;
                    u32x4 w; w.x = pk2(v0[0], v0[1]); w.y = pk2(v0[2], v0[3]); w.z = pk2(v1[0], v1[1]); w.w = pk2(v1[2], v1[3]);
                    if (u.pn < 4) *(u32x4*)(Ug + ((size_t)((col >> 4) * S5N + n)) * 512 + r * 16 + (col & 15)) = w;
                    else *(u32x4*)(P + (size_t)t * NPAD + col) = w; } }
    }
};
struct EpiGlu {
    static constexpr bool PERM = true, AFTER_DRAIN = false;
    const bf16* Gb; bf16* O;
    __device__ __forceinline__ void operator()(const pg8::f32x4 (&acc)[2][2][4][2], const pg8::Unit& u, int wr, int wc, int fr, int fq) const {
        const int row0 = u.pm * 256 + wr * 64 + fr, col0 = u.pn * 256 + wc * 32 + 8 * fq;
#pragma unroll
        for (int ai = 0; ai < 2; ++ai)
#pragma unroll
            for (int m = 0; m < 4; ++m) { const size_t ro = (size_t)(row0 + ai * 128 + m * 16) * 1024 + col0;
#pragma unroll
                for (int bj = 0; bj < 2; ++bj) { const pg8::f32x4 v0 = acc[ai][bj][m][0], v1 = acc[ai][bj][m][1];
                    const u32x4 gq = *(const u32x4*)(Gb + ro + bj * 128);
                    u32x4 w;
                    w.x = pk2(bflo(gq.x) * sigmoidf_(v0[0]), bfhi(gq.x) * sigmoidf_(v0[1]));
                    w.y = pk2(bflo(gq.y) * sigmoidf_(v0[2]), bfhi(gq.y) * sigmoidf_(v0[3]));
                    w.z = pk2(bflo(gq.z) * sigmoidf_(v1[0]), bfhi(gq.z) * sigmoidf_(v1[1]));
                    w.w = pk2(bflo(gq.w) * sigmoidf_(v1[2]), bfhi(gq.w) * sigmoidf_(v1[3]));
                    *(u32x4*)(O + ro + bj * 128) = w; } }
    }
};
template <bool SECOND> struct EpiBr {
    static constexpr bool PERM = true, AFTER_DRAIN = false;
    const bf16* P; int gcol; float* M1; bf16* Mo;
    __device__ __forceinline__ void operator()(const pg8::f32x4 (&acc)[2][2][4][2], const pg8::Unit& u, int wr, int wc, int fr, int fq) const {
        const int row0 = u.pm * 256 + wr * 64 + fr, col0 = u.pn * 256 + wc * 32 + 8 * fq;
#pragma unroll
        for (int ai = 0; ai < 2; ++ai)
#pragma unroll
            for (int m = 0; m < 4; ++m) { const size_t row = (size_t)(row0 + ai * 128 + m * 16);
#pragma unroll
                for (int bj = 0; bj < 2; ++bj) { const pg8::f32x4 v0 = acc[ai][bj][m][0], v1 = acc[ai][bj][m][1];
                    const int col = col0 + bj * 128;
                    const u32x4 gq = *(const u32x4*)(P + row * NPAD + gcol + col);
                    f32x4 r0, r1;
                    r0[0] = sigmoidf_(bflo(gq.x)) * v0[0]; r0[1] = sigmoidf_(bfhi(gq.x)) * v0[1]; r0[2] = sigmoidf_(bflo(gq.y)) * v0[2]; r0[3] = sigmoidf_(bfhi(gq.y)) * v0[3];
                    r1[0] = sigmoidf_(bflo(gq.z)) * v1[0]; r1[1] = sigmoidf_(bfhi(gq.z)) * v1[1]; r1[2] = sigmoidf_(bflo(gq.w)) * v1[2]; r1[3] = sigmoidf_(bfhi(gq.w)) * v1[3];
                    float* mp = M1 + row * DM + col;
                    if (!SECOND) { *(f32x4*)mp = r0; *(f32x4*)(mp + 4) = r1; }
                    else { const f32x4 a0 = *(const f32x4*)mp, a1 = *(const f32x4*)(mp + 4); r0 += a0; r1 += a1;
                        u32x4 w; w.x = pk2(r0[0], r0[1]); w.y = pk2(r0[2], r0[3]); w.z = pk2(r1[0], r1[1]); w.w = pk2(r1[2], r1[3]);
                        *(u32x4*)(Mo + row * DM + col) = w; } }
                asm volatile("" ::: "memory"); }
    }
};
struct EpiSwiglu {
    static constexpr bool PERM = true, AFTER_DRAIN = false;
    bf16* O;
    __device__ __forceinline__ void operator()(const pg8::f32x4 (&acc)[2][2][4][2], const pg8::Unit& u, int wr, int wc, int fr, int fq) const {
        const int row0 = u.pm * 256 + wr * 64 + fr, col0 = (u.pn & 3) * 128 + wc * 32 + 8 * fq;
#pragma unroll
        for (int ai = 0; ai < 2; ++ai)
#pragma unroll
            for (int m = 0; m < 4; ++m) { bf16* rowp = O + (size_t)(row0 + ai * 128 + m * 16) * EDIM + col0;
                const pg8::f32x4 g0 = acc[ai][0][m][0], g1 = acc[ai][0][m][1], u0 = acc[ai][1][m][0], u1 = acc[ai][1][m][1];
                u32x4 w; w.x = pk2(siluf_(g0[0]) * u0[0], siluf_(g0[1]) * u0[1]); w.y = pk2(siluf_(g0[2]) * u0[2], siluf_(g0[3]) * u0[3]);
                w.z = pk2(siluf_(g1[0]) * u1[0], siluf_(g1[1]) * u1[1]); w.w = pk2(siluf_(g1[2]) * u1[2], siluf_(g1[3]) * u1[3]);
                *(u32x4*)rowp = w; }
    }
};

__device__ __forceinline__ const float* xrow_ptr(const unsigned char* ws, int layer, int t) {
    if (layer == 0) return t < TC ? inp(I_CTX) + (size_t)t * DM : inp(I_X) + (size_t)(t - TC) * DM;
    return (const float*)(ws + WS_X) + (size_t)t * DM;
}
__device__ __forceinline__ int mods_row(int t) { return t < TC ? 4 : (t - TC) / SEQ; }
__device__ __forceinline__ void tr_item(const float* src, size_t ld, bf16* dst, int K, LAS float* scr, int lane) {
#pragma unroll 8
    for (int i = 0; i < 32; ++i) { const int kk = 2 * i + (lane >> 5); scr[kk * 33 + (lane & 31)] = src[(size_t)kk * ld + (lane & 31)]; }
    LDS_WAIT();
    const int c = lane & 7;
#pragma unroll
    for (int j = 0; j < 4; ++j) { const int n = (lane >> 3) + 8 * j; const LAS float* s = scr + (8 * c) * 33 + n;
        u32x4 o; o.x = pk2(s[0 * 33], s[1 * 33]); o.y = pk2(s[2 * 33], s[3 * 33]); o.z = pk2(s[4 * 33], s[5 * 33]); o.w = pk2(s[6 * 33], s[7 * 33]);
        *(u32x4*)(dst + (size_t)n * K + 8 * c) = o; }
    LDS_WAIT();
}

__device__ __forceinline__ void s5_tables(const Frame& F, int layer, unsigned char* ws);
__device__ __forceinline__ void s5_state(const Frame& F, unsigned char* ws);
__device__ __forceinline__ void s5_out(const Frame& F, unsigned char* ws);

__device__ __forceinline__ void ph_pre(const Args& A, const Frame& F, int layer) {
    unsigned char* ws = A.ws; asm volatile("" : "+s"(ws));
    if (layer == 0) {
        LAS float* sil = (LAS float*)F.lds;
        for (int i = F.tid; i < 5 * DM; i += 512) { const int r = i / DM, k = i % DM; const float c = (r < 4) ? inp(I_C)[r * DM + k] : inp(I_CCTX)[k]; sil[i] = c / (1.f + expf(-c)); }
        __syncthreads();
        float* mods = (float*)(ws + WS_MODS);
        LAS float* part = (LAS float*)(F.lds + 5 * DM * 4);
        for (int it = F.vcu; it < NLAYER * 96; it += F.G) {
            const int l = it / 96, nb = it % 96;
            const float* W = inp(I_WMOD) + (size_t)l * DM * MODW + (size_t)(F.wave * 256) * MODW + nb * 128 + F.lane * 2;
            f32x2 acc[5];
#pragma unroll
            for (int r = 0; r < 5; ++r) acc[r] = (f32x2){0.f, 0.f};
#pragma unroll 8
            for (int k = 0; k < 256; ++k) { const f32x2 w = *(const f32x2*)(W + (size_t)k * MODW);
#pragma unroll
                for (int r = 0; r < 5; ++r) acc[r] += sil[r * DM + F.wave * 256 + k] * w; }
#pragma unroll
            for (int r = 0; r < 5; ++r) *(LAS f32x2*)(part + (F.wave * 5 + r) * 128 + F.lane * 2) = acc[r];
            __syncthreads();
            for (int o = F.tid; o < 5 * 128; o += 512) { const int r = o / 128, c = o % 128; float sum = inp(I_BMOD)[(size_t)l * MODW + nb * 128 + c];
#pragma unroll
                for (int w8 = 0; w8 < 8; ++w8) sum += part[(w8 * 5 + r) * 128 + c];
                mods[((size_t)l * 5 + r) * MODW + nb * 128 + c] = sum; }
            __syncthreads();
        }
        __syncthreads();
    }
    LAS float* scr = (LAS float*)(F.lds + F.wave * 16384);
    bf16* Wb = (bf16*)(ws + WS_W);
    constexpr int S_IN = 296 * 32, S_GLU = 512, S_BR = 1024, S_OUT = 2048, S_GU = NEX * 1024, S_DN = NEX * 512;
    constexpr int NITEMS = S_IN + S_GLU + 2 * S_BR + S_OUT + S_GU + S_DN;
    for (int it = F.gw; it < NITEMS; it += F.NGW) {
        int r = it;
        if (r < S_IN) {
            const int kb = r / 296, nb = r % 296, n0 = nb * 32, k0 = kb * 64;
            bf16* dst = Wb + WO_IN / 2 + (size_t)n0 * DM + k0;
            if (n0 >= 9248) { const int c = F.lane & 7;
#pragma unroll
                for (int j = 0; j < 4; ++j) { const int n = (F.lane >> 3) + 8 * j; *(u32x4*)(dst + (size_t)n * DM + 8 * c) = (u32x4){0u, 0u, 0u, 0u}; } }
            else { const int no = n0 < 5120 ? n0 : (n0 < 9216 ? n0 + 32 : n0 - 9216 + 5120);
                tr_item(inp(I_WIN) + (size_t)layer * DM * 9248 + (size_t)k0 * 9248 + no, 9248, dst, DM, scr, F.lane); }
            continue; }
        r -= S_IN;
        if (r < S_GLU) { const int kb = r / 32, nb = r % 32;
            tr_item(inp(I_WGLU) + (size_t)layer * 1024 * 1024 + (size_t)(kb * 64) * 1024 + nb * 32, 1024, Wb + WO_GLU / 2 + (size_t)(nb * 32) * 1024 + kb * 64, 1024, scr, F.lane); continue; }
        r -= S_GLU;
        if (r < 2 * S_BR) { const int which = r / S_BR, rr = r % S_BR, kb = rr / 64, nb = rr % 64;
            const float* src = inp(which ? I_WBRD : I_WBRS) + (size_t)layer * 1024 * DM + (size_t)(kb * 64) * DM + nb * 32;
            tr_item(src, DM, Wb + (which ? WO_BRD : WO_BRS) / 2 + (size_t)(nb * 32) * 1024 + kb * 64, 1024, scr, F.lane); continue; }
        r -= 2 * S_BR;
        if (r < S_OUT) { const int kb = r / 64, nb = r % 64;
            tr_item(inp(I_WOUT) + (size_t)layer * DM * DM + (size_t)(kb * 64) * DM + nb * 32, DM, Wb + WO_OUT / 2 + (size_t)(nb * 32) * DM + kb * 64, DM, scr, F.lane); continue; }
        r -= S_OUT;
        if (r < S_GU) { const int e = r / 1024, rr = r % 1024, kb = rr / 32, nb = rr % 32, nd0 = nb * 32;
            const int pn = nd0 / 256, half = (nd0 % 256) / 128, j0 = pn * 128 + (nd0 % 128);
            const float* base = (e < NE) ? (inp(half ? I_MUP : I_MGATE) + ((size_t)layer * NE + e) * DM * EDIM) : (inp(half ? I_SUP : I_SGATE) + (size_t)layer * DM * EDIM);
            tr_item(base + (size_t)(kb * 64) * EDIM + j0, EDIM, Wb + WO_GU / 2 + ((size_t)e * 1024 + nd0) * DM + kb * 64, DM, scr, F.lane); continue; }
        r -= S_GU;
        { const int e = r / 512, rr = r % 512, kb = rr / 64, nb = rr % 64;
            const float* base = (e < NE) ? (inp(I_MDOWN) + ((size_t)layer * NE + e) * EDIM * DM) : (inp(I_SDOWN) + (size_t)layer * EDIM * DM);
            tr_item(base + (size_t)(kb * 64) * DM + nb * 32, DM, Wb + WO_DN / 2 + ((size_t)e * DM + nb * 32) * EDIM + kb * 64, EDIM, scr, F.lane); }
    }
    s5_tables(F, layer, ws);
}

__device__ __forceinline__ void ph_n1(const Args& A, const Frame& F, int layer) {
    unsigned char* ws = A.ws; asm volatile("" : "+s"(ws));
    const float* mods = (const float*)(ws + WS_MODS) + (size_t)layer * 5 * MODW;
    const float* nw = inp(I_NMPRE) + (size_t)layer * DM;
    bf16* ab = (bf16*)(ws + WS_AB);
    for (int t = F.gw; t < TT; t += F.NGW) {
        const f32x4* xr = (const f32x4*)xrow_ptr(ws, layer, t) + F.lane;
        f32x4 v[8]; float ss = 0.f;
#pragma unroll
        for (int j = 0; j < 8; ++j) { v[j] = xr[64 * j]; ss += (v[j].x * v[j].x + v[j].y * v[j].y) + (v[j].z * v[j].z + v[j].w * v[j].w); }
        const float r = rsqrtf(wave_sum(ss) * (1.f / DM) + EPS);
        const float* mr = mods + (size_t)mods_row(t) * MODW;
        u32x2* o = (u32x2*)(ab + (size_t)t * DM) + F.lane;
#pragma unroll
        for (int j = 0; j < 8; ++j) { const int col = 4 * (F.lane + 64 * j);
            const f32x4 w = *(const f32x4*)(nw + col), sh = *(const f32x4*)(mr + col), sc = *(const f32x4*)(mr + DM + col);
            const f32x4 y = (v[j] * r * w) * (1.f + sc) + sh;
            u32x2 q; q.x = pk2(y.x, y.y); q.y = pk2(y.z, y.w); o[64 * j] = q; }
    }
}

__device__ __forceinline__ void ph_prep(const Args& A, const Frame& F, int layer) {
    unsigned char* ws = A.ws; asm volatile("" : "+s"(ws));
    const bf16* P = (const bf16*)(ws + WS_B + WB_P);
    bf16* qkv = (bf16*)(ws + WS_B + WB_QKV);
    float* bg = (float*)(ws + WS_B + WB_BG);
    const float* cw = inp(I_CONV) + (size_t)layer * 3 * 3072;
    s5_state(F, ws);
    for (int it = F.gw; it < TT * 8; it += F.NGW) {
        const int t = it >> 3, h = it & 7;
        bool hp, hn;
        if (t < TC) { const int i = t & 255; hp = i > 0; hn = i < 255; } else { const int l = (t - TC) & 2047; hp = l > 0; hn = l < 2047; }
        float val[3][2];
#pragma unroll
        for (int part = 0; part < 3; ++part) {
            const int ch = part * 1024 + h * 128 + 2 * F.lane;
            const bf16* pc = P + (size_t)t * NPAD + PC_QKV + ch;
            const unsigned x0 = *(const unsigned*)pc;
            const unsigned xm = hp ? *(const unsigned*)(pc - NPAD) : 0u;
            const unsigned xp = hn ? *(const unsigned*)(pc + NPAD) : 0u;
            const f32x2 w0 = *(const f32x2*)(cw + ch), w1 = *(const f32x2*)(cw + 3072 + ch), w2 = *(const f32x2*)(cw + 2 * 3072 + ch);
            val[part][0] = siluf_(w0.x * bflo(xm) + w1.x * bflo(x0) + w2.x * bflo(xp));
            val[part][1] = siluf_(w0.y * bfhi(xm) + w1.y * bfhi(x0) + w2.y * bfhi(xp));
        }
        const float qs = rsqrtf(wave_sum(val[0][0] * val[0][0] + val[0][1] * val[0][1]) + EPS) * 0.08838834764831845f;
        const float ks = rsqrtf(wave_sum(val[1][0] * val[1][0] + val[1][1] * val[1][1]) + EPS);
        bf16* o = qkv + (size_t)t * 3072 + h * 128 + 2 * F.lane;
        *(unsigned*)o = pk2(val[0][0] * qs, val[0][1] * qs);
        *(unsigned*)(o + 1024) = pk2(val[1][0] * ks, val[1][1] * ks);
        *(unsigned*)(o + 2048) = pk2(val[2][0], val[2][1]);
        if (h == 0 && F.lane < 32) {
            const int idx = F.lane, kind = idx >> 4, dh = idx & 15;
            const float raw = bf2f(P[(size_t)t * NPAD + PC_BA + idx]);
            float o2;
            if (kind == 0) o2 = 1.f / (1.f + expf(-raw));
            else { const float xx = raw + inp(I_DTB)[layer * 16 + dh]; const float sp = xx > 20.f ? xx : log1pf(expf(xx)); o2 = -expf(inp(I_ALOG)[layer * 16 + dh]) * sp; }
            bg[(size_t)t * 32 + idx] = o2;
        }
    }
}


typedef short bf16x8v __attribute__((ext_vector_type(8)));
typedef unsigned short u16x4v __attribute__((ext_vector_type(4)));
__device__ __forceinline__ int dn_tok(int b, int dir, int s) {
    if (s < CTXL) return b * CTXL + (dir ? (CTXL - 1 - s) : s);
    const int m = s - CTXL; return TC + b * SEQ + (dir ? (SEQ - 1 - m) : m);
}
__device__ __forceinline__ pg8::f32x4 mfma16(bf16x8v a, bf16x8v b, pg8::f32x4 c) { return __builtin_amdgcn_mfma_f32_16x16x32_bf16(a, b, c, 0, 0, 0); }
__device__ __forceinline__ bf16x8v frag_tr(unsigned lds_base, int pitch, int r0, int c0, int lane) {
    const int g = lane >> 4, q = (lane & 15) >> 2, p = lane & 3;
    const unsigned a0 = lds_base + (unsigned)((r0 + 8 * g + q) * pitch + (c0 + 4 * p) * 2);
    u16x4v lo, hi;
    asm volatile("ds_read_b64_tr_b16 %0, %2\n\tds_read_b64_tr_b16 %1, %3\n\ts_waitcnt lgkmcnt(0)" : "=&v"(lo), "=&v"(hi) : "v"(a0), "v"(a0 + 4u * (unsigned)pitch) : "memory");
    bf16x8v r; r[0] = (short)lo[0]; r[1] = (short)lo[1]; r[2] = (short)lo[2]; r[3] = (short)lo[3]; r[4] = (short)hi[0]; r[5] = (short)hi[1]; r[6] = (short)hi[2]; r[7] = (short)hi[3];
    return r;
}
__device__ __forceinline__ void ph_dn_a(const Args& A, const Frame& F, int layer, unsigned char* ws_in) {
    for (int unit = F.NGW - 1 - F.gw; unit < DN_UNITS; unit += F.NGW) {
        int lane = F.lane; asm volatile("" : "+v"(lane));
        unsigned char* ws = ws_in; asm volatile("" : "+s"(ws));
        const bf16* qkv = (const bf16*)(ws + WS_B + WB_QKV);
        const float* bg = (const float*)(ws + WS_B + WB_BG);
        unsigned char* dnu = ws + WS_B + WB_DNU;
        const int l15 = lane & 15, g4 = lane >> 4;
        LAS unsigned char* wl = F.lds + F.wave * 17408;
        LAS float* XA = (LAS float*)wl;
        LAS unsigned char* XK = wl;
        LAS unsigned char* TL = wl + 8704;
        LAS float* tab = (LAS float*)(wl + 8704 + 8192);
        const int c = unit % 36, dir = (unit / 36) & 1, h = (unit / 72) & 7, b = unit / 576;
        const int ti = dn_tok(b, dir, 64 * c + lane);
        const float beta = bg[(size_t)ti * 32 + dir * 8 + h], gi = bg[(size_t)ti * 32 + 16 + dir * 8 + h];
        float gc = gi;
#pragma unroll
        for (int o = 1; o < 64; o <<= 1) { const float t = __int_as_float(__builtin_amdgcn_ds_bpermute(((lane - o) & 63) << 2, __float_as_int(gc))); if (lane >= o) gc += t; }
        const float glast = __int_as_float(__builtin_amdgcn_readlane(__float_as_int(gc), 63));
        tab[lane] = gc; tab[64 + lane] = beta;
        float* SC = (float*)(dnu + DNU_SC) + (size_t)unit * 256;
        SC[lane] = __expf(gc); SC[64 + lane] = __expf(glast - gc); if (lane == 0) SC[128] = __expf(glast);
        LDS_WAIT();
        bf16x8v KF[4][4];
        int tokr[4];
#pragma unroll
        for (int rt = 0; rt < 4; ++rt) { tokr[rt] = dn_tok(b, dir, 64 * c + 16 * rt + l15);
#pragma unroll
            for (int ks = 0; ks < 4; ++ks) KF[rt][ks] = *(const bf16x8v*)(qkv + (size_t)tokr[rt] * 3072 + 1024 + h * 128 + 32 * ks + 8 * g4); }
        bf16* QKo = (bf16*)(dnu + DNU_QK) + (size_t)unit * 4096;
#pragma unroll
        for (int it = 0; it < 4; ++it) {
            bf16x8v QF[4];
#pragma unroll
            for (int ks = 0; ks < 4; ++ks) QF[ks] = *(const bf16x8v*)(qkv + (size_t)tokr[it] * 3072 + h * 128 + 32 * ks + 8 * g4);
            const int i = 16 * it + l15; const float gci = tab[i];
#pragma unroll
            for (int jt = 0; jt < 4; ++jt) {
                u32x2 w = (u32x2){0u, 0u};
                if (jt <= it) {
                    pg8::f32x4 acc = (pg8::f32x4){0.f, 0.f, 0.f, 0.f};
#pragma unroll
                    for (int ks = 0; ks < 4; ++ks) acc = mfma16(KF[jt][ks], QF[ks], acc);
                    const int j0 = 16 * jt + 4 * g4; const f32x4 gcj = *(const LAS f32x4*)(tab + j0);
                    float v[4];
#pragma unroll
                    for (int r = 0; r < 4; ++r) v[r] = (j0 + r <= i) ? acc[r] * __expf(gci - gcj[r]) : 0.f;
                    w.x = pk2(v[0], v[1]); w.y = pk2(v[2], v[3]);
                }
                *(u32x2*)(QKo + (size_t)i * 64 + 16 * jt + 4 * g4) = w;
            }
            asm volatile("" ::: "memory");
        }
        float Tc[64];
#pragma unroll
        for (int hf = 0; hf < 2; ++hf) {
#pragma unroll
            for (int it2 = 0; it2 < 2; ++it2) { const int it = 2 * hf + it2; const int i = 16 * it + l15; const float gci = tab[i], bi = tab[64 + i];
#pragma unroll
                for (int jt = 0; jt < 4; ++jt) if (jt <= it) {
                    pg8::f32x4 acc = (pg8::f32x4){0.f, 0.f, 0.f, 0.f};
#pragma unroll
                    for (int ks = 0; ks < 4; ++ks) acc = mfma16(KF[jt][ks], KF[it][ks], acc);
                    const int j0 = 16 * jt + 4 * g4; const f32x4 gcj = *(const LAS f32x4*)(tab + j0);
                    f32x4 o;
#pragma unroll
                    for (int r = 0; r < 4; ++r) o[r] = bi * acc[r] * __expf(fminf(gci - gcj[r], 0.f));
                    *(LAS f32x4*)(XA + (16 * it2 + l15) * 68 + j0) = o;
                } }
            LDS_WAIT();
#pragma unroll
            for (int ii = 0; ii < 32; ++ii) { const int i = 32 * hf + ii;
                float t = (i == lane) ? 1.f : 0.f;
#pragma unroll
                for (int q = 0; q < (i + 3) / 4; ++q) { const f32x4 a = *(const LAS f32x4*)(XA + ii * 68 + 4 * q);
#pragma unroll
                    for (int r = 0; r < 4; ++r) if (4 * q + r < i) t -= a[r] * Tc[4 * q + r]; }
                Tc[i] = t; asm volatile("" ::: "memory"); }
            LDS_WAIT();
        }
#pragma unroll
        for (int i = 0; i < 64; ++i) *(LAS bf16*)(TL + i * 128 + lane * 2) = (bf16)f2bf(Tc[i] * beta);
        LDS_WAIT();
        const unsigned xk_addr = (unsigned)(size_t)XK;
        bf16* Wo = (bf16*)(dnu + DNU_W) + (size_t)unit * 8192;
        bf16* KTo = (bf16*)(dnu + DNU_KT) + (size_t)unit * 8192;
        bf16* UTo = (bf16*)(dnu + DNU_UT) + (size_t)unit * 8192;
#pragma unroll
        for (int pass = 0; pass < 2; ++pass) {
#pragma unroll
          for (int chf = 0; chf < 2; ++chf) {
            pg8::f32x4 acc[4][4];
#pragma unroll
            for (int a = 0; a < 4; ++a)
#pragma unroll
                for (int bq = 0; bq < 4; ++bq) acc[a][bq] = (pg8::f32x4){0.f, 0.f, 0.f, 0.f};
#pragma unroll
            for (int ks = 0; ks < 2; ++ks) {
#pragma unroll
                for (int q = 0; q < 8; ++q) { const int n = lane + 64 * q, row = n >> 4, ch = n & 15;
                    const int tk = dn_tok(b, dir, 64 * c + 32 * ks + row);
                    const u32x4 d = *(const u32x4*)(qkv + (size_t)tk * 3072 + (pass ? 2048 : 1024) + h * 128 + 8 * ch);
                    *(LAS u32x4*)(XK + row * 272 + 16 * ch) = d; }
                LDS_WAIT();
                bf16x8v TF[4];
#pragma unroll
                for (int it = 0; it < 4; ++it) { u32x4 t = *(const LAS u32x4*)(TL + (16 * it + l15) * 128 + (32 * ks + 8 * g4) * 2);
                    if (pass == 0) { const f32x4 g0 = *(const LAS f32x4*)(tab + 32 * ks + 8 * g4), g1 = *(const LAS f32x4*)(tab + 32 * ks + 8 * g4 + 4);
                        t.x = pk2(bflo(t.x) * __expf(g0[0]), bfhi(t.x) * __expf(g0[1])); t.y = pk2(bflo(t.y) * __expf(g0[2]), bfhi(t.y) * __expf(g0[3]));
                        t.z = pk2(bflo(t.z) * __expf(g1[0]), bfhi(t.z) * __expf(g1[1])); t.w = pk2(bflo(t.w) * __expf(g1[2]), bfhi(t.w) * __expf(g1[3])); }
                    TF[it] = __builtin_bit_cast(bf16x8v, t); }
#pragma unroll
                for (int c4 = 0; c4 < 4; ++c4) { const int ct = 4 * chf + c4;
                    const bf16x8v XF = frag_tr(xk_addr, 272, 0, 16 * ct, lane);
                    if (pass == 0) { *(bf16x8v*)(KTo + (size_t)(16 * ct + l15) * 64 + 32 * ks + 8 * g4) = XF;
#pragma unroll
                        for (int it = 0; it < 4; ++it) acc[c4][it] = mfma16(XF, TF[it], acc[c4][it]); }
                    else {
#pragma unroll
                        for (int it = 0; it < 4; ++it) acc[c4][it] = mfma16(TF[it], XF, acc[c4][it]); }
                }
                LDS_WAIT();
            }
#pragma unroll
            for (int c4 = 0; c4 < 4; ++c4)
#pragma unroll
                for (int it = 0; it < 4; ++it) { const int ct = 4 * chf + c4; const pg8::f32x4 a = acc[c4][it]; u32x2 w; w.x = pk2(a[0], a[1]); w.y = pk2(a[2], a[3]);
                    if (pass == 0) *(u32x2*)(Wo + (size_t)(16 * it + l15) * 128 + 16 * ct + 4 * g4) = w;
                    else *(u32x2*)(UTo + (size_t)(16 * ct + l15) * 64 + 16 * it + 4 * g4) = w; }
            asm volatile("" ::: "memory");
          }
        }
    }
}

__device__ __forceinline__ void ph_dn_b(const Args& A, const Frame& F, int layer) {
    unsigned char* ws = A.ws; asm volatile("" : "+s"(ws));
    const bf16* qkv = (const bf16*)(ws + WS_B + WB_QKV);
    const unsigned char* dnu = ws + WS_B + WB_DNU;
    float* obase = (float*)(ws + WS_B + WB_O);
    const int lane = F.lane, l15 = lane & 15, g4 = lane >> 4, w = F.wave, mt = w >> 1, nt = w & 1, kt = w;
    LAS unsigned char* ST = F.lds;
    LAS unsigned char* VN = F.lds + 8704;
    LAS unsigned char* VS = F.lds + 8704 + 4608;
    for (int item = F.vcu; item < 256; item += F.G) {
        const int seq = item >> 2, vd0 = (item & 3) * 32, dir = seq & 1, h = (seq >> 1) & 7, b = seq >> 4;
        float* ob = obase + (size_t)dir * TT * 1024;
        for (int i = F.tid; i < 8704 / 4; i += 512) ((LAS unsigned*)ST)[i] = 0u;
        pg8::f32x4 accS[2]; accS[0] = (pg8::f32x4){0.f, 0.f, 0.f, 0.f}; accS[1] = accS[0];
        __syncthreads();
        bf16x8v WF[4], QF[4], QKF[2], KTF[2]; u32x2 Uc; f32x4 gam, ee; float glast;
        {   const size_t unit = (size_t)seq * 36;
            const int tq = dn_tok(b, dir, 16 * mt + l15);
#pragma unroll
            for (int ks = 0; ks < 4; ++ks) { WF[ks] = *(const bf16x8v*)((const bf16*)(dnu + DNU_W) + unit * 8192 + (size_t)(16 * mt + l15) * 128 + 32 * ks + 8 * g4);
                QF[ks] = *(const bf16x8v*)(qkv + (size_t)tq * 3072 + h * 128 + 32 * ks + 8 * g4); }
#pragma unroll
            for (int ks = 0; ks < 2; ++ks) { QKF[ks] = *(const bf16x8v*)((const bf16*)(dnu + DNU_QK) + unit * 4096 + (size_t)(16 * mt + l15) * 64 + 32 * ks + 8 * g4);
                KTF[ks] = *(const bf16x8v*)((const bf16*)(dnu + DNU_KT) + unit * 8192 + (size_t)(16 * kt + l15) * 64 + 32 * ks + 8 * g4); }
            Uc = *(const u32x2*)((const bf16*)(dnu + DNU_UT) + unit * 8192 + (size_t)(vd0 + 16 * nt + l15) * 64 + 16 * mt + 4 * g4);
            const float* SC = (const float*)(dnu + DNU_SC) + unit * 256;
            gam = *(const f32x4*)(SC + 16 * mt + 4 * g4); ee = *(const f32x4*)(SC + 64 + 16 * mt + 4 * g4); glast = SC[128]; }
        for (int c = 0; c < 36; ++c) {
            bf16x8v cW[4], cQ[4], cQK[2], cKT[2]; const u32x2 cU = Uc; const f32x4 cgam = gam, cee = ee; const float cgl = glast;
#pragma unroll
            for (int ks = 0; ks < 4; ++ks) { cW[ks] = WF[ks]; cQ[ks] = QF[ks]; }
#pragma unroll
            for (int ks = 0; ks < 2; ++ks) { cQK[ks] = QKF[ks]; cKT[ks] = KTF[ks]; }
            if (c + 1 < 36) { const size_t unit = (size_t)seq * 36 + c + 1;
                const int tq = dn_tok(b, dir, 64 * (c + 1) + 16 * mt + l15);
#pragma unroll
                for (int ks = 0; ks < 4; ++ks) { WF[ks] = *(const bf16x8v*)((const bf16*)(dnu + DNU_W) + unit * 8192 + (size_t)(16 * mt + l15) * 128 + 32 * ks + 8 * g4);
                    QF[ks] = *(const bf16x8v*)(qkv + (size_t)tq * 3072 + h * 128 + 32 * ks + 8 * g4); }
#pragma unroll
                for (int ks = 0; ks < 2; ++ks) { QKF[ks] = *(const bf16x8v*)((const bf16*)(dnu + DNU_QK) + unit * 4096 + (size_t)(16 * mt + l15) * 64 + 32 * ks + 8 * g4);
                    KTF[ks] = *(const bf16x8v*)((const bf16*)(dnu + DNU_KT) + unit * 8192 + (size_t)(16 * kt + l15) * 64 + 32 * ks + 8 * g4); }
                Uc = *(const u32x2*)((const bf16*)(dnu + DNU_UT) + unit * 8192 + (size_t)(vd0 + 16 * nt + l15) * 64 + 16 * mt + 4 * g4);
                const float* SC = (const float*)(dnu + DNU_SC) + unit * 256;
                gam = *(const f32x4*)(SC + 16 * mt + 4 * g4); ee = *(const f32x4*)(SC + 64 + 16 * mt + 4 * g4); glast = SC[128]; }
            pg8::f32x4 P = (pg8::f32x4){0.f, 0.f, 0.f, 0.f}, O1 = P;
#pragma unroll
            for (int ks = 0; ks < 4; ++ks) { const bf16x8v SF = *(const LAS bf16x8v*)(ST + (16 * nt + l15) * 272 + (32 * ks + 8 * g4) * 2);
                P = mfma16(cW[ks], SF, P); O1 = mfma16(cQ[ks], SF, O1); }
            float vn[4];
            vn[0] = bflo(cU.x) - P[0]; vn[1] = bfhi(cU.x) - P[1]; vn[2] = bflo(cU.y) - P[2]; vn[3] = bfhi(cU.y) - P[3];
            { u32x2 a; a.x = pk2(vn[0], vn[1]); a.y = pk2(vn[2], vn[3]); *(LAS u32x2*)(VN + (16 * nt + l15) * 144 + (16 * mt + 4 * g4) * 2) = a;
              u32x2 e; e.x = pk2(vn[0] * cee[0], vn[1] * cee[1]); e.y = pk2(vn[2] * cee[2], vn[3] * cee[3]); *(LAS u32x2*)(VS + (16 * nt + l15) * 144 + (16 * mt + 4 * g4) * 2) = e; }
            __syncthreads();
            pg8::f32x4 O2 = (pg8::f32x4){0.f, 0.f, 0.f, 0.f};
#pragma unroll
            for (int ks = 0; ks < 2; ++ks) { const bf16x8v VF = *(const LAS bf16x8v*)(VN + (16 * nt + l15) * 144 + (32 * ks + 8 * g4) * 2); O2 = mfma16(cQK[ks], VF, O2); }
#pragma unroll
            for (int r = 0; r < 4; ++r) { const int tk = dn_tok(b, dir, 64 * c + 16 * mt + 4 * g4 + r); ob[(size_t)tk * 1024 + h * 128 + vd0 + 16 * nt + l15] = cgam[r] * O1[r] + O2[r]; }
#pragma unroll
            for (int n2 = 0; n2 < 2; ++n2) { pg8::f32x4 a = accS[n2] * cgl;
#pragma unroll
                for (int ks = 0; ks < 2; ++ks) { const bf16x8v VF = *(const LAS bf16x8v*)(VS + (16 * n2 + l15) * 144 + (32 * ks + 8 * g4) * 2); a = mfma16(cKT[ks], VF, a); }
                accS[n2] = a;
                u32x2 sw; sw.x = pk2(a[0], a[1]); sw.y = pk2(a[2], a[3]); *(LAS u32x2*)(ST + (16 * n2 + l15) * 272 + (16 * kt + 4 * g4) * 2) = sw; }
            __syncthreads();
        }
    }
    s5_out(F, ws);
}


struct S5Lam { float abr, abi, cr, ci, lrs, lis; };
__device__ __forceinline__ S5Lam s5_lam(int layer, int dir, int g, int p) {
    const size_t pg = (size_t)(layer * 2 + dir) * 64 + g;
    const float lr = inp(I_LAMRE)[pg * 64 + p], li = inp(I_LAMIM)[pg * 64 + p], step = expf(inp(I_LOGSTEP)[pg]);
    S5Lam L; L.lrs = lr * step; L.lis = li * step;
    const float mag = expf(L.lrs); L.abr = mag * cosf(L.lis); L.abi = mag * sinf(L.lis);
    const float den = lr * lr + li * li, nr = L.abr - 1.f; L.cr = (nr * lr + L.abi * li) / den; L.ci = (L.abi * lr - nr * li) / den;
    return L;
}
__device__ __forceinline__ void s5_pow(const S5Lam& L, int n, float& pr, float& pi) { const float m = expf(L.lrs * (float)n); float sn, cs; sincosf(L.lis * (float)n, &sn, &cs); pr = m * cs; pi = m * sn; }
__device__ __forceinline__ void s5_tables(const Frame& F, int layer, unsigned char* ws) {
    unsigned char* sb = ws + WS_B + WB_S5;
    bf16* Kc = (bf16*)(sb + S5_KC); bf16* Wst = (bf16*)(sb + S5_WST); bf16* Wout = (bf16*)(sb + S5_WOUT); float* L32 = (float*)(sb + S5_L32);
    const int gt = F.vcu * 512 + F.tid, NT = F.G * 512;
    for (int it = gt; it < 64 * 63 * 16; it += NT) {
        const int j = it & 15, l = (it >> 4) % 63, g = it / (63 * 16);
        float acc[16];
#pragma unroll
        for (int q = 0; q < 16; ++q) acc[q] = 0.f;
        for (int d = 0; d < 2; ++d) {
            if ((d == 0 && l < 31) || (d == 1 && l > 31)) continue;
            const int tau = d == 0 ? l - 31 : 31 - l;
            const size_t pg = (size_t)(layer * 2 + d) * 64 + g;
            for (int p = 0; p < 64; ++p) {
                const S5Lam L = s5_lam(layer, d, g, p);
                float pr, pi; s5_pow(L, tau, pr, pi);
                const float c_r = inp(I_CRE)[(pg * 16 + j) * 64 + p], c_i = inp(I_CIM)[(pg * 16 + j) * 64 + p];
                const float tr = c_r * pr - c_i * pi, ti = c_r * pi + c_i * pr;
                const float ur = tr * L.cr - ti * L.ci, ui = tr * L.ci + ti * L.cr;
                const float* br = inp(I_BRE) + (pg * 64 + p) * 16; const float* bi = inp(I_BIM) + (pg * 64 + p) * 16;
#pragma unroll
                for (int q = 0; q < 16; ++q) acc[q] += ur * br[q] - ui * bi[q];
            }
        }
        if (l == 31) acc[j] += inp(I_S5D)[(size_t)layer * 1024 + g * 16 + j];
        u32x4 w0, w1;
        w0.x = pk2(acc[0], acc[1]); w0.y = pk2(acc[2], acc[3]); w0.z = pk2(acc[4], acc[5]); w0.w = pk2(acc[6], acc[7]);
        w1.x = pk2(acc[8], acc[9]); w1.y = pk2(acc[10], acc[11]); w1.z = pk2(acc[12], acc[13]); w1.w = pk2(acc[14], acc[15]);
        bf16* o = Kc + ((size_t)(g * 63 + l) * 16 + j) * 16; *(u32x4*)o = w0; *(u32x4*)(o + 8) = w1;
    }
    for (int it = gt; it < 64 * 2 * 32 * 64; it += NT) {
        const int p = it & 63, r = (it >> 6) & 31, d = (it >> 11) & 1, g = it >> 12;
        const size_t pg = (size_t)(layer * 2 + d) * 64 + g;
        const S5Lam L = s5_lam(layer, d, g, p);
        float pr, pi; s5_pow(L, d == 0 ? 31 - r : r, pr, pi);
        const float qr = pr * L.cr - pi * L.ci, qi = pr * L.ci + pi * L.cr;
        const float* br = inp(I_BRE) + (pg * 64 + p) * 16; const float* bi = inp(I_BIM) + (pg * 64 + p) * 16;
        float wr_[16], wi_[16];
#pragma unroll
        for (int q = 0; q < 16; ++q) { wr_[q] = qr * br[q] - qi * bi[q]; wi_[q] = qr * bi[q] + qi * br[q]; }
        bf16* o = Wst + ((size_t)(g * 2 + d) * 128 + p) * 512 + r * 16;
        u32x4 a0, a1, b0, b1;
        a0.x = pk2(wr_[0], wr_[1]); a0.y = pk2(wr_[2], wr_[3]); a0.z = pk2(wr_[4], wr_[5]); a0.w = pk2(wr_[6], wr_[7]);
        a1.x = pk2(wr_[8], wr_[9]); a1.y = pk2(wr_[10], wr_[11]); a1.z = pk2(wr_[12], wr_[13]); a1.w = pk2(wr_[14], wr_[15]);
        b0.x = pk2(wi_[0], wi_[1]); b0.y = pk2(wi_[2], wi_[3]); b0.z = pk2(wi_[4], wi_[5]); b0.w = pk2(wi_[6], wi_[7]);
        b1.x = pk2(wi_[8], wi_[9]); b1.y = pk2(wi_[10], wi_[11]); b1.z = pk2(wi_[12], wi_[13]); b1.w = pk2(wi_[14], wi_[15]);
        *(u32x4*)o = a0; *(u32x4*)(o + 8) = a1; *(u32x4*)(o + 64 * 512) = b0; *(u32x4*)(o + 64 * 512 + 8) = b1;
    }
    for (int it = gt; it < 64 * 2 * 32 * 64; it += NT) {
        const int p = it & 63, sp = (it >> 6) & 31, d = (it >> 11) & 1, g = it >> 12;
        const size_t pg = (size_t)(layer * 2 + d) * 64 + g;
        const S5Lam L = s5_lam(layer, d, g, p);
        float pr, pi; s5_pow(L, d == 0 ? sp + 1 : 32 - sp, pr, pi);
        bf16* o = Wout + ((size_t)(g * 2 + d) * 512 + sp * 16) * 128 + p;
#pragma unroll
        for (int j = 0; j < 16; ++j) { const float c_r = inp(I_CRE)[(pg * 16 + j) * 64 + p], c_i = inp(I_CIM)[(pg * 16 + j) * 64 + p];
            o[(size_t)j * 128] = (bf16)f2bf(c_r * pr - c_i * pi); o[(size_t)j * 128 + 64] = (bf16)f2bf(-(c_r * pi + c_i * pr)); }
    }
    for (int it = gt; it < 64 * 2 * 64; it += NT) { const int p = it & 63, d = (it >> 6) & 1, g = it >> 7; const S5Lam L = s5_lam(layer, d, g, p); float pr, pi; s5_pow(L, 32, pr, pi); L32[2 * it] = pr; L32[2 * it + 1] = pi; }
}
__device__ __forceinline__ void s5_state(const Frame& F, unsigned char* ws) {
    const unsigned char* sb = ws + WS_B + WB_S5;
    const int l15 = F.lane & 15, g4 = F.lane >> 4, w = F.wave;
    for (int item = F.vcu; item < 256; item += F.G) {
        const int nh = item & 1, d = (item >> 1) & 1, g = item >> 2;
        const bf16* Arow = (const bf16*)(sb + S5_WST) + ((size_t)(g * 2 + d) * 128 + 16 * w + l15) * 512 + 8 * g4;
        const bf16* Brow = (const bf16*)(sb + S5_UG) + ((size_t)g * S5N + nh * 144 + l15) * 512 + 8 * g4;
        pg8::f32x4 acc[9];
#pragma unroll
        for (int q = 0; q < 9; ++q) acc[q] = (pg8::f32x4){0.f, 0.f, 0.f, 0.f};
#pragma unroll 2
        for (int ks = 0; ks < 16; ++ks) { const bf16x8v a = *(const bf16x8v*)(Arow + 32 * ks);
#pragma unroll
            for (int q = 0; q < 9; ++q) { const bf16x8v bq = *(const bf16x8v*)(Brow + (size_t)(16 * q) * 512 + 32 * ks); acc[q] = mfma16(a, bq, acc[q]); } }
        float* So = (float*)(sb + S5_SLOC) + ((size_t)(g * 2 + d) * S5N + nh * 144 + l15) * 128 + 16 * w + 4 * g4;
#pragma unroll
        for (int q = 0; q < 9; ++q) *(f32x4*)(So + (size_t)(16 * q) * 128) = acc[q];
    }
}
__device__ __forceinline__ void s5_carry(const Frame& F, unsigned char* ws) {
    const unsigned char* sb = ws + WS_B + WB_S5;
    if (F.gw >= 512) return;
    const int p = F.lane, b = F.gw & 3, d = (F.gw >> 2) & 1, g = F.gw >> 3;
    const float* L32 = (const float*)(sb + S5_L32) + 2 * ((g * 2 + d) * 64 + p);
    const float lr = L32[0], li = L32[1];
    const float* Sl = (const float*)(sb + S5_SLOC) + ((size_t)(g * 2 + d) * S5N + b * 72) * 128 + p;
    bf16* Hi = (bf16*)(sb + S5_HIN) + ((size_t)(g * 2 + d) * S5N + b * 72) * 128 + p;
    float hr = 0.f, hi = 0.f;
#pragma unroll 4
    for (int st = 0; st < 72; ++st) {
        const int ch = d == 0 ? st : (st < 8 ? 7 - st : 79 - st);
        Hi[(size_t)ch * 128] = (bf16)f2bf(hr); Hi[(size_t)ch * 128 + 64] = (bf16)f2bf(hi);
        const float sr = Sl[(size_t)ch * 128], si = Sl[(size_t)ch * 128 + 64];
        const float nr = lr * hr - li * hi + sr, ni = lr * hi + li * hr + si; hr = nr; hi = ni;
    }
}
__device__ __forceinline__ void s5_out(const Frame& F, unsigned char* ws) {
    const unsigned char* sb = ws + WS_B + WB_S5;
    bf16* gb = (bf16*)(ws + WS_B + WB_G);
    const int l15 = F.lane & 15, g4 = F.lane >> 4, w = F.wave;
    LAS unsigned char* KL = F.lds;
    for (int item = F.vcu; item < 256; item += F.G) {
        const int mq = item & 3, g = item >> 2;
        __syncthreads();
        for (int i = F.tid; i < 63 * 32; i += 512) *((LAS u32x4*)KL + i) = *((const u32x4*)(sb + S5_KC + (size_t)g * 63 * 512) + i);
        __syncthreads();
        const int ntn = (w < 2) ? 3 : 2;
        pg8::f32x4 acc[8][3];
#pragma unroll
        for (int m = 0; m < 8; ++m)
#pragma unroll
            for (int q = 0; q < 3; ++q) acc[m][q] = (pg8::f32x4){0.f, 0.f, 0.f, 0.f};
        const bf16* Ub = (const bf16*)(sb + S5_UG) + ((size_t)g * S5N + 16 * w + l15) * 512 + 8 * g4;
#pragma unroll 2
        for (int ks = 0; ks < 16; ++ks) {
            bf16x8v bq[3];
#pragma unroll
            for (int q = 0; q < 3; ++q) if (q < ntn) bq[q] = *(const bf16x8v*)(Ub + (size_t)(128 * q) * 512 + 32 * ks);
            const int r = 2 * ks + (g4 >> 1);
#pragma unroll
            for (int m = 0; m < 8; ++m) { const int sp = 8 * mq + m, l = sp - r + 31;
                const bf16x8v a = *(const LAS bf16x8v*)(KL + ((l * 16 + l15) * 16 + 8 * (g4 & 1)) * 2);
#pragma unroll
                for (int q = 0; q < 3; ++q) if (q < ntn) acc[m][q] = mfma16(a, bq[q], acc[m][q]); }
        }
#pragma unroll
        for (int d = 0; d < 2; ++d) {
            const bf16* Hb = (const bf16*)(sb + S5_HIN) + ((size_t)(g * 2 + d) * S5N + 16 * w + l15) * 128 + 8 * g4;
            const bf16* Wo = (const bf16*)(sb + S5_WOUT) + ((size_t)(g * 2 + d) * 512 + (8 * mq) * 16 + l15) * 128 + 8 * g4;
#pragma unroll
            for (int ks = 0; ks < 4; ++ks) {
                bf16x8v bq[3];
#pragma unroll
                for (int q = 0; q < 3; ++q) if (q < ntn) bq[q] = *(const bf16x8v*)(Hb + (size_t)(128 * q) * 128 + 32 * ks);
#pragma unroll
                for (int m = 0; m < 8; ++m) { const bf16x8v a = *(const bf16x8v*)(Wo + (size_t)(16 * m) * 128 + 32 * ks);
#pragma unroll
                    for (int q = 0; q < 3; ++q) if (q < ntn) acc[m][q] = mfma16(a, bq[q], acc[m][q]); }
            }
        }
#pragma unroll
        for (int q = 0; q < 3; ++q) if (q < ntn) {
            const int n = 16 * (w + 8 * q) + l15, b = n / 72, ch = n % 72;
#pragma unroll
            for (int m = 0; m < 8; ++m) { const int sp = 8 * mq + m;
                const int t = ch < 8 ? b * CTXL + ch * 32 + sp : TC + b * SEQ + sp * 64 + (ch - 8);
                const pg8::f32x4 a = acc[m][q];
                u32x2 o; o.x = pk2(gelu_tanh(a[0]), gelu_tanh(a[1])); o.y = pk2(gelu_tanh(a[2]), gelu_tanh(a[3]));
                *(u32x2*)(gb + (size_t)t * 1024 + g * 16 + 4 * g4) = o; }
        }
    }
}

__device__ __forceinline__ void ph_scan(const Args& A, const Frame& F, int layer) {
    unsigned char* ws = A.ws; asm volatile("" : "+s"(ws));
    s5_carry(F, ws);
    ph_dn_a(A, F, layer, ws);
}

__device__ __forceinline__ void ph_post(const Args& A, const Frame& F, int layer) {
    unsigned char* ws = A.ws; asm volatile("" : "+s"(ws));
    const bf16* P = (const bf16*)(ws + WS_B + WB_P);
    const float* ob = (const float*)(ws + WS_B + WB_O);
    bf16* dno = (bf16*)(ws + WS_B + WB_DNO);
    const int c0 = 16 * F.lane;
    for (int t = F.gw; t < TT; t += F.NGW) {
        {
            float o[16]; float ss = 0.f;
#pragma unroll
            for (int q = 0; q < 4; ++q) { const f32x4 a = *(const f32x4*)(ob + (size_t)t * 1024 + c0 + 4 * q), bq = *(const f32x4*)(ob + (size_t)(TT + t) * 1024 + c0 + 4 * q);
#pragma unroll
                for (int j = 0; j < 4; ++j) { o[4 * q + j] = a[j] + bq[j]; ss += o[4 * q + j] * o[4 * q + j]; } }
            ss += __shfl_xor(ss, 1); ss += __shfl_xor(ss, 2); ss += __shfl_xor(ss, 4);
            const float r = rsqrtf(ss * (1.f / 128.f) + EPS);
            const u32x4 za = *(const u32x4*)(P + (size_t)t * NPAD + PC_Z + c0), zb = *(const u32x4*)(P + (size_t)t * NPAD + PC_Z + c0 + 8);
            float z[16];
            z[0] = bflo(za.x); z[1] = bfhi(za.x); z[2] = bflo(za.y); z[3] = bfhi(za.y); z[4] = bflo(za.z); z[5] = bfhi(za.z); z[6] = bflo(za.w); z[7] = bfhi(za.w);
            z[8] = bflo(zb.x); z[9] = bfhi(zb.x); z[10] = bflo(zb.y); z[11] = bfhi(zb.y); z[12] = bflo(zb.z); z[13] = bfhi(zb.z); z[14] = bflo(zb.w); z[15] = bfhi(zb.w);
            const float* nw = inp(I_DNNORM) + (size_t)layer * 128 + (c0 & 127);
            float e[16];
#pragma unroll
            for (int j = 0; j < 16; ++j) e[j] = o[j] * r * nw[j] * siluf_(z[j]);
            u32x4 w0, w1;
            w0.x = pk2(e[0], e[1]); w0.y = pk2(e[2], e[3]); w0.z = pk2(e[4], e[5]); w0.w = pk2(e[6], e[7]);
            w1.x = pk2(e[8], e[9]); w1.y = pk2(e[10], e[11]); w1.z = pk2(e[12], e[13]); w1.w = pk2(e[14], e[15]);
            *(u32x4*)(dno + (size_t)t * 1024 + c0) = w0; *(u32x4*)(dno + (size_t)t * 1024 + c0 + 8) = w1;
        }
    }
}

__device__ __forceinline__ void ph_row2(const Args& A, const Frame& F, int layer) {
    unsigned char* ws = A.ws; asm volatile("" : "+s"(ws));
    const float* mods = (const float*)(ws + WS_MODS) + (size_t)layer * 5 * MODW;
    const float* mix = (const float*)(ws + WS_B + WB_MIX);
    float* xc = (float*)(ws + WS_X);
    bf16* hb = (bf16*)(ws + WS_AB);
    const float* nwp = inp(I_NMPOST) + (size_t)layer * DM;
    const float* nwf = inp(I_NFPRE) + (size_t)layer * DM;
    const float* wr = inp(I_ROUTER) + (size_t)layer * DM * NE;
    int* eidx = (int*)(ws + WS_EIDX); float* wts = (float*)(ws + WS_WTS);
    unsigned* cnt = (unsigned*)(ws + WS_CTL) + CW_CNT + layer * 128;
    LAS float* hrow = (LAS float*)(F.lds + F.wave * 8192);
    const float ebias = inp(I_MBIAS)[layer * NE + F.lane];
    for (int t = F.gw; t < TT; t += F.NGW) {
        const f32x4* mr4 = (const f32x4*)(mix + (size_t)t * DM) + F.lane;
        const f32x4* xr4 = (const f32x4*)xrow_ptr(ws, layer, t) + F.lane;
        const float* mrow = mods + (size_t)mods_row(t) * MODW;
        f32x4 v[8]; float ss = 0.f;
#pragma unroll
        for (int j = 0; j < 8; ++j) { v[j] = mr4[64 * j]; ss += (v[j].x * v[j].x + v[j].y * v[j].y) + (v[j].z * v[j].z + v[j].w * v[j].w); }
        const float r = rsqrtf(wave_sum(ss) * (1.f / DM) + EPS);
        float ss2 = 0.f;
#pragma unroll
        for (int j = 0; j < 8; ++j) { const int col = 4 * (F.lane + 64 * j);
            const f32x4 w = *(const f32x4*)(nwp + col), gt = *(const f32x4*)(mrow + 2 * DM + col), xo = xr4[64 * j];
            v[j] = xo + gt * (v[j] * r * w);
            *((f32x4*)(xc + (size_t)t * DM) + F.lane + 64 * j) = v[j];
            ss2 += (v[j].x * v[j].x + v[j].y * v[j].y) + (v[j].z * v[j].z + v[j].w * v[j].w); }
        const float r2 = rsqrtf(wave_sum(ss2) * (1.f / DM) + EPS);
        u32x2* ho = (u32x2*)(hb + (size_t)t * DM) + F.lane;
#pragma unroll
        for (int j = 0; j < 8; ++j) { const int col = 4 * (F.lane + 64 * j);
            const f32x4 w = *(const f32x4*)(nwf + col), sh = *(const f32x4*)(mrow + 3 * DM + col), sc = *(const f32x4*)(mrow + 4 * DM + col);
            const f32x4 y = (v[j] * r2 * w) * (1.f + sc) + sh;
            u32x2 q; q.x = pk2(y.x, y.y); q.y = pk2(y.z, y.w); ho[64 * j] = q;
            *((LAS f32x4*)hrow + F.lane + 64 * j) = y; }
        LDS_WAIT();
        float logit = 0.f;
#pragma unroll 4
        for (int d4 = 0; d4 < DM / 4; ++d4) { const f32x4 h4 = *((const LAS f32x4*)hrow + d4);
            const float* wp = wr + (size_t)(4 * d4) * NE + F.lane;
            logit += h4.x * wp[0]; logit += h4.y * wp[NE]; logit += h4.z * wp[2 * NE]; logit += h4.w * wp[3 * NE]; }
        const float score = 1.f / (1.f + expf(-logit));
        const float sel = score + ebias;
        float m1 = sel;
        m1 = fmaxf(m1, __shfl_xor(m1, 1)); m1 = fmaxf(m1, __shfl_xor(m1, 2)); m1 = fmaxf(m1, __shfl_xor(m1, 4));
        const unsigned long long eqm = __ballot(sel == m1);
        const int gbase = F.lane & ~7;
        const unsigned gm = (unsigned)((eqm >> gbase) & 0xffull);
        const int amax = gbase + __builtin_ctz(gm);
        float s2 = (F.lane == amax) ? -__builtin_inff() : sel;
        s2 = fmaxf(s2, __shfl_xor(s2, 1)); s2 = fmaxf(s2, __shfl_xor(s2, 2)); s2 = fmaxf(s2, __shfl_xor(s2, 4));
        const float gs = m1 + s2;
        int grank = 0; const int myg = F.lane >> 3;
#pragma unroll
        for (int g2 = 0; g2 < 8; ++g2) { const float og = __shfl(gs, g2 * 8); grank += (og > gs || (og == gs && g2 < myg)) ? 1 : 0; }
        const float selm = (grank < 4) ? sel : -__builtin_inff();
        int rank = 0;
#pragma unroll 8
        for (int e2 = 0; e2 < 64; ++e2) { const float os = __shfl(selm, e2); rank += (os > selm || (os == selm && e2 < F.lane)) ? 1 : 0; }
        const bool chosen = (grank < 4) && (rank < 8);
        const float wsum = wave_sum(chosen ? score : 0.f);
        if (chosen) { eidx[(size_t)t * 8 + rank] = F.lane; wts[(size_t)t * 8 + rank] = score / wsum * 2.5f; atomicAdd(cnt + F.lane, 1u); }
        LDS_WAIT();
    }
}

__device__ __forceinline__ void ph_fill(const Args& A, const Frame& F, int layer) {
    unsigned char* ws = A.ws; asm volatile("" : "+s"(ws));
    unsigned* ctl = (unsigned*)(ws + WS_CTL);
    LAS int* off = (LAS int*)(F.lds);
    LAS int* cn = (LAS int*)(F.lds + 1024);
    if (F.tid < NEX) cn[F.tid] = (F.tid < NE) ? (int)__hip_atomic_load(ctl + CW_CNT + layer * 128 + F.tid, __ATOMIC_RELAXED, __HIP_MEMORY_SCOPE_AGENT) : TT;
    __syncthreads();
    if (F.tid == 0) {
        int o = 0;
        for (int e = 0; e < NEX; ++e) { off[e] = o; o += (cn[e] + 255) & ~255; }
        off[NEX] = o;
    }
    __syncthreads();
    int* misc = (int*)(ws + WS_MISC) + layer * 1024;
    if (blockIdx.x == 0) {
        const int ntiles = off[NEX] >> 8;
        for (int tl = F.tid; tl < ntiles; tl += 512) { int e = 0; for (int q = 0; q < NEX; ++q) if ((off[q] >> 8) <= tl) e = q; misc[tl] = e; }
        if (F.tid == 0) misc[512] = ntiles;
    }
    {
        bf16* hpz = (bf16*)(ws + WS_B + WB_HPERM);
        for (int e = 0; e < NE; ++e) { const int r0 = off[e] + cn[e], r1 = off[e + 1];
            for (int r = r0 + F.gw; r < r1; r += F.NGW) { u32x4* d = (u32x4*)(hpz + (size_t)r * DM) + F.lane;
#pragma unroll
                for (int j = 0; j < 4; ++j) d[64 * j] = (u32x4){0u, 0u, 0u, 0u}; } }
    }
    const int* eidx = (const int*)(ws + WS_EIDX);
    int* slot_of = (int*)(ws + WS_SLOT);
    const bf16* hb = (const bf16*)(ws + WS_AB);
    bf16* hp = (bf16*)(ws + WS_B + WB_HPERM);
    for (int it = F.gw; it < TT * 9; it += F.NGW) {
        const int t = it / 9, k = it % 9;
        int slot;
        if (k < 8) { const int e = eidx[(size_t)t * 8 + k]; int pos = 0;
            if (F.lane == 0) pos = (int)atomicAdd(ctl + CW_FILL + layer * 128 + e, 1u);
            pos = __builtin_amdgcn_readfirstlane(pos); slot = off[e] + pos; }
        else slot = off[NE] + t;
        if (F.lane == 0) slot_of[(size_t)t * 9 + k] = slot;
        const u32x4* s = (const u32x4*)(hb + (size_t)t * DM) + F.lane; u32x4* d = (u32x4*)(hp + (size_t)slot * DM) + F.lane;
#pragma unroll
        for (int j = 0; j < 4; ++j) d[64 * j] = s[64 * j];
    }
}

__device__ __forceinline__ void ph_comb(const Args& A, const Frame& F, int layer) {
    unsigned char* ws = A.ws; asm volatile("" : "+s"(ws));
    const float* mods = (const float*)(ws + WS_MODS) + (size_t)layer * 5 * MODW;
    const bf16* ys = (const bf16*)(ws + WS_B + WB_HPERM);
    const int* slot_of = (const int*)(ws + WS_SLOT);
    const float* wts = (const float*)(ws + WS_WTS);
    float* xc = (float*)(ws + WS_X);
    const float* nw = inp(I_NFPOST) + (size_t)layer * DM;
    const bool last = (layer == NLAYER - 1);
    for (int t = F.gw; t < TT; t += F.NGW) {
        float f[32];
#pragma unroll
        for (int j = 0; j < 32; ++j) f[j] = 0.f;
#pragma unroll
        for (int k = 0; k < 9; ++k) {
            const int slot = slot_of[(size_t)t * 9 + k]; const float w = (k < 8) ? wts[(size_t)t * 8 + k] : 1.f;
            const u32x4* yr = (const u32x4*)(ys + (size_t)slot * DM + 32 * F.lane);
#pragma unroll
            for (int q = 0; q < 4; ++q) { const u32x4 y = yr[q];
                f[8 * q + 0] += w * bflo(y.x); f[8 * q + 1] += w * bfhi(y.x); f[8 * q + 2] += w * bflo(y.y); f[8 * q + 3] += w * bfhi(y.y);
                f[8 * q + 4] += w * bflo(y.z); f[8 * q + 5] += w * bfhi(y.z); f[8 * q + 6] += w * bflo(y.w); f[8 * q + 7] += w * bfhi(y.w); }
            if (k % 3 == 2) asm volatile("" ::: "memory");
        }
        float ss = 0.f;
#pragma unroll
        for (int j = 0; j < 32; ++j) ss += f[j] * f[j];
        const float r = rsqrtf(wave_sum(ss) * (1.f / DM) + EPS);
        const float* mrow = mods + (size_t)mods_row(t) * MODW + 5 * DM;
        const int c0 = 32 * F.lane;
        float* xr = xc + (size_t)t * DM + c0;
#pragma unroll
        for (int q = 0; q < 8; ++q) { const f32x4 w = *(const f32x4*)(nw + c0 + 4 * q), gt = *(const f32x4*)(mrow + c0 + 4 * q), xo = *(const f32x4*)(xr + 4 * q);
            f32x4 y; y.x = xo.x + gt.x * (f[4 * q] * r * w.x); y.y = xo.y + gt.y * (f[4 * q + 1] * r * w.y); y.z = xo.z + gt.z * (f[4 * q + 2] * r * w.z); y.w = xo.w + gt.w * (f[4 * q + 3] * r * w.w);
            if (!last) *(f32x4*)(xr + 4 * q) = y;
            else if (t >= TC) *(f32x4*)(A.out + (size_t)(t - TC) * DM + c0 + 4 * q) = y; }
    }
}

constexpr int NPH = 15;
__device__ __forceinline__ bool ph_in(int lo, int hi, int k) { asm volatile("" : "+s"(lo), "+s"(hi)); return lo <= k && k < hi; }
constexpr int PER_PHASE_LAUNCH = MK_PER_PHASE;
#ifndef DBG_STOP
#define DBG_STOP 0
#endif

#ifndef PHMASK
#define PHMASK 0xFFFF
#endif
#define IN(k) (((PHMASK >> ((k) % NPH)) & 1) && ph_in(lo, hi, (k)))
#define GETWS const Frame F = make_frame(lds, wave_s); unsigned char* ws = args.ws; asm volatile("" : "+s"(ws)); bf16* Wb = (bf16*)(ws + WS_W)
#define SEAM(k) do { if (IN(k) && IN((k) + 1)) xcd_barrier(bar, wave_s); } while (0)
template <int LAYER>
__device__ __forceinline__ void layer_body(const Args& args, LAS unsigned char* lds, const XcdBarrier& bar, int wave_s, int lo, int hi) {
    constexpr int layer = LAYER;
        const int pb = layer * NPH;
        if (IN(pb + 0)) { const Frame F = make_frame(lds, wave_s); ph_pre(args, F, layer); } SEAM(pb + 0);
        if (IN(pb + 1)) { const Frame F = make_frame(lds, wave_s); ph_n1(args, F, layer); } SEAM(pb + 1);
        if (IN(pb + 2)) {
            GETWS;
            pg8::Gemm g{(const pg8::bf16_t*)(ws + WS_AB), Wb + WO_IN / 2, TT, NPAD, DM}; pg8::StaticOrder S; S.init(TT, NPAD, F.G, F.bx);
            EpiInProj E{(bf16*)(ws + WS_B + WB_P), (bf16*)(ws + WS_B + WB_S5 + S5_UG)};
            pg8::gemm_phase<EpiInProj, pg8::StaticOrder>(F.lds, g, S, E, nullptr, F.tid);
        } SEAM(pb + 2);
        if (IN(pb + 3)) { const Frame F = make_frame(lds, wave_s); ph_prep(args, F, layer); } SEAM(pb + 3);
        if (IN(pb + 4)) { const Frame F = make_frame(lds, wave_s); ph_scan(args, F, layer); } SEAM(pb + 4);
        if (IN(pb + 5)) { const Frame F = make_frame(lds, wave_s); ph_dn_b(args, F, layer); } SEAM(pb + 5);
        if (IN(pb + 6)) { const Frame F = make_frame(lds, wave_s); ph_post(args, F, layer); } SEAM(pb + 6);
        if (IN(pb + 7)) {
            GETWS;
            pg8::Gemm g{(const pg8::bf16_t*)(ws + WS_B + WB_G), Wb + WO_GLU / 2, TT, 1024, 1024}; pg8::StaticOrder S; S.init(TT, 1024, F.G, F.bx);
            EpiGlu E{(const bf16*)(ws + WS_B + WB_G), (bf16*)(ws + WS_B + WB_S5O)};
            pg8::gemm_phase<EpiGlu, pg8::StaticOrder>(F.lds, g, S, E, nullptr, F.tid);
        } SEAM(pb + 7);
        if (IN(pb + 8)) { GETWS;
            { pg8::Gemm g{(const pg8::bf16_t*)(ws + WS_B + WB_S5O), Wb + WO_BRS / 2, TT, DM, 1024}; pg8::StaticOrder S; S.init(TT, DM, F.G, F.bx);
              EpiBr<false> E{(const bf16*)(ws + WS_B + WB_P), PC_GS5, (float*)(ws + WS_B + WB_M1), nullptr};
              pg8::gemm_phase<EpiBr<false>, pg8::StaticOrder>(F.lds, g, S, E, nullptr, F.tid); }
            __syncthreads();
            { pg8::Gemm g{(const pg8::bf16_t*)(ws + WS_B + WB_DNO), Wb + WO_BRD / 2, TT, DM, 1024}; pg8::StaticOrder S; S.init(TT, DM, F.G, F.bx);
              EpiBr<true> E{(const bf16*)(ws + WS_B + WB_P), PC_GDN, (float*)(ws + WS_B + WB_M1), (bf16*)(ws + WS_B + WB_M)};
              pg8::gemm_phase<EpiBr<true>, pg8::StaticOrder>(F.lds, g, S, E, nullptr, F.tid); }
        } SEAM(pb + 8);
        if (IN(pb + 9)) {
            GETWS;
            pg8::Gemm g{(const pg8::bf16_t*)(ws + WS_B + WB_M), Wb + WO_OUT / 2, TT, DM, DM}; pg8::StaticOrder S; S.init(TT, DM, F.G, F.bx);
            pg8::EpiF32 E{(float*)(ws + WS_B + WB_MIX), DM, nullptr};
            pg8::gemm_phase<pg8::EpiF32, pg8::StaticOrder>(F.lds, g, S, E, nullptr, F.tid);
        } SEAM(pb + 9);
        if (IN(pb + 10)) { const Frame F = make_frame(lds, wave_s); ph_row2(args, F, layer); } SEAM(pb + 10);
        if (IN(pb + 11)) { const Frame F = make_frame(lds, wave_s); ph_fill(args, F, layer); } SEAM(pb + 11);
        if (IN(pb + 12)) {
            GETWS;
            const int* misc = (const int*)(ws + WS_MISC) + layer * 1024;
            const int ntiles = __builtin_amdgcn_readfirstlane((int)__hip_atomic_load(misc + 512, __ATOMIC_RELAXED, __HIP_MEMORY_SCOPE_AGENT));
            pg8::Gemm g{(const pg8::bf16_t*)(ws + WS_B + WB_HPERM), Wb + WO_GU / 2, ntiles * 256, 1024, DM}; MoeOrder S{ntiles, 4, F.G, F.bx, misc};
            EpiSwiglu E{(bf16*)(ws + WS_B + WB_ACT)};
            pg8::gemm_phase<EpiSwiglu, MoeOrder>(F.lds, g, S, E, nullptr, F.tid);
        } SEAM(pb + 12);
        if (IN(pb + 13)) {
            GETWS;
            const int* misc = (const int*)(ws + WS_MISC) + layer * 1024;
            const int ntiles = __builtin_amdgcn_readfirstlane((int)__hip_atomic_load(misc + 512, __ATOMIC_RELAXED, __HIP_MEMORY_SCOPE_AGENT));
            pg8::Gemm g{(const pg8::bf16_t*)(ws + WS_B + WB_ACT), Wb + WO_DN / 2, ntiles * 256, DM, EDIM}; MoeOrder S{ntiles, 8, F.G, F.bx, misc};
            EpiBf16Mod E{(bf16*)(ws + WS_B + WB_HPERM), DM, 8};
            pg8::gemm_phase<EpiBf16Mod, MoeOrder>(F.lds, g, S, E, nullptr, F.tid);
        } SEAM(pb + 13);
        if (IN(pb + 14)) { const Frame F = make_frame(lds, wave_s); ph_comb(args, F, layer); } SEAM(pb + 14);
    }

__global__ void __launch_bounds__(512, 2) hybrid_fwd(Args args) {
    extern __shared__ __attribute__((aligned(16))) unsigned char lds_raw[];
    LAS unsigned char* const lds = (LAS unsigned char*)lds_raw;
    volatile LAS unsigned* MISC = (volatile LAS unsigned*)(lds + LDS_MISC);
    const int wave_s = __builtin_amdgcn_readfirstlane((int)(threadIdx.x >> 6));
    if (threadIdx.x < 4) MISC[threadIdx.x] = 0u;
    __syncthreads();
    unsigned* ctl = (unsigned*)(args.ws + WS_CTL);
    XcdBarrier bar; bar.bar = ctl + CW_BAR; bar.x = 0; bar.st = nullptr;
    if (!PER_PHASE_LAUNCH) { bar.bar = ctl + CW_BAR; bar.x = xb_xcc_id(); bar.st = MISC; if (threadIdx.x == 0) (void)xb_add(&bar.bar[XB_XCNT(bar.x)], 1u); }
    const int lo = args.ph_lo, hi = args.ph_hi;
    layer_body<0>(args, lds, bar, wave_s, lo, hi);
    layer_body<1>(args, lds, bar, wave_s, lo, hi);
    if (DBG_STOP && lo == 1000) {
        const float* xc = (const float*)(args.ws + WS_X) + (size_t)TC * DM;
        for (size_t i = (size_t)blockIdx.x * 512 + threadIdx.x; i < (size_t)TL * DM / 4; i += (size_t)gridDim.x * 512) ((f32x4*)args.out)[i] = ((const f32x4*)xc)[i];
    }
#undef IN
#undef SEAM
}

extern "C" void kernel_launch(void* const* d_in, const int* in_sizes, int n_in, void* d_out, int out_size, void* d_ws, size_t ws_size, hipStream_t stream) {
    static int grid = 0;
    if (grid == 0) {
        if (n_in != 35 || out_size != TL * DM || ws_size < WS_END) { fprintf(stderr, "kernel_launch: unexpected shapes (n_in %d out %d ws %zu need %zu)\n", n_in, out_size, ws_size, (size_t)WS_END); grid = -1; return; }
        int dev = 0, cus = 0;
        if (hipGetDevice(&dev) != hipSuccess || hipDeviceGetAttribute(&cus, hipDeviceAttributeMultiprocessorCount, dev) != hipSuccess) { grid = -1; return; }
        if (hipFuncSetAttribute((const void*)hybrid_fwd, hipFuncAttributeMaxDynamicSharedMemorySize, LDS_BYTES) != hipSuccess) { grid = -1; return; }
        int per_cu = 0;
        (void)hipOccupancyMaxActiveBlocksPerMultiprocessor(&per_cu, (const void*)hybrid_fwd, 512, LDS_BYTES);
        (void)hipGetLastError();
        if (per_cu < 1) { fprintf(stderr, "kernel_launch: occupancy query says %d blocks per CU\n", per_cu); }
        grid = cus;
    }
    if (grid < 0) return;
    (void)hipMemsetAsync((char*)d_ws + WS_CTL, 0, CTL_ZERO_BYTES, stream);
    Args a{};
    for (int i = 0; i < 35; ++i) a.in[i] = (const float*)d_in[i];
    a.out = (float*)d_out; a.ws = (unsigned char*)d_ws;
    if (PER_PHASE_LAUNCH) {
        for (int ph = 0; ph < (DBG_STOP ? DBG_STOP : NLAYER * NPH); ++ph) { a.ph_lo = ph; a.ph_hi = ph + 1; hipLaunchKernelGGL(hybrid_fwd, dim3(grid), dim3(512), LDS_BYTES, stream, a); }
        if (DBG_STOP) { a.ph_lo = 1000; a.ph_hi = 1001; hipLaunchKernelGGL(hybrid_fwd, dim3(grid), dim3(512), LDS_BYTES, stream, a); }
    } else {
        a.ph_lo = 0; a.ph_hi = NLAYER * NPH;
        hipLaunchKernelGGL(hybrid_fwd, dim3(grid), dim3(512), LDS_BYTES, stream, a);
    }
}
```

```cpp
#include <hip/hip_runtime.h>
#include <cstdio>
#include <cstdint>
#ifndef MK_PER_PHASE
#define MK_PER_PHASE 0
#endif
#define DBG_STOP 0
#define DBG_T2 0
namespace pg8 {
#define PG8_LAS __attribute__((address_space(3)))
typedef unsigned short bf16_t;
typedef short bf16x8 __attribute__((ext_vector_type(8)));
typedef float f32x4 __attribute__((ext_vector_type(4)));
typedef unsigned u32x4 __attribute__((ext_vector_type(4)));
constexpr int BM = 256, BK = 64, HALF = 128, HTB = HALF * BK * 2  , STAGE_BYTES = 8 * HTB, NXCD = 8, WGM = 8;

__host__ __device__ __forceinline__ int lds_byte(int r, int c) { const int st = (r >> 4) * 2 + (c >> 5), rr = r & 15, cc = c & 31, ob = rr * 64 + cc * 2; return st * 1024 + (ob ^ (((ob >> 9) & 1) << 5)); }
__host__ __device__ __forceinline__ void stage_rc(int b, int& R, int& C) { const int st = b / 1024, sb = b % 1024, swz = sb ^ (((sb >> 9) & 1) << 5); R = (st >> 1) * 16 + swz / 64; C = (st & 1) * 32 + (swz % 64) / 2; }
__host__ __device__ __forceinline__ int perm32(int rho) { const int n = rho >> 4, i = rho & 15; return 8 * (i >> 2) + 4 * n + (i & 3); }

struct Unit { int pm, pn; };
struct Gemm { const bf16_t* A; const bf16_t* Bt; int M, N, K; };

struct StaticOrder {
    int nM, nN, nwg, G, c;
    __host__ __device__ void init(int M, int N, int G_, int c_) { nM = M / BM; nN = N / BM; nwg = nM * nN; G = G_; c = c_; }
    __host__ __device__ bool next(int i, Unit& u) const {
        const long L = (long)i * G + c; if (L >= nwg) return false;
        int wgid = (int)L; { const int q = nwg / NXCD, r = nwg % NXCD, xcd = wgid % NXCD, off = wgid / NXCD; wgid = (xcd < r ? xcd * (q + 1) : r * (q + 1) + (xcd - r) * q) + off; }
        const int nig = WGM * nN, gid = wgid / nig, fm = gid * WGM, gsz = (nM - fm) < WGM ? (nM - fm) : WGM;
        u.pm = fm + ((wgid % nig) % gsz); u.pn = (wgid % nig) / gsz; return true;
    }
    __device__ __forceinline__ void a_ready(const Unit&) const {}
    __device__ __forceinline__ void done(const Unit&) const {}
};
struct CountedOrder : StaticOrder {
    const unsigned* ready; unsigned need; unsigned* tmo;
    __device__ __forceinline__ void a_ready(const Unit& u) const {
        if (threadIdx.x < 64) {
            const unsigned long long t0 = __builtin_amdgcn_s_memrealtime(); unsigned polls = 0;
            while ((unsigned)__builtin_amdgcn_readfirstlane(__hip_atomic_load(ready + 64 * u.pm, __ATOMIC_RELAXED, __HIP_MEMORY_SCOPE_AGENT)) < need) {
                if ((++polls & 255u) == 0u && __builtin_amdgcn_readfirstlane(__hip_atomic_load(tmo, __ATOMIC_RELAXED, __HIP_MEMORY_SCOPE_AGENT)) != 0u) break;
                if (__builtin_amdgcn_s_memrealtime() - t0 > 2000000ull) {
                    if (threadIdx.x == 0) { unsigned expect = 0u; __hip_atomic_compare_exchange_strong(tmo + 1, &expect, 0x600u | (unsigned)(u.pm & 0xff), __ATOMIC_RELAXED, __ATOMIC_RELAXED, __HIP_MEMORY_SCOPE_AGENT); __hip_atomic_store(tmo, 1u, __ATOMIC_RELAXED, __HIP_MEMORY_SCOPE_AGENT); }
                    break; }
                __builtin_amdgcn_s_sleep(2); }
            __builtin_amdgcn_fence(__ATOMIC_ACQUIRE, "agent");
            asm volatile("s_waitcnt vmcnt(0)" ::: "memory");
        }
#if !defined(BROKEN_HOOK_NO_BARRIER)
        asm volatile("" ::: "memory"); __builtin_amdgcn_s_barrier(); asm volatile("" ::: "memory");
#endif
    }
};

__device__ __forceinline__ unsigned cvt_pk_bf16(float lo, float hi) { unsigned r; asm volatile("v_cvt_pk_bf16_f32 %0, %1, %2" : "=v"(r) : "v"(lo), "v"(hi)); return r; }
typedef float f32x2 __attribute__((ext_vector_type(2)));
__device__ __forceinline__ f32x2 gelu_pk(f32x2 v) {
    const f32x2 av = __builtin_elementwise_abs(v), d = av * 0.2316418882f + 1.0f;
    f32x2 t; t.x = __builtin_amdgcn_rcpf(d.x); t.y = __builtin_amdgcn_rcpf(d.y);
    f32x2 q = t * 0.5307027145f + (-0.7265760135f); q = q * t + 0.7107068705f; q = q * t + (-0.142248368f); q = q * t + 0.127414796f; q = q * t;
    const f32x2 s = (v * v) * (-0.72134752044f);
    f32x2 e; e.x = __builtin_amdgcn_exp2f(s.x); e.y = __builtin_amdgcn_exp2f(s.y);
    const f32x2 m = v * (q * e), r = v - m;
    f32x2 o; o.x = v.x < 0.f ? m.x : r.x; o.y = v.y < 0.f ? m.y : r.y; return o;
}

struct EpiF32 {
    static constexpr bool PERM = false, AFTER_DRAIN = false;
    float* C; int ldc; const float* bias;
    __device__ __forceinline__ void operator()(const f32x4 (&acc)[2][2][4][2], const Unit& u, int wr, int wc, int fr, int fq) const {
        const int row0 = u.pm * BM + wr * 64 + fr, col0 = u.pn * BM + wc * 32 + 4 * fq;
        f32x4 bv[2][2];
#pragma unroll
        for (int bj = 0; bj < 2; ++bj)
#pragma unroll
            for (int n = 0; n < 2; ++n) bv[bj][n] = bias ? *(const f32x4*)(bias + col0 + bj * HALF + n * 16) : (f32x4){0.f, 0.f, 0.f, 0.f};
#pragma unroll
        for (int ai = 0; ai < 2; ++ai)
#pragma unroll
            for (int m = 0; m < 4; ++m) { float* rowp = C + (size_t)(row0 + ai * HALF + m * 16) * ldc + col0;
#pragma unroll
                for (int bj = 0; bj < 2; ++bj)
#pragma unroll
                    for (int n = 0; n < 2; ++n) *(f32x4*)(rowp + bj * HALF + n * 16) = acc[ai][bj][m][n] + bv[bj][n]; }
    }
};
template <int ACT  > struct EpiBf16 {
    static constexpr bool PERM = true, AFTER_DRAIN = false;
    bf16_t* O; int ldc; const float* bias; int split_cols; size_t split_stride;
    __device__ __forceinline__ void operator()(const f32x4 (&acc)[2][2][4][2], const Unit& u, int wr, int wc, int fr, int fq) const {
        const int row0 = u.pm * BM + wr * 64 + fr; int colt = u.pn * BM; bf16_t* base = O;
        if (split_cols) { const int t = colt / split_cols; base += (size_t)t * split_stride; colt -= t * split_cols; }
        const int col0 = colt + wc * 32 + 8 * fq, bcol0 = u.pn * BM + wc * 32 + 8 * fq;
        f32x4 bv[2][2];
#pragma unroll
        for (int bj = 0; bj < 2; ++bj)
#pragma unroll
            for (int n = 0; n < 2; ++n) bv[bj][n] = bias ? *(const f32x4*)(bias + bcol0 + bj * HALF + 4 * n) : (f32x4){0.f, 0.f, 0.f, 0.f};
#pragma unroll
        for (int ai = 0; ai < 2; ++ai)
#pragma unroll
            for (int m = 0; m < 4; ++m) { bf16_t* rowp = base + (size_t)(row0 + ai * HALF + m * 16) * ldc + col0;
#pragma unroll
                for (int bj = 0; bj < 2; ++bj) { f32x4 v0 = acc[ai][bj][m][0] + bv[bj][0], v1 = acc[ai][bj][m][1] + bv[bj][1];
                    if (ACT == 1) { f32x2 a = gelu_pk((f32x2){v0[0], v0[1]}), b = gelu_pk((f32x2){v0[2], v0[3]}), c = gelu_pk((f32x2){v1[0], v1[1]}), d = gelu_pk((f32x2){v1[2], v1[3]});
                        v0 = (f32x4){a.x, a.y, b.x, b.y}; v1 = (f32x4){c.x, c.y, d.x, d.y}; }
                    if (ACT == 2) {
#pragma unroll
                        for (int j = 0; j < 4; ++j) { v0[j] = 0.5f * v0[j] * (1.0f + erff(v0[j] * 0.70710678f)); v1[j] = 0.5f * v1[j] * (1.0f + erff(v1[j] * 0.70710678f)); } }
                    u32x4 w; w.x = cvt_pk_bf16(v0[0], v0[1]); w.y = cvt_pk_bf16(v0[2], v0[3]); w.z = cvt_pk_bf16(v1[0], v1[1]); w.w = cvt_pk_bf16(v1[2], v1[3]);
                    *(u32x4*)(rowp + bj * HALF) = w; } }
    }
};

struct PanelStats {
    unsigned* xbuf;
    unsigned* cnt;
    unsigned* tmo;
    int ntn; float eps;
    unsigned code;
    __device__ __forceinline__ bool run(const f32x4 (&v)[2][2][4][2], const Unit& u, int wr, int wc, int fr, int fq, PG8_LAS unsigned char* lds, int wid, int lane) const {
        typedef float f32x2v __attribute__((ext_vector_type(2)));
        PG8_LAS f32x2v* P = (PG8_LAS f32x2v*)lds;
        PG8_LAS f32x2v* S = (PG8_LAS f32x2v*)(lds + 8192);
        PG8_LAS unsigned* flag = (PG8_LAS unsigned*)(lds + 8192 + 2048);
#pragma unroll
        for (int ai = 0; ai < 2; ++ai)
#pragma unroll
            for (int m = 0; m < 4; ++m) {
                float s = 0.f;
#pragma unroll
                for (int bj = 0; bj < 2; ++bj)
#pragma unroll
                    for (int n = 0; n < 2; ++n) { const f32x4 x = v[ai][bj][m][n]; s += (x[0] + x[1]) + (x[2] + x[3]); }
                s += __shfl_xor(s, 16); s += __shfl_xor(s, 32);
                const float mw = s * (1.0f / 64.0f); float q = 0.f;
#pragma unroll
                for (int bj = 0; bj < 2; ++bj)
#pragma unroll
                    for (int n = 0; n < 2; ++n) { const f32x4 d = v[ai][bj][m][n] - mw; q += (d[0] * d[0] + d[1] * d[1]) + (d[2] * d[2] + d[3] * d[3]); }
                q += __shfl_xor(q, 16); q += __shfl_xor(q, 32);
                if (fq == 0) P[(ai * HALF + wr * 64 + m * 16 + fr) * 4 + wc] = (f32x2v){mw, q};
            }
        asm volatile("s_waitcnt lgkmcnt(0)" ::: "memory"); __builtin_amdgcn_s_barrier(); asm volatile("" ::: "memory");
#if defined(BROKEN_NO_WAIT)
        if (blockIdx.x >= 64) { const long long t0 = clock64(); while (clock64() - t0 < 60000) __builtin_amdgcn_s_sleep(8); }
#endif
        const int row = wid * 32 + (lane & 31);
        if (lane < 32) {
            const f32x2v a = P[row * 4 + 0], b = P[row * 4 + 1], c = P[row * 4 + 2], d = P[row * 4 + 3];
            const float mt = (a.x + b.x + c.x + d.x) * 0.25f;
            const float da = a.x - mt, db = b.x - mt, dc = c.x - mt, dd = d.x - mt;
            const float m2 = (a.y + b.y) + (c.y + d.y) + 64.0f * ((da * da + db * db) + (dc * dc + dd * dd));
            unsigned long long* slot = (unsigned long long*)xbuf + ((size_t)(u.pm * BM + row) * 4 + u.pn);
            __hip_atomic_store(slot, ((unsigned long long)__float_as_uint(m2) << 32) | __float_as_uint(mt), __ATOMIC_RELAXED, __HIP_MEMORY_SCOPE_AGENT);
        }
        asm volatile("s_waitcnt vmcnt(0)" ::: "memory");
        if (lane == 0) __hip_atomic_fetch_add(cnt + 64 * u.pm, 1u, __ATOMIC_RELAXED, __HIP_MEMORY_SCOPE_AGENT);
        if (wid == 0) {
            bool dead = false; const unsigned long long t0 = __builtin_amdgcn_s_memrealtime(); const unsigned want = 8u * (unsigned)ntn;
            for (;;) {
#if defined(BROKEN_NO_WAIT)
                break;
#endif
                if ((unsigned)__builtin_amdgcn_readfirstlane(__hip_atomic_load(cnt + 64 * u.pm, __ATOMIC_RELAXED, __HIP_MEMORY_SCOPE_AGENT)) >= want) break;
                if (__builtin_amdgcn_s_memrealtime() - t0 > 2000000ull) {
                    if (lane == 0) { unsigned expect = 0u; __hip_atomic_compare_exchange_strong(tmo + 1, &expect, code | (unsigned)(u.pm & 0xff), __ATOMIC_RELAXED, __ATOMIC_RELAXED, __HIP_MEMORY_SCOPE_AGENT);
                                     __hip_atomic_store(tmo, 1u, __ATOMIC_RELAXED, __HIP_MEMORY_SCOPE_AGENT); }
                    dead = true; break; }
                __builtin_amdgcn_s_sleep(2);
            }
            __builtin_amdgcn_fence(__ATOMIC_ACQUIRE, "agent");
            if (lane == 0) flag[0] = dead ? 1u : 0u;
        }
        asm volatile("s_waitcnt vmcnt(0) lgkmcnt(0)" ::: "memory"); __builtin_amdgcn_s_barrier(); asm volatile("" ::: "memory");
        const bool bad = flag[0] != 0u;
        if (lane < 32) {
            const unsigned long long* slot = (const unsigned long long*)xbuf + (size_t)(u.pm * BM + row) * 4; float mt[4], m2[4]; float ms = 0.f;
#pragma unroll
            for (int t = 0; t < 4; ++t) { if (t < ntn) { const unsigned long long w = __hip_atomic_load(slot + t, __ATOMIC_RELAXED, __HIP_MEMORY_SCOPE_AGENT); mt[t] = __uint_as_float((unsigned)w); m2[t] = __uint_as_float((unsigned)(w >> 32)); } else { mt[t] = 0.f; m2[t] = 0.f; } ms += mt[t]; }
            const float mean = ms / (float)ntn; float q = 0.f;
#pragma unroll
            for (int t = 0; t < 4; ++t) if (t < ntn) { const float dm = mt[t] - mean; q += m2[t] + 256.0f * dm * dm; }
            S[row] = (f32x2v){mean, 1.0f / sqrtf(q / (256.0f * (float)ntn) + eps)};
        }
        asm volatile("s_waitcnt lgkmcnt(0)" ::: "memory"); __builtin_amdgcn_s_barrier(); asm volatile("" ::: "memory");
        return bad;
    }
};
struct EpiLnRes {
    static constexpr bool PERM = false, AFTER_DRAIN = true;
    const float* base; float* out; int ldc; const float* bias; PanelStats st; unsigned poison;
    __device__ __forceinline__ void refuse(size_t i0, size_t stride, int M, int N) const { const float q = __builtin_nanf(""); for (size_t i = i0; i < (size_t)M * N; i += stride) out[(i / N) * ldc + i % N] = q;
        if (i0 == 0) { unsigned expect = 0u; __hip_atomic_compare_exchange_strong(st.tmo + 1, &expect, 0x7f0u, __ATOMIC_RELAXED, __ATOMIC_RELAXED, __HIP_MEMORY_SCOPE_AGENT); __hip_atomic_store(st.tmo, 1u, __ATOMIC_RELAXED, __HIP_MEMORY_SCOPE_AGENT); } }
    __device__ __forceinline__ void fused(f32x4 (&acc)[2][2][4][2], const Unit& u, int wr, int wc, int fr, int fq, PG8_LAS unsigned char* lds, int wid, int lane) const {
        typedef float f32x2v __attribute__((ext_vector_type(2)));
        const PG8_LAS f32x2v* S = (const PG8_LAS f32x2v*)(lds + 8192);
        const int col0 = u.pn * BM + wc * 32 + 4 * fq;
#pragma unroll
        for (int bj = 0; bj < 2; ++bj)
#pragma unroll
            for (int n = 0; n < 2; ++n) { const f32x4 bv = bias ? *(const f32x4*)(bias + col0 + bj * HALF + n * 16) : (f32x4){0.f, 0.f, 0.f, 0.f};
#pragma unroll
                for (int ai = 0; ai < 2; ++ai)
#pragma unroll
                    for (int m = 0; m < 4; ++m) acc[ai][bj][m][n] += bv; }
        const bool bad = st.run(acc, u, wr, wc, fr, fq, lds, wid, lane) || poison != 0u;
        const float qnan = __builtin_nanf("");
#pragma unroll
        for (int ai = 0; ai < 2; ++ai)
#pragma unroll
            for (int m = 0; m < 4; ++m) { const int r = ai * HALF + wr * 64 + m * 16 + fr; const f32x2v sr = S[r]; const size_t off = (size_t)(u.pm * BM + r) * ldc + col0;
#pragma unroll
                for (int bj = 0; bj < 2; ++bj)
#pragma unroll
                    for (int n = 0; n < 2; ++n) { const f32x4 bs = *(const f32x4*)(base + off + bj * HALF + n * 16); f32x4 o = bs + (acc[ai][bj][m][n] - sr.x) * sr.y;
                        if (bad) o = (f32x4){qnan, qnan, qnan, qnan}; *(f32x4*)(out + off + bj * HALF + n * 16) = o; }
                asm volatile("" ::: "memory"); }
    }
};
struct EpiLnResLn {
    static constexpr bool PERM = false, AFTER_DRAIN = true;
    const float* base; float* out; bf16_t* xn; int ldc; const float* bias; PanelStats st1, st2; unsigned poison;
    __device__ __forceinline__ void refuse(size_t i0, size_t stride, int M, int N) const { const float q = __builtin_nanf(""); for (size_t i = i0; i < (size_t)M * N; i += stride) { const size_t o = (i / N) * ldc + i % N; out[o] = q; xn[o] = (bf16_t)0x7fc0u; }
        if (i0 == 0) { unsigned expect = 0u; __hip_atomic_compare_exchange_strong(st1.tmo + 1, &expect, 0x7f0u, __ATOMIC_RELAXED, __ATOMIC_RELAXED, __HIP_MEMORY_SCOPE_AGENT); __hip_atomic_store(st1.tmo, 1u, __ATOMIC_RELAXED, __HIP_MEMORY_SCOPE_AGENT); } }
    __device__ __forceinline__ void fused(f32x4 (&acc)[2][2][4][2], const Unit& u, int wr, int wc, int fr, int fq, PG8_LAS unsigned char* lds, int wid, int lane) const {
        typedef float f32x2v __attribute__((ext_vector_type(2))); typedef unsigned u32x2v __attribute__((ext_vector_type(2)));
        const PG8_LAS f32x2v* S = (const PG8_LAS f32x2v*)(lds + 8192);
        const int col0 = u.pn * BM + wc * 32 + 4 * fq;
#pragma unroll
        for (int bj = 0; bj < 2; ++bj)
#pragma unroll
            for (int n = 0; n < 2; ++n) { const f32x4 bv = bias ? *(const f32x4*)(bias + col0 + bj * HALF + n * 16) : (f32x4){0.f, 0.f, 0.f, 0.f};
#pragma unroll
                for (int ai = 0; ai < 2; ++ai)
#pragma unroll
                    for (int m = 0; m < 4; ++m) acc[ai][bj][m][n] += bv; }
        bool bad = st1.run(acc, u, wr, wc, fr, fq, lds, wid, lane) || poison != 0u;
        const float qnan = __builtin_nanf("");
#pragma unroll
        for (int ai = 0; ai < 2; ++ai)
#pragma unroll
            for (int m = 0; m < 4; ++m) { const int r = ai * HALF + wr * 64 + m * 16 + fr; const f32x2v sr = S[r]; const size_t off = (size_t)(u.pm * BM + r) * ldc + col0;
#pragma unroll
                for (int bj = 0; bj < 2; ++bj)
#pragma unroll
                    for (int n = 0; n < 2; ++n) { const f32x4 bs = *(const f32x4*)(base + off + bj * HALF + n * 16); acc[ai][bj][m][n] = bs + (acc[ai][bj][m][n] - sr.x) * sr.y; }
                asm volatile("" : "+v"(acc[ai][0][m][0]), "+v"(acc[ai][0][m][1]), "+v"(acc[ai][1][m][0]), "+v"(acc[ai][1][m][1]));
                if (m & 1) asm volatile("" ::: "memory"); }
        const bool bad1 = bad;
        bad = st2.run(acc, u, wr, wc, fr, fq, lds, wid, lane) || bad;
#pragma unroll
        for (int ai = 0; ai < 2; ++ai)
#pragma unroll
            for (int m = 0; m < 4; ++m) { const int r = ai * HALF + wr * 64 + m * 16 + fr; const f32x2v sr = S[r]; const size_t off = (size_t)(u.pm * BM + r) * ldc + col0;
#pragma unroll
                for (int bj = 0; bj < 2; ++bj)
#pragma unroll
                    for (int n = 0; n < 2; ++n) { const f32x4 x1 = acc[ai][bj][m][n]; *(f32x4*)(out + off + bj * HALF + n * 16) = bad1 ? (f32x4){qnan, qnan, qnan, qnan} : x1;
                        const f32x4 o = (x1 - sr.x) * sr.y; u32x2v w; w.x = cvt_pk_bf16(o[0], o[1]); w.y = cvt_pk_bf16(o[2], o[3]);
                        if (bad) { w.x = 0x7fc07fc0u; w.y = 0x7fc07fc0u; } *(u32x2v*)(xn + off + bj * HALF + n * 16) = w; }
                asm volatile("" ::: "memory"); }
    }
};

template <class Epi, class Sched, bool STAMP = false>
__device__ __forceinline__ void gemm_phase(PG8_LAS unsigned char* lds, const Gemm g, const Sched& S, const Epi& E, unsigned long long* stamps, int tid_in) {
    int tid_ = tid_in; asm volatile("" : "+v"(tid_));
    const int tid = tid_, wid = __builtin_amdgcn_readfirstlane(tid >> 6), lane = tid & 63, wr = wid >> 2, wc = wid & 3, fr = lane & 15, fq = lane >> 4;
    const int K = g.K, nt = K / BK;
    int ts_lo = 0, ts_hi = 0, nts = 0; const unsigned long long rt_entry = STAMP ? (unsigned long long)wall_clock64() : 0ull;
#define PG8_STAMP() do { if (STAMP && wid == 0 && nts < 64) { const unsigned long long _c = (unsigned long long)clock64(); \
        ts_lo = (lane == nts) ? (int)(unsigned)_c : ts_lo; ts_hi = (lane == nts) ? (int)(unsigned)(_c >> 32) : ts_hi; ++nts; } } while (0)
    PG8_STAMP();
    unsigned voffA[2], voffB[2];
#pragma unroll
    for (int i = 0; i < 2; ++i) { int R, C; stage_rc(tid * 16 + i * 8192, R, C); const int Rb = Epi::PERM ? ((R & ~31) + perm32(R & 31)) : R;
        voffA[i] = (unsigned)(R * K + C) * 2u; voffB[i] = (unsigned)(Rb * K + C) * 2u; }
    const size_t kstep = (size_t)(BK * 2);
    const size_t hstep = (size_t)HALF * K * 2;
    const size_t tstep = 2 * hstep;
    const unsigned ldsw = (unsigned)wid * 1024u;
    const int aoff = lds_byte(wr * 64 + fr, fq * 8), boff = lds_byte(wc * 32 + fr, fq * 8);
#define PG8_SA(b, h) (((b) * 2 + (h)) * HTB)
#define PG8_SB(b, h) ((4 + (b) * 2 + (h)) * HTB)
#define PG8_STAGE(bufoff, gbase, voff) do { _Pragma("unroll") for (int _i = 0; _i < 2; ++_i) \
        __builtin_amdgcn_global_load_lds((const unsigned*)((const char*)(gbase) + (voff)[_i]), (PG8_LAS unsigned*)(lds + (bufoff) + ldsw + _i * 8192), 16, 0, 0); } while (0)
#define PG8_LDA(dst, b, h) do { _Pragma("unroll") for (int m = 0; m < 4; ++m) _Pragma("unroll") for (int k = 0; k < 2; ++k) dst[m][k] = *(const PG8_LAS bf16x8*)(lds + PG8_SA(b, h) + aoff + m * 2048 + k * 1024); } while (0)
#define PG8_LDB(dst, b, h) do { _Pragma("unroll") for (int n = 0; n < 2; ++n) _Pragma("unroll") for (int k = 0; k < 2; ++k) dst[n][k] = *(const PG8_LAS bf16x8*)(lds + PG8_SB(b, h) + boff + n * 2048 + k * 1024); } while (0)
#define PG8_MMA(ai, bj, At, Bt) do { __builtin_amdgcn_s_setprio(1); _Pragma("unroll") for (int m = 0; m < 4; ++m) _Pragma("unroll") for (int n = 0; n < 2; ++n) _Pragma("unroll") for (int k = 0; k < 2; ++k) \
        acc[ai][bj][m][n] = __builtin_amdgcn_mfma_f32_16x16x32_bf16(Bt[n][k], At[m][k], acc[ai][bj][m][n], 0, 0, 0); __builtin_amdgcn_s_setprio(0); } while (0)
#define PG8_WAIT_V(n) asm volatile("s_waitcnt vmcnt(" #n ")" ::: "memory")
#define PG8_WAIT_L(n) asm volatile("s_waitcnt lgkmcnt(" #n ")" ::: "memory")
#define PG8_BAR __builtin_amdgcn_s_barrier()
#define PG8_SCHED __builtin_amdgcn_sched_barrier(0)
    Unit cur, nxt; int ui = 0;
    if (!S.next(0, cur)) return;
    f32x4 acc[2][2][4][2];
#pragma unroll
    for (int a = 0; a < 2; ++a)
#pragma unroll
        for (int b = 0; b < 2; ++b)
#pragma unroll
            for (int m = 0; m < 4; ++m)
#pragma unroll
                for (int n = 0; n < 2; ++n) acc[a][b][m][n] = (f32x4){0.f, 0.f, 0.f, 0.f};
    bf16x8 At[4][2], B0[2][2], B1[2][2];
    const char* cA = (const char*)g.A + (size_t)cur.pm * tstep; const char* cB = (const char*)g.Bt + (size_t)cur.pn * tstep;
    S.a_ready(cur);
    PG8_STAGE(PG8_SB(0, 0), cB, voffB); PG8_STAGE(PG8_SA(0, 0), cA, voffA); PG8_STAGE(PG8_SB(0, 1), cB + hstep, voffB); PG8_STAGE(PG8_SA(0, 1), cA + hstep, voffA);
    if (wr == 1) PG8_BAR;
    PG8_WAIT_V(4); PG8_BAR;
    PG8_STAGE(PG8_SB(1, 0), cB + kstep, voffB); PG8_STAGE(PG8_SA(1, 0), cA + kstep, voffA); PG8_STAGE(PG8_SB(1, 1), cB + hstep + kstep, voffB);
    PG8_WAIT_V(6); PG8_BAR;
    PG8_STAMP();
    for (;;) {
        const bool has_next = S.next(ui + 1, nxt);
        const char* nA = has_next ? (const char*)g.A + (size_t)nxt.pm * tstep : cA; const char* nB = has_next ? (const char*)g.Bt + (size_t)nxt.pn * tstep : cB;
        for (int t = 0; t < nt; t += 2) {
            const bool last = (t == nt - 2);
            const char* a1 = cA + (size_t)(t + 1) * kstep;
            const char* a2 = last ? nA : cA + (size_t)(t + 2) * kstep; const char* b2 = last ? nB : cB + (size_t)(t + 2) * kstep;
            const char* a3 = a2 + kstep; const char* b3 = b2 + kstep;
            if (last && has_next) S.a_ready(nxt);
            PG8_LDB(B0, 0, 0); PG8_SCHED; PG8_LDA(At, 0, 0); PG8_STAGE(PG8_SA(1, 1), a1 + hstep, voffA);
            PG8_WAIT_L(8); PG8_BAR; PG8_WAIT_L(0); PG8_MMA(0, 0, At, B0); PG8_BAR; PG8_SCHED;
            PG8_LDB(B1, 0, 1); PG8_STAGE(PG8_SB(0, 0), b2, voffB);
            PG8_BAR; PG8_WAIT_L(0); PG8_MMA(0, 1, At, B1); PG8_BAR;
            PG8_LDA(At, 0, 1); PG8_STAGE(PG8_SA(0, 0), a2, voffA);
            PG8_BAR; PG8_WAIT_L(0); PG8_MMA(1, 0, At, B0); PG8_BAR; PG8_SCHED;
            PG8_STAGE(PG8_SB(0, 1), b2 + hstep, voffB);
            PG8_WAIT_V(6); PG8_BAR; PG8_MMA(1, 1, At, B1); PG8_BAR;
            PG8_LDB(B0, 1, 0); PG8_SCHED; PG8_LDA(At, 1, 0); PG8_STAGE(PG8_SA(0, 1), a2 + hstep, voffA);
            PG8_WAIT_L(8); PG8_BAR; PG8_WAIT_L(0); PG8_MMA(0, 0, At, B0); PG8_BAR; PG8_SCHED;
            PG8_LDB(B1, 1, 1); PG8_STAGE(PG8_SB(1, 0), b3, voffB);
            PG8_BAR; PG8_WAIT_L(0); PG8_MMA(0, 1, At, B1); PG8_BAR;
            PG8_LDA(At, 1, 1); PG8_STAGE(PG8_SA(1, 0), a3, voffA);
            PG8_BAR; PG8_WAIT_L(0); PG8_MMA(1, 0, At, B0); PG8_BAR; PG8_SCHED;
            PG8_STAGE(PG8_SB(1, 1), b3 + hstep, voffB);
            PG8_WAIT_V(6); PG8_BAR; PG8_MMA(1, 1, At, B1); PG8_BAR;
        }
        PG8_STAMP();
        if constexpr (!Epi::AFTER_DRAIN) { E(acc, cur, wr, wc, fr, fq); S.done(cur); }
        PG8_STAMP();
        if (!has_next) break;
#pragma unroll
        for (int a = 0; a < 2; ++a)
#pragma unroll
            for (int b = 0; b < 2; ++b)
#pragma unroll
                for (int m = 0; m < 4; ++m)
#pragma unroll
                    for (int n = 0; n < 2; ++n) acc[a][b][m][n] = (f32x4){0.f, 0.f, 0.f, 0.f};
        cur = nxt; cA = nA; cB = nB; ++ui;
    }
    PG8_WAIT_V(0);
    if (wr == 0) PG8_BAR;
    PG8_BAR;
    if constexpr (Epi::AFTER_DRAIN) { E.fused(acc, cur, wr, wc, fr, fq, lds, wid, lane); S.done(cur); }
    PG8_STAMP();
    if (STAMP && wid == 0) { stamps[lane] = lane < nts ? (((unsigned long long)(unsigned)ts_hi << 32) | (unsigned)ts_lo) : 0ull;
        if (lane == 62) stamps[62] = rt_entry; if (lane == 63) stamps[63] = (unsigned long long)wall_clock64(); }
#undef PG8_STAMP
#undef PG8_SA
#undef PG8_SB
#undef PG8_STAGE
#undef PG8_LDA
#undef PG8_LDB
#undef PG8_MMA
#undef PG8_WAIT_V
#undef PG8_WAIT_L
#undef PG8_BAR
#undef PG8_SCHED
}
}

constexpr int DM = 2048, NBATCH = 4, SEQ = 2048, CTXL = 256;
constexpr int TC = NBATCH * CTXL;
constexpr int TL = NBATCH * SEQ;
constexpr int TT = TC + TL;
constexpr int NLAYER = 2;
constexpr int NPAD = 9472;
constexpr int PC_U = 0, PC_QKV = 1024, PC_Z = 4096, PC_GS5 = 5120, PC_GDN = 7168, PC_BA = 9216;
constexpr int NE = 64, NEX = 65, EDIM = 512;
constexpr int MAXTILES = 388, MAXSLOT = MAXTILES * 256;
constexpr float EPS = 1e-6f;
constexpr int MODW = 12288;

constexpr size_t MiB = 1u << 20;
constexpr size_t WS_CTL = 0, CTL_ZERO_BYTES = 2 * MiB;
constexpr int CW_BAR = 4096;
constexpr int CW_CNT = 16384;
constexpr int CW_FILL = 16384 + 256;
constexpr int CW_TS = 32768;
constexpr size_t WS_MODS = 1 * MiB;
constexpr size_t WS_MISC = 2 * MiB;
constexpr size_t WS_W = 4 * MiB;
constexpr size_t WO_IN = 0, WO_GLU = 37 * MiB, WO_BRS = 39 * MiB, WO_BRD = 43 * MiB, WO_OUT = 47 * MiB, WO_GU = 55 * MiB, WO_DN = (55 + 260) * MiB, W_BYTES = (55 + 260 + 130) * MiB;
constexpr size_t WS_X = WS_W + W_BYTES;
constexpr size_t WS_EIDX = WS_X + 72 * MiB;
constexpr size_t WS_WTS = WS_EIDX + 1 * MiB;
constexpr size_t WS_SLOT = WS_WTS + 1 * MiB;
constexpr size_t WS_AB = WS_SLOT + 1 * MiB;
constexpr size_t WS_B = WS_AB + 36 * MiB;
constexpr size_t WB_P = 0;
constexpr size_t WB_QKV = 167 * MiB;
constexpr size_t WB_BG = WB_QKV + 108 * MiB;
constexpr size_t WB_Y = WB_BG + 2 * MiB;
constexpr size_t WB_O = WB_Y + 72 * MiB;
constexpr size_t WB_G = WB_O + 72 * MiB;
constexpr size_t WB_DNO = WB_G + 18 * MiB;
constexpr size_t WB_S5O = WB_DNO + 18 * MiB;
constexpr size_t WB_M1 = WB_S5O + 18 * MiB;
constexpr size_t WB_M = WB_M1 + 72 * MiB;
constexpr size_t WB_MIX = WB_M + 36 * MiB;
constexpr size_t WB_DNU = WB_MIX + 72 * MiB;
constexpr int DN_UNITS = 4 * 8 * 2 * 36;
constexpr size_t DNU_W = 0, DNU_UT = (size_t)DN_UNITS * 16384, DNU_KT = 2 * DNU_UT, DNU_QK = 3 * DNU_UT, DNU_SC = DNU_QK + (size_t)DN_UNITS * 8192;
constexpr size_t WB_S5 = WB_DNU + 132 * MiB;
constexpr int S5N = 288;
constexpr size_t S5_KC = 0, S5_WST = 4 * MiB, S5_WOUT = 20 * MiB, S5_L32 = 36 * MiB, S5_UG = 37 * MiB, S5_SLOC = 55 * MiB, S5_HIN = 73 * MiB;
constexpr size_t WB_END = WB_S5 + 82 * MiB;
constexpr size_t WB_HPERM = 0;
constexpr size_t WB_ACT = 388 * MiB;
static_assert(WB_ACT + 97 * MiB <= WB_END, "moe scratch fits");
constexpr size_t WS_END = WS_B + WB_END;

constexpr int LDS_BYTES = 147456;
constexpr int LDS_MISC = LDS_BYTES - 256;

#define LAS __attribute__((address_space(3)))
typedef unsigned short bf16;
typedef float f32x4 __attribute__((ext_vector_type(4)));
typedef float f32x2 __attribute__((ext_vector_type(2)));
typedef unsigned u32x4 __attribute__((ext_vector_type(4)));
typedef unsigned u32x2 __attribute__((ext_vector_type(2)));

#define LDS_WAIT() asm volatile("s_waitcnt lgkmcnt(0)" ::: "memory")
#define VM_WAIT() asm volatile("s_waitcnt vmcnt(0)" ::: "memory")

__device__ __forceinline__ unsigned f2bf(float f) { unsigned u = __float_as_uint(f); return (u + 0x7fffu + ((u >> 16) & 1u)) >> 16; }
__device__ __forceinline__ unsigned pk2(float lo, float hi) { return f2bf(lo) | (f2bf(hi) << 16); }
__device__ __forceinline__ float bflo(unsigned w) { return __uint_as_float(w << 16); }
__device__ __forceinline__ float bfhi(unsigned w) { return __uint_as_float(w & 0xffff0000u); }
__device__ __forceinline__ float bf2f(bf16 b) { return __uint_as_float(((unsigned)b) << 16); }
__device__ __forceinline__ float sigmoidf_(float x) { return 1.f / (1.f + __expf(-x)); }
__device__ __forceinline__ float siluf_(float x) { return x / (1.f + __expf(-x)); }
__device__ __forceinline__ float gelu_tanh(float x) { const float t = tanhf(0.7978845608028654f * (x + 0.044715f * x * x * x)); return 0.5f * x * (1.f + t); }
__device__ __forceinline__ int lane_id() { int l; asm volatile("v_mbcnt_lo_u32_b32 %0, -1, 0\n\tv_mbcnt_hi_u32_b32 %0, -1, %0" : "=v"(l)); return l; }
__device__ __forceinline__ float wave_sum(float v) {
#pragma unroll
    for (int o = 1; o < 64; o <<= 1) v += __shfl_xor(v, o);
    return v;
}

#define XB_TMO      128
#define XB_XCNT(j)  (256  + 64 * (j))
#define XB_XSUB(j)  (1280 + 64 * (j))
#define XB_XGEN(j)  (2304 + 64 * (j))
#define XB_TOP      3328
#define XB_TOPGEN   3392
#define XCD_BAR_WORDS 3456
#define XB_SPIN_CAP (1u << 20)

__device__ __forceinline__ unsigned xb_ld(unsigned* p)              { return __hip_atomic_load(p, __ATOMIC_RELAXED, __HIP_MEMORY_SCOPE_AGENT); }
__device__ __forceinline__ unsigned xb_add(unsigned* p, unsigned v) { return __hip_atomic_fetch_add(p, v, __ATOMIC_RELAXED, __HIP_MEMORY_SCOPE_AGENT); }
__device__ __forceinline__ unsigned xb_xcc_id() { return (unsigned)__builtin_amdgcn_s_getreg((3 << 11) | 20) & 0xFu; }
#define XB_SPIN(cond, bar) do { unsigned _sp = 0; while (cond) { __builtin_amdgcn_s_sleep(1); \
    if ((++_sp & 255u) == 0u) { if (xb_ld(&(bar)[XB_TMO])) break; if (_sp > XB_SPIN_CAP) { atomicAdd(&(bar)[XB_TMO], 1u); break; } } } } while (0)

struct XcdBarrier { unsigned* bar; unsigned x; volatile LAS unsigned* st; };

__device__ __forceinline__ XcdBarrier xcd_barrier_post(unsigned* bar, volatile LAS unsigned* st) {
    XcdBarrier b; b.bar = bar; b.x = xb_xcc_id(); b.st = st;
    if (threadIdx.x == 0) (void)xb_add(&bar[XB_XCNT(b.x)], 1u);
    return b;
}
__device__ __forceinline__ void xcd_barrier_complete(unsigned* bar, unsigned x, unsigned& nloc, unsigned& nx) {
    const unsigned G = gridDim.x * gridDim.y * gridDim.z;
    unsigned sum, cnt, mine, sp = 0u;
    for (;;) {
        sum = 0u; cnt = 0u; mine = 0u;
#pragma unroll
        for (unsigned j = 0; j < 16; ++j) { const unsigned c = xb_ld(&bar[XB_XCNT(j)]); sum += c; cnt += (c > 0u) ? 1u : 0u; mine = (j == x) ? c : mine; }
        if (sum == G) break;
        __builtin_amdgcn_s_sleep(1);
        if ((++sp & 255u) == 0u) { if (xb_ld(&bar[XB_TMO])) break; if (sp > XB_SPIN_CAP) { atomicAdd(&bar[XB_TMO], 1u); break; } }
    }
    nloc = mine > 0u ? mine : 1u; nx = cnt > 0u ? cnt : 1u;
}
__device__ __forceinline__ void xcd_barrier(const XcdBarrier& b, int wave_s) {
    asm volatile("s_waitcnt vmcnt(0)" ::: "memory");
    __syncthreads();
    asm volatile("" : "+s"(wave_s));
    if (wave_s == 0 && lane_id() == 0) {
        unsigned* bar = b.bar; asm volatile("" : "+s"(bar));
        __builtin_amdgcn_s_waitcnt(0);
        unsigned nloc = b.st[0], nx = b.st[1];
        unsigned bx_ = b.x; asm volatile("" : "+s"(bx_));
        if (nloc == 0u) { xcd_barrier_complete(bar, bx_, nloc, nx); b.st[0] = nloc; b.st[1] = nx; }
        const unsigned old = xb_add(&bar[XB_XSUB(bx_)], 1u);
        const unsigned gen = old / nloc;
        if (old + 1u == (gen + 1u) * nloc) {
            __builtin_amdgcn_fence(__ATOMIC_RELEASE, "agent");
            asm volatile("s_waitcnt vmcnt(0)" ::: "memory");
            const unsigned og = xb_add(&bar[XB_TOP], 1u);
            const unsigned tg = og / nx;
            if (og + 1u == (tg + 1u) * nx) xb_add(&bar[XB_TOPGEN], 1u);
            else XB_SPIN(xb_ld(&bar[XB_TOPGEN]) == tg, bar);
            __builtin_amdgcn_fence(__ATOMIC_ACQUIRE, "agent");
            xb_add(&bar[XB_XGEN(bx_)], 1u);
            asm volatile("s_waitcnt vmcnt(0)" ::: "memory");
        } else {
            XB_SPIN(xb_ld(&bar[XB_XGEN(bx_)]) == gen, bar);
            __builtin_amdgcn_fence(__ATOMIC_ACQUIRE, "agent");
            asm volatile("s_waitcnt vmcnt(0)" ::: "memory");
        }
    }
    __syncthreads();
}

struct Args { const float* in[35]; float* out; unsigned char* ws; int ph_lo, ph_hi; };
struct Frame { LAS unsigned char* lds; int tid, lane, wave, G, bx, vcu, gw, NGW; };
__device__ __forceinline__ Frame make_frame(LAS unsigned char* lds, int wave_s) {
    asm volatile("" : "+s"(wave_s));
    Frame F; int tid = wave_s * 64 + lane_id(); asm volatile("" : "+v"(tid)); int bx = blockIdx.x; asm volatile("" : "+s"(bx));
    F.lds = lds; F.tid = tid; F.lane = tid & 63; F.wave = __builtin_amdgcn_readfirstlane(tid >> 6); F.G = gridDim.x; F.bx = bx;
    F.vcu = (F.G % 8 == 0) ? (bx % 8) * (F.G / 8) + bx / 8 : bx; F.gw = F.vcu * 8 + F.wave; F.NGW = F.G * 8; return F;
}
#define CAS __attribute__((address_space(4)))
__device__ __forceinline__ const float* inp(int i) {
    asm volatile("" : "+s"(i));
    const CAS char* ka = (const CAS char*)__builtin_amdgcn_kernarg_segment_ptr();
    return *(const float* const CAS*)(ka + 8 * i);
}

enum { I_X = 0, I_C, I_CTX, I_CCTX, I_WMOD, I_BMOD, I_NMPRE, I_NMPOST, I_NFPRE, I_NFPOST, I_WIN, I_LAMRE, I_LAMIM, I_LOGSTEP, I_BRE, I_BIM, I_CRE, I_CIM,
       I_S5D, I_WGLU, I_CONV, I_ALOG, I_DTB, I_DNNORM, I_WBRS, I_WBRD, I_WOUT, I_ROUTER, I_MBIAS, I_MGATE, I_MUP, I_MDOWN, I_SGATE, I_SUP, I_SDOWN };

struct MoeOrder {
    int ntiles, npn, G, c; const int* tile_e;
    __device__ __forceinline__ bool next(int i, pg8::Unit& u) const {
        const long L = (long)i * G + c; if (L >= (long)ntiles * npn) return false;
        const int tile = (int)(L / npn), pl = (int)(L % npn);
        const int e = __builtin_amdgcn_readfirstlane((int)__hip_atomic_load(tile_e + tile, __ATOMIC_RELAXED, __HIP_MEMORY_SCOPE_AGENT));
        u.pm = tile; u.pn = e * npn + pl; return true;
    }
    __device__ __forceinline__ void a_ready(const pg8::Unit&) const {}
    __device__ __forceinline__ void done(const pg8::Unit&) const {}
};

struct EpiBf16Mod {
    static constexpr bool PERM = true, AFTER_DRAIN = false;
    bf16* O; int ldc; int npn;
    __device__ __forceinline__ void operator()(const pg8::f32x4 (&acc)[2][2][4][2], const pg8::Unit& u, int wr, int wc, int fr, int fq) const {
        const int row0 = u.pm * 256 + wr * 64 + fr, col0 = (u.pn % npn) * 256 + wc * 32 + 8 * fq;
#pragma unroll
        for (int ai = 0; ai < 2; ++ai)
#pragma unroll
            for (int m = 0; m < 4; ++m) { bf16* rowp = O + (size_t)(row0 + ai * 128 + m * 16) * ldc + col0;
#pragma unroll
                for (int bj = 0; bj < 2; ++bj) { const pg8::f32x4 v0 = acc[ai][bj][m][0], v1 = acc[ai][bj][m][1];
                    u32x4 w; w.x = pk2(v0[0], v0[1]); w.y = pk2(v0[2], v0[3]); w.z = pk2(v1[0], v1[1]); w.w = pk2(v1[2], v1[3]);
                    *(u32x4*)(rowp + bj * 128) = w; } }
    }
};

struct EpiInProj {
    static constexpr bool PERM = true, AFTER_DRAIN = false;
    bf16* P; bf16* Ug;
    __device__ __forceinline__ void operator()(const pg8::f32x4 (&acc)[2][2][4][2], const pg8::Unit& u, int wr, int wc, int fr, int fq) const {
        const int row0 = u.pm * 256 + wr * 64 + fr, col0 = u.pn * 256 + wc * 32 + 8 * fq;
#pragma unroll
        for (int ai = 0; ai < 2; ++ai)
#pragma unroll
            for (int m = 0; m < 4; ++m) { const int t = row0 + ai * 128 + m * 16;
                int n, r;
                if (t < TC) { n = (t >> 8) * 72 + ((t & 255) >> 5); r = t & 31; } else { const int tt = t - TC, l = tt & 2047; n = (tt >> 11) * 72 + 8 + (l & 63); r = l >> 6; }
#pragma unroll
                for (int bj = 0; bj < 2; ++bj) { const pg8::f32x4 v0 = acc[ai][bj][m][0], v1 = acc[ai][bj][m][1]; const int col = col0 + bj * 128;
                    u32x4 w; w.x = pk2(v0[0], v0[1]); w.y = pk2(v0[2], v0[3]); w.z = pk2(v1[0], v1[1]); w.w = pk2(v1[2], v1[3]);
                    if (u.pn < 4) *(u32x4*)(Ug + ((size_t)((col >> 4) * S5N + n)) * 512 + r * 16 + (col & 15)) = w;
                    else *(u32x4*)(P + (size_t)t * NPAD + col) = w; } }
    }
};
struct EpiGlu {
    static constexpr bool PERM = true, AFTER_DRAIN = false;
    const bf16* Gb; bf16* O;
    __device__ __forceinline__ void operator()(const pg8::f32x4 (&acc)[2][2][4][2], const pg8::Unit& u, int wr, int wc, int fr, int fq) const {
        const int row0 = u.pm * 256 + wr * 64 + fr, col0 = u.pn * 256 + wc * 32 + 8 * fq;
#pragma unroll
        for (int ai = 0; ai < 2; ++ai)
#pragma unroll
            for (int m = 0; m < 4; ++m) { const size_t ro = (size_t)(row0 + ai * 128 + m * 16) * 1024 + col0;
#pragma unroll
                for (int bj = 0; bj < 2; ++bj) { const pg8::f32x4 v0 = acc[ai][bj][m][0], v1 = acc[ai][bj][m][1];
                    const u32x4 gq = *(const u32x4*)(Gb + ro + bj * 128);
                    u32x4 w;
                    w.x = pk2(bflo(gq.x) * sigmoidf_(v0[0]), bfhi(gq.x) * sigmoidf_(v0[1]));
                    w.y = pk2(bflo(gq.y) * sigmoidf_(v0[2]), bfhi(gq.y) * sigmoidf_(v0[3]));
                    w.z = pk2(bflo(gq.z) * sigmoidf_(v1[0]), bfhi(gq.z) * sigmoidf_(v1[1]));
                    w.w = pk2(bflo(gq.w) * sigmoidf_(v1[2]), bfhi(gq.w) * sigmoidf_(v1[3]));
                    *(u32x4*)(O + ro + bj * 128) = w; } }
    }
};
template <bool SECOND> struct EpiBr {
    static constexpr bool PERM = true, AFTER_DRAIN = false;
    const bf16* P; int gcol; float* M1; bf16* Mo;
    __device__ __forceinline__ void operator()(const pg8::f32x4 (&acc)[2][2][4][2], const pg8::Unit& u, int wr, int wc, int fr, int fq) const {
        const int row0 = u.pm * 256 + wr * 64 + fr, col0 = u.pn * 256 + wc * 32 + 8 * fq;
#pragma unroll
        for (int ai = 0; ai < 2; ++ai)
#pragma unroll
            for (int m = 0; m < 4; ++m) { const size_t row = (size_t)(row0 + ai * 128 + m * 16);
#pragma unroll
                for (int bj = 0; bj < 2; ++bj) { const pg8::f32x4 v0 = acc[ai][bj][m][0], v1 = acc[ai][bj][m][1];
                    const int col = col0 + bj * 128;
                    const u32x4 gq = *(const u32x4*)(P + row * NPAD + gcol + col);
                    f32x4 r0, r1;
                    r0[0] = sigmoidf_(bflo(gq.x)) * v0[0]; r0[1] = sigmoidf_(bfhi(gq.x)) * v0[1]; r0[2] = sigmoidf_(bflo(gq.y)) * v0[2]; r0[3] = sigmoidf_(bfhi(gq.y)) * v0[3];
                    r1[0] = sigmoidf_(bflo(gq.z)) * v1[0]; r1[1] = sigmoidf_(bfhi(gq.z)) * v1[1]; r1[2] = sigmoidf_(bflo(gq.w)) * v1[2]; r1[3] = sigmoidf_(bfhi(gq.w)) * v1[3];
                    float* mp = M1 + row * DM + col;
                    if (!SECOND) { *(f32x4*)mp = r0; *(f32x4*)(mp + 4) = r1; }
                    else { const f32x4 a0 = *(const f32x4*)mp, a1 = *(const f32x4*)(mp + 4); r0 += a0; r1 += a1;
                        u32x4 w; w.x = pk2(r0[0], r0[1]); w.y = pk2(r0[2], r0[3]); w.z = pk2(r1[0], r1[1]); w.w = pk2(r1[2], r1[3]);
                        *(u32x4*)(Mo + row * DM + col) = w; } }
                asm volatile("" ::: "memory"); }
    }
};
struct EpiSwiglu {
    static constexpr bool PERM = true, AFTER_DRAIN = false;
    bf16* O;
    __device__ __forceinline__ void operator()(const pg8::f32x4 (&acc)[2][2][4][2], const pg8::Unit& u, int wr, int wc, int fr, int fq) const {
        const int row0 = u.pm * 256 + wr * 64 + fr, col0 = (u.pn & 3) * 128 + wc * 32 + 8 * fq;
#pragma unroll
        for (int ai = 0; ai < 2; ++ai)
#pragma unroll
            for (int m = 0; m < 4; ++m) { bf16* rowp = O + (size_t)(row0 + ai * 128 + m * 16) * EDIM + col0;
                const pg8::f32x4 g0 = acc[ai][0][m][0], g1 = acc[ai][0][m][1], u0 = acc[ai][1][m][0], u1 = acc[ai][1][m][1];
                u32x4 w; w.x = pk2(siluf_(g0[0]) * u0[0], siluf_(g0[1]) * u0[1]); w.y = pk2(siluf_(g0[2]) * u0[2], siluf_(g0[3]) * u0[3]);
                w.z = pk2(siluf_(g1[0]) * u1[0], siluf_(g1[1]) * u1[1]); w.w = pk2(siluf_(g1[2]) * u1[2], siluf_(g1[3]) * u1[3]);
                *(u32x4*)rowp = w; }
    }
};

__device__ __forceinline__ const float* xrow_ptr(const unsigned char* ws, int layer, int t) {
    if (layer == 0) return t < TC ? inp(I_CTX) + (size_t)t * DM : inp(I_X) + (size_t)(t - TC) * DM;
    return (const float*)(ws + WS_X) + (size_t)t * DM;
}
__device__ __forceinline__ int row_lo(int layer) { return layer == NLAYER - 1 ? TC : 0; }
__device__ __forceinline__ int mods_row(int t) { return t < TC ? 4 : (t - TC) / SEQ; }
__device__ __forceinline__ void tr_item(const float* src, size_t ld, bf16* dst, int K, LAS float* scr, int lane) {
    float v[32];
#pragma unroll
    for (int i = 0; i < 32; ++i) { const int kk = 2 * i + (lane >> 5); v[i] = __builtin_nontemporal_load(src + (size_t)kk * ld + (lane & 31)); }
#pragma unroll
    for (int i = 0; i < 32; ++i) { const int kk = 2 * i + (lane >> 5); scr[kk * 33 + (lane & 31)] = v[i]; }
    LDS_WAIT();
    const int c = lane & 7;
#pragma unroll
    for (int j = 0; j < 4; ++j) { const int n = (lane >> 3) + 8 * j; const LAS float* s = scr + (8 * c) * 33 + n;
        u32x4 o; o.x = pk2(s[0 * 33], s[1 * 33]); o.y = pk2(s[2 * 33], s[3 * 33]); o.z = pk2(s[4 * 33], s[5 * 33]); o.w = pk2(s[6 * 33], s[7 * 33]);
        *(u32x4*)(dst + (size_t)n * K + 8 * c) = o; }
    LDS_WAIT();
}

__device__ __forceinline__ void s5_tables(const Frame& F, int layer, unsigned char* ws);
__device__ __forceinline__ void s5_state(const Frame& F, unsigned char* ws);
__device__ __forceinline__ void s5_out(const Frame& F, unsigned char* ws);

__device__ __forceinline__ void ph_pre(const Args& A, const Frame& F, int layer) {
    unsigned char* ws = A.ws; asm volatile("" : "+s"(ws));
    if (layer == 0) {
        LAS float* sil = (LAS float*)F.lds;
        for (int i = F.tid; i < 5 * DM; i += 512) { const int r = i / DM, k = i % DM; const float c = (r < 4) ? inp(I_C)[r * DM + k] : inp(I_CCTX)[k]; sil[i] = c / (1.f + expf(-c)); }
        __syncthreads();
        float* mods = (float*)(ws + WS_MODS);
        LAS float* part = (LAS float*)(F.lds + 5 * DM * 4);
        for (int it = F.vcu; it < NLAYER * 96; it += F.G) {
            const int l = it / 96, nb = it % 96;
            const float* W = inp(I_WMOD) + (size_t)l * DM * MODW + (size_t)(F.wave * 256) * MODW + nb * 128 + F.lane * 2;
            f32x2 acc[5];
#pragma unroll
            for (int r = 0; r < 5; ++r) acc[r] = (f32x2){0.f, 0.f};
#pragma unroll 8
            for (int k = 0; k < 256; ++k) { const f32x2 w = *(const f32x2*)(W + (size_t)k * MODW);
#pragma unroll
                for (int r = 0; r < 5; ++r) acc[r] += sil[r * DM + F.wave * 256 + k] * w; }
#pragma unroll
            for (int r = 0; r < 5; ++r) *(LAS f32x2*)(part + (F.wave * 5 + r) * 128 + F.lane * 2) = acc[r];
            __syncthreads();
            for (int o = F.tid; o < 5 * 128; o += 512) { const int r = o / 128, c = o % 128; float sum = inp(I_BMOD)[(size_t)l * MODW + nb * 128 + c];
#pragma unroll
                for (int w8 = 0; w8 < 8; ++w8) sum += part[(w8 * 5 + r) * 128 + c];
                mods[((size_t)l * 5 + r) * MODW + nb * 128 + c] = sum; }
            __syncthreads();
        }
        __syncthreads();
    }
    LAS float* scr = (LAS float*)(F.lds + F.wave * 16384);
    bf16* Wb = (bf16*)(ws + WS_W);
    constexpr int S_IN = 296 * 32, S_GLU = 512, S_BR = 1024, S_OUT = 2048, S_GU = NEX * 1024, S_DN = NEX * 512;
    constexpr int NITEMS = S_IN + S_GLU + 2 * S_BR + S_OUT + S_GU + S_DN;
    for (int it = F.gw; it < NITEMS; it += F.NGW) {
        int r = it; const float* src; size_t ld; bf16* dst; int K; bool zero = false;
        if (r < S_IN) {
            const int kb = r / 296, nb = r % 296, n0 = nb * 32, k0 = kb * 64;
            dst = Wb + WO_IN / 2 + (size_t)n0 * DM + k0; K = DM; ld = 9248;
            zero = n0 >= 9248;
            const int no = n0 < 5120 ? n0 : (n0 < 9216 ? n0 + 32 : n0 - 9216 + 5120);
            src = inp(I_WIN) + (size_t)layer * DM * 9248 + (size_t)k0 * 9248 + (zero ? 0 : no);
        } else if ((r -= S_IN) < S_GLU) { const int kb = r / 32, nb = r % 32;
            src = inp(I_WGLU) + (size_t)layer * 1024 * 1024 + (size_t)(kb * 64) * 1024 + nb * 32; ld = 1024; dst = Wb + WO_GLU / 2 + (size_t)(nb * 32) * 1024 + kb * 64; K = 1024;
        } else if ((r -= S_GLU) < 2 * S_BR) { const int which = r / S_BR, rr = r % S_BR, kb = rr / 64, nb = rr % 64;
            src = inp(which ? I_WBRD : I_WBRS) + (size_t)layer * 1024 * DM + (size_t)(kb * 64) * DM + nb * 32; ld = DM; dst = Wb + (which ? WO_BRD : WO_BRS) / 2 + (size_t)(nb * 32) * 1024 + kb * 64; K = 1024;
        } else if ((r -= 2 * S_BR) < S_OUT) { const int kb = r / 64, nb = r % 64;
            src = inp(I_WOUT) + (size_t)layer * DM * DM + (size_t)(kb * 64) * DM + nb * 32; ld = DM; dst = Wb + WO_OUT / 2 + (size_t)(nb * 32) * DM + kb * 64; K = DM;
        } else if ((r -= S_OUT) < S_GU) { const int e = r / 1024, rr = r % 1024, kb = rr / 32, nb = rr % 32, nd0 = nb * 32;
            const int pn = nd0 / 256, half = (nd0 % 256) / 128, j0 = pn * 128 + (nd0 % 128);
            const float* base = (e < NE) ? (inp(half ? I_MUP : I_MGATE) + ((size_t)layer * NE + e) * DM * EDIM) : (inp(half ? I_SUP : I_SGATE) + (size_t)layer * DM * EDIM);
            src = base + (size_t)(kb * 64) * EDIM + j0; ld = EDIM; dst = Wb + WO_GU / 2 + ((size_t)e * 1024 + nd0) * DM + kb * 64; K = DM;
        } else { r -= S_GU; const int e = r / 512, rr = r % 512, kb = rr / 64, nb = rr % 64;
            const float* base = (e < NE) ? (inp(I_MDOWN) + ((size_t)layer * NE + e) * EDIM * DM) : (inp(I_SDOWN) + (size_t)layer * EDIM * DM);
            src = base + (size_t)(kb * 64) * DM + nb * 32; ld = DM; dst = Wb + WO_DN / 2 + ((size_t)e * DM + nb * 32) * EDIM + kb * 64; K = EDIM; }
        if (zero) { const int c = F.lane & 7;
#pragma unroll
            for (int j = 0; j < 4; ++j) { const int n = (F.lane >> 3) + 8 * j; *(u32x4*)(dst + (size_t)n * K + 8 * c) = (u32x4){0u, 0u, 0u, 0u}; } }
        else tr_item(src, ld, dst, K, scr, F.lane);
    }
    s5_tables(F, layer, ws);
}

__device__ __forceinline__ void ph_n1(const Args& A, const Frame& F, int layer) {
    unsigned char* ws = A.ws; asm volatile("" : "+s"(ws));
    const float* mods = (const float*)(ws + WS_MODS) + (size_t)layer * 5 * MODW;
    const float* nw = inp(I_NMPRE) + (size_t)layer * DM;
    bf16* ab = (bf16*)(ws + WS_AB);
    for (int t = F.gw; t < TT; t += F.NGW) {
        const f32x4* xr = (const f32x4*)xrow_ptr(ws, layer, t) + F.lane;
        f32x4 v[8]; float ss = 0.f;
#pragma unroll
        for (int j = 0; j < 8; ++j) { v[j] = xr[64 * j]; ss += (v[j].x * v[j].x + v[j].y * v[j].y) + (v[j].z * v[j].z + v[j].w * v[j].w); }
        const float r = rsqrtf(wave_sum(ss) * (1.f / DM) + EPS);
        const float* mr = mods + (size_t)mods_row(t) * MODW;
        u32x2* o = (u32x2*)(ab + (size_t)t * DM) + F.lane;
#pragma unroll
        for (int j = 0; j < 8; ++j) { const int col = 4 * (F.lane + 64 * j);
            const f32x4 w = *(const f32x4*)(nw + col), sh = *(const f32x4*)(mr + col), sc = *(const f32x4*)(mr + DM + col);
            const f32x4 y = (v[j] * r * w) * (1.f + sc) + sh;
            u32x2 q; q.x = pk2(y.x, y.y); q.y = pk2(y.z, y.w); o[64 * j] = q; }
    }
}

__device__ __forceinline__ void ph_prep(const Args& A, const Frame& F, int layer) {
    unsigned char* ws = A.ws; asm volatile("" : "+s"(ws));
    const bf16* P = (const bf16*)(ws + WS_B + WB_P);
    bf16* qkv = (bf16*)(ws + WS_B + WB_QKV);
    float* bg = (float*)(ws + WS_B + WB_BG);
    const float* cw = inp(I_CONV) + (size_t)layer * 3 * 3072;
    s5_state(F, ws);
    for (int it = F.gw; it < TT * 8; it += F.NGW) {
        const int t = it >> 3, h = it & 7;
        bool hp, hn;
        if (t < TC) { const int i = t & 255; hp = i > 0; hn = i < 255; } else { const int l = (t - TC) & 2047; hp = l > 0; hn = l < 2047; }
        float val[3][2];
#pragma unroll
        for (int part = 0; part < 3; ++part) {
            const int ch = part * 1024 + h * 128 + 2 * F.lane;
            const bf16* pc = P + (size_t)t * NPAD + PC_QKV + ch;
            const unsigned x0 = *(const unsigned*)pc;
            const unsigned xm = hp ? *(const unsigned*)(pc - NPAD) : 0u;
            const unsigned xp = hn ? *(const unsigned*)(pc + NPAD) : 0u;
            const f32x2 w0 = *(const f32x2*)(cw + ch), w1 = *(const f32x2*)(cw + 3072 + ch), w2 = *(const f32x2*)(cw + 2 * 3072 + ch);
            val[part][0] = siluf_(w0.x * bflo(xm) + w1.x * bflo(x0) + w2.x * bflo(xp));
            val[part][1] = siluf_(w0.y * bfhi(xm) + w1.y * bfhi(x0) + w2.y * bfhi(xp));
        }
        const float qs = rsqrtf(wave_sum(val[0][0] * val[0][0] + val[0][1] * val[0][1]) + EPS) * 0.08838834764831845f;
        const float ks = rsqrtf(wave_sum(val[1][0] * val[1][0] + val[1][1] * val[1][1]) + EPS);
        bf16* o = qkv + (size_t)t * 3072 + h * 128 + 2 * F.lane;
        *(unsigned*)o = pk2(val[0][0] * qs, val[0][1] * qs);
        *(unsigned*)(o + 1024) = pk2(val[1][0] * ks, val[1][1] * ks);
        *(unsigned*)(o + 2048) = pk2(val[2][0], val[2][1]);
        if (h == 0 && F.lane < 32) {
            const int idx = F.lane, kind = idx >> 4, dh = idx & 15;
            const float raw = bf2f(P[(size_t)t * NPAD + PC_BA + idx]);
            float o2;
            if (kind == 0) o2 = 1.f / (1.f + expf(-raw));
            else { const float xx = raw + inp(I_DTB)[layer * 16 + dh]; const float sp = xx > 20.f ? xx : log1pf(expf(xx)); o2 = -expf(inp(I_ALOG)[layer * 16 + dh]) * sp; }
            bg[(size_t)t * 32 + idx] = o2;
        }
    }
}


typedef short bf16x8v __attribute__((ext_vector_type(8)));
typedef unsigned short u16x4v __attribute__((ext_vector_type(4)));
__device__ __forceinline__ int dn_tok(int b, int dir, int s) {
    if (s < CTXL) return b * CTXL + (dir ? (CTXL - 1 - s) : s);
    const int m = s - CTXL; return TC + b * SEQ + (dir ? (SEQ - 1 - m) : m);
}
__device__ __forceinline__ pg8::f32x4 mfma16(bf16x8v a, bf16x8v b, pg8::f32x4 c) { return __builtin_amdgcn_mfma_f32_16x16x32_bf16(a, b, c, 0, 0, 0); }
__device__ __forceinline__ bf16x8v frag_tr(unsigned lds_base, int pitch, int r0, int c0, int lane) {
    const int g = lane >> 4, q = (lane & 15) >> 2, p = lane & 3;
    const unsigned a0 = lds_base + (unsigned)((r0 + 8 * g + q) * pitch + (c0 + 4 * p) * 2);
    u16x4v lo, hi;
    asm volatile("ds_read_b64_tr_b16 %0, %2\n\tds_read_b64_tr_b16 %1, %3\n\ts_waitcnt lgkmcnt(0)" : "=&v"(lo), "=&v"(hi) : "v"(a0), "v"(a0 + 4u * (unsigned)pitch) : "memory");
    bf16x8v r; r[0] = (short)lo[0]; r[1] = (short)lo[1]; r[2] = (short)lo[2]; r[3] = (short)lo[3]; r[4] = (short)hi[0]; r[5] = (short)hi[1]; r[6] = (short)hi[2]; r[7] = (short)hi[3];
    return r;
}
__device__ __forceinline__ void ph_dn_a(const Args& A, const Frame& F, int layer, unsigned char* ws_in) {
    for (int unit = F.NGW - 1 - F.gw; unit < DN_UNITS; unit += F.NGW) {
        int lane = F.lane; asm volatile("" : "+v"(lane));
        unsigned char* ws = ws_in; asm volatile("" : "+s"(ws));
        const bf16* qkv = (const bf16*)(ws + WS_B + WB_QKV);
        const float* bg = (const float*)(ws + WS_B + WB_BG);
        unsigned char* dnu = ws + WS_B + WB_DNU;
        const int l15 = lane & 15, g4 = lane >> 4;
        LAS unsigned char* wl = F.lds + F.wave * 17408;
        LAS float* XA = (LAS float*)wl;
        LAS unsigned char* XK = wl;
        LAS unsigned char* TL = wl + 8704;
        LAS float* tab = (LAS float*)(wl + 8704 + 8192);
        const int c = unit % 36, dir = (unit / 36) & 1, h = (unit / 72) & 7, b = unit / 576;
        const int ti = dn_tok(b, dir, 64 * c + lane);
        const float beta = bg[(size_t)ti * 32 + dir * 8 + h], gi = bg[(size_t)ti * 32 + 16 + dir * 8 + h];
        float gc = gi;
#pragma unroll
        for (int o = 1; o < 64; o <<= 1) { const float t = __int_as_float(__builtin_amdgcn_ds_bpermute(((lane - o) & 63) << 2, __float_as_int(gc))); if (lane >= o) gc += t; }
        const float glast = __int_as_float(__builtin_amdgcn_readlane(__float_as_int(gc), 63));
        tab[lane] = gc; tab[64 + lane] = beta;
        float* SC = (float*)(dnu + DNU_SC) + (size_t)unit * 256;
        SC[lane] = __expf(gc); SC[64 + lane] = __expf(glast - gc); if (lane == 0) SC[128] = __expf(glast);
        LDS_WAIT();
        bf16x8v KF[4][4];
        int tokr[4];
#pragma unroll
        for (int rt = 0; rt < 4; ++rt) { tokr[rt] = dn_tok(b, dir, 64 * c + 16 * rt + l15);
#pragma unroll
            for (int ks = 0; ks < 4; ++ks) KF[rt][ks] = *(const bf16x8v*)(qkv + (size_t)tokr[rt] * 3072 + 1024 + h * 128 + 32 * ks + 8 * g4); }
        bf16* QKo = (bf16*)(dnu + DNU_QK) + (size_t)unit * 4096;
#pragma unroll
        for (int it = 0; it < 4; ++it) {
            bf16x8v QF[4];
#pragma unroll
            for (int ks = 0; ks < 4; ++ks) QF[ks] = *(const bf16x8v*)(qkv + (size_t)tokr[it] * 3072 + h * 128 + 32 * ks + 8 * g4);
            const int i = 16 * it + l15; const float gci = tab[i];
#pragma unroll
            for (int jt = 0; jt < 4; ++jt) {
                u32x2 w = (u32x2){0u, 0u};
                if (jt <= it) {
                    pg8::f32x4 acc = (pg8::f32x4){0.f, 0.f, 0.f, 0.f};
#pragma unroll
                    for (int ks = 0; ks < 4; ++ks) acc = mfma16(KF[jt][ks], QF[ks], acc);
                    const int j0 = 16 * jt + 4 * g4; const f32x4 gcj = *(const LAS f32x4*)(tab + j0);
                    float v[4];
#pragma unroll
                    for (int r = 0; r < 4; ++r) v[r] = (j0 + r <= i) ? acc[r] * __expf(gci - gcj[r]) : 0.f;
                    w.x = pk2(v[0], v[1]); w.y = pk2(v[2], v[3]);
                }
                *(u32x2*)(QKo + (size_t)i * 64 + 16 * jt + 4 * g4) = w;
            }
            asm volatile("" ::: "memory");
        }
        float Tc[64];
#pragma unroll
        for (int hf = 0; hf < 2; ++hf) {
#pragma unroll
            for (int it2 = 0; it2 < 2; ++it2) { const int it = 2 * hf + it2; const int i = 16 * it + l15; const float gci = tab[i], bi = tab[64 + i];
#pragma unroll
                for (int jt = 0; jt < 4; ++jt) if (jt <= it) {
                    pg8::f32x4 acc = (pg8::f32x4){0.f, 0.f, 0.f, 0.f};
#pragma unroll
                    for (int ks = 0; ks < 4; ++ks) acc = mfma16(KF[jt][ks], KF[it][ks], acc);
                    const int j0 = 16 * jt + 4 * g4; const f32x4 gcj = *(const LAS f32x4*)(tab + j0);
                    f32x4 o;
#pragma unroll
                    for (int r = 0; r < 4; ++r) o[r] = bi * acc[r] * __expf(fminf(gci - gcj[r], 0.f));
                    *(LAS f32x4*)(XA + (16 * it2 + l15) * 68 + j0) = o;
                } }
            LDS_WAIT();
#pragma unroll
            for (int ii = 0; ii < 32; ++ii) { const int i = 32 * hf + ii;
                float t = (i == lane) ? 1.f : 0.f;
#pragma unroll
                for (int q = 0; q < (i + 3) / 4; ++q) { const f32x4 a = *(const LAS f32x4*)(XA + ii * 68 + 4 * q);
#pragma unroll
                    for (int r = 0; r < 4; ++r) if (4 * q + r < i) t -= a[r] * Tc[4 * q + r]; }
                Tc[i] = t; asm volatile("" ::: "memory"); }
            LDS_WAIT();
        }
#pragma unroll
        for (int i = 0; i < 64; ++i) *(LAS bf16*)(TL + i * 128 + lane * 2) = (bf16)f2bf(Tc[i] * beta);
        LDS_WAIT();
        const unsigned xk_addr = (unsigned)(size_t)XK;
        bf16* Wo = (bf16*)(dnu + DNU_W) + (size_t)unit * 8192;
        bf16* KTo = (bf16*)(dnu + DNU_KT) + (size_t)unit * 8192;
        bf16* UTo = (bf16*)(dnu + DNU_UT) + (size_t)unit * 8192;
#pragma unroll
        for (int pass = 0; pass < 2; ++pass) {
#pragma unroll
          for (int chf = 0; chf < 2; ++chf) {
            pg8::f32x4 acc[4][4];
#pragma unroll
            for (int a = 0; a < 4; ++a)
#pragma unroll
                for (int bq = 0; bq < 4; ++bq) acc[a][bq] = (pg8::f32x4){0.f, 0.f, 0.f, 0.f};
#pragma unroll
            for (int ks = 0; ks < 2; ++ks) {
#pragma unroll
                for (int q = 0; q < 8; ++q) { const int n = lane + 64 * q, row = n >> 4, ch = n & 15;
                    const int tk = dn_tok(b, dir, 64 * c + 32 * ks + row);
                    const u32x4 d = *(const u32x4*)(qkv + (size_t)tk * 3072 + (pass ? 2048 : 1024) + h * 128 + 8 * ch);
                    *(LAS u32x4*)(XK + row * 272 + 16 * ch) = d; }
                LDS_WAIT();
                bf16x8v TF[4];
#pragma unroll
                for (int it = 0; it < 4; ++it) { u32x4 t = *(const LAS u32x4*)(TL + (16 * it + l15) * 128 + (32 * ks + 8 * g4) * 2);
                    if (pass == 0) { const f32x4 g0 = *(const LAS f32x4*)(tab + 32 * ks + 8 * g4), g1 = *(const LAS f32x4*)(tab + 32 * ks + 8 * g4 + 4);
                        t.x = pk2(bflo(t.x) * __expf(g0[0]), bfhi(t.x) * __expf(g0[1])); t.y = pk2(bflo(t.y) * __expf(g0[2]), bfhi(t.y) * __expf(g0[3]));
                        t.z = pk2(bflo(t.z) * __expf(g1[0]), bfhi(t.z) * __expf(g1[1])); t.w = pk2(bflo(t.w) * __expf(g1[2]), bfhi(t.w) * __expf(g1[3])); }
                    TF[it] = __builtin_bit_cast(bf16x8v, t); }
#pragma unroll
                for (int c4 = 0; c4 < 4; ++c4) { const int ct = 4 * chf + c4;
                    const bf16x8v XF = frag_tr(xk_addr, 272, 0, 16 * ct, lane);
                    if (pass == 0) { *(bf16x8v*)(KTo + (size_t)(16 * ct + l15) * 64 + 32 * ks + 8 * g4) = XF;
#pragma unroll
                        for (int it = 0; it < 4; ++it) acc[c4][it] = mfma16(XF, TF[it], acc[c4][it]); }
                    else {
#pragma unroll
                        for (int it = 0; it < 4; ++it) acc[c4][it] = mfma16(TF[it], XF, acc[c4][it]); }
                }
                LDS_WAIT();
            }
#pragma unroll
            for (int c4 = 0; c4 < 4; ++c4)
#pragma unroll
                for (int it = 0; it < 4; ++it) { const int ct = 4 * chf + c4; const pg8::f32x4 a = acc[c4][it]; u32x2 w; w.x = pk2(a[0], a[1]); w.y = pk2(a[2], a[3]);
                    if (pass == 0) *(u32x2*)(Wo + (size_t)(16 * it + l15) * 128 + 16 * ct + 4 * g4) = w;
                    else *(u32x2*)(UTo + (size_t)(16 * ct + l15) * 64 + 16 * it + 4 * g4) = w; }
            asm volatile("" ::: "memory");
          }
        }
    }
}

__device__ __forceinline__ void ph_dn_b(const Args& A, const Frame& F, int layer) {
    unsigned char* ws = A.ws; asm volatile("" : "+s"(ws));
    const bf16* qkv = (const bf16*)(ws + WS_B + WB_QKV);
    const unsigned char* dnu = ws + WS_B + WB_DNU;
    float* obase = (float*)(ws + WS_B + WB_O);
    const int lane = F.lane, l15 = lane & 15, g4 = lane >> 4, w = F.wave, mt = w >> 1, nt = w & 1, kt = w;
    LAS unsigned char* ST = F.lds;
    LAS unsigned char* VN = F.lds + 8704;
    LAS unsigned char* VS = F.lds + 8704 + 4608;
    for (int item = F.vcu; item < 256; item += F.G) {
        const int seq = item >> 2, vd0 = (item & 3) * 32, dir = seq & 1, h = (seq >> 1) & 7, b = seq >> 4;
        float* ob = obase + (size_t)dir * TT * 1024;
        for (int i = F.tid; i < 8704 / 4; i += 512) ((LAS unsigned*)ST)[i] = 0u;
        pg8::f32x4 accS[2]; accS[0] = (pg8::f32x4){0.f, 0.f, 0.f, 0.f}; accS[1] = accS[0];
        __syncthreads();
        bf16x8v WF[4], QF[4], QKF[2], KTF[2]; u32x2 Uc; f32x4 gam, ee; float glast;
        {   const size_t unit = (size_t)seq * 36;
            const int tq = dn_tok(b, dir, 16 * mt + l15);
#pragma unroll
            for (int ks = 0; ks < 4; ++ks) { WF[ks] = *(const bf16x8v*)((const bf16*)(dnu + DNU_W) + unit * 8192 + (size_t)(16 * mt + l15) * 128 + 32 * ks + 8 * g4);
                QF[ks] = *(const bf16x8v*)(qkv + (size_t)tq * 3072 + h * 128 + 32 * ks + 8 * g4); }
#pragma unroll
            for (int ks = 0; ks < 2; ++ks) { QKF[ks] = *(const bf16x8v*)((const bf16*)(dnu + DNU_QK) + unit * 4096 + (size_t)(16 * mt + l15) * 64 + 32 * ks + 8 * g4);
                KTF[ks] = *(const bf16x8v*)((const bf16*)(dnu + DNU_KT) + unit * 8192 + (size_t)(16 * kt + l15) * 64 + 32 * ks + 8 * g4); }
            Uc = *(const u32x2*)((const bf16*)(dnu + DNU_UT) + unit * 8192 + (size_t)(vd0 + 16 * nt + l15) * 64 + 16 * mt + 4 * g4);
            const float* SC = (const float*)(dnu + DNU_SC) + unit * 256;
            gam = *(const f32x4*)(SC + 16 * mt + 4 * g4); ee = *(const f32x4*)(SC + 64 + 16 * mt + 4 * g4); glast = SC[128]; }
        for (int c = 0; c < 36; ++c) {
            bf16x8v cW[4], cQ[4], cQK[2], cKT[2]; const u32x2 cU = Uc; const f32x4 cgam = gam, cee = ee; const float cgl = glast;
#pragma unroll
            for (int ks = 0; ks < 4; ++ks) { cW[ks] = WF[ks]; cQ[ks] = QF[ks]; }
#pragma unroll
            for (int ks = 0; ks < 2; ++ks) { cQK[ks] = QKF[ks]; cKT[ks] = KTF[ks]; }
            if (c + 1 < 36) { const size_t unit = (size_t)seq * 36 + c + 1;
                const int tq = dn_tok(b, dir, 64 * (c + 1) + 16 * mt + l15);
#pragma unroll
                for (int ks = 0; ks < 4; ++ks) { WF[ks] = *(const bf16x8v*)((const bf16*)(dnu + DNU_W) + unit * 8192 + (size_t)(16 * mt + l15) * 128 + 32 * ks + 8 * g4);
                    QF[ks] = *(const bf16x8v*)(qkv + (size_t)tq * 3072 + h * 128 + 32 * ks + 8 * g4); }
#pragma unroll
                for (int ks = 0; ks < 2; ++ks) { QKF[ks] = *(const bf16x8v*)((const bf16*)(dnu + DNU_QK) + unit * 4096 + (size_t)(16 * mt + l15) * 64 + 32 * ks + 8 * g4);
                    KTF[ks] = *(const bf16x8v*)((const bf16*)(dnu + DNU_KT) + unit * 8192 + (size_t)(16 * kt + l15) * 64 + 32 * ks + 8 * g4); }
                Uc = *(const u32x2*)((const bf16*)(dnu + DNU_UT) + unit * 8192 + (size_t)(vd0 + 16 * nt + l15) * 64 + 16 * mt + 4 * g4);
                const float* SC = (const float*)(dnu + DNU_SC) + unit * 256;
                gam = *(const f32x4*)(SC + 16 * mt + 4 * g4); ee = *(const f32x4*)(SC + 64 + 16 * mt + 4 * g4); glast = SC[128]; }
            pg8::f32x4 P = (pg8::f32x4){0.f, 0.f, 0.f, 0.f}, O1 = P;
#pragma unroll
            for (int ks = 0; ks < 4; ++ks) { const bf16x8v SF = *(const LAS bf16x8v*)(ST + (16 * nt + l15) * 272 + (32 * ks + 8 * g4) * 2);
                P = mfma16(cW[ks], SF, P); O1 = mfma16(cQ[ks], SF, O1); }
            float vn[4];
            vn[0] = bflo(cU.x) - P[0]; vn[1] = bfhi(cU.x) - P[1]; vn[2] = bflo(cU.y) - P[2]; vn[3] = bfhi(cU.y) - P[3];
            { u32x2 a; a.x = pk2(vn[0], vn[1]); a.y = pk2(vn[2], vn[3]); *(LAS u32x2*)(VN + (16 * nt + l15) * 144 + (16 * mt + 4 * g4) * 2) = a;
              u32x2 e; e.x = pk2(vn[0] * cee[0], vn[1] * cee[1]); e.y = pk2(vn[2] * cee[2], vn[3] * cee[3]); *(LAS u32x2*)(VS + (16 * nt + l15) * 144 + (16 * mt + 4 * g4) * 2) = e; }
            __syncthreads();
            pg8::f32x4 O2 = (pg8::f32x4){0.f, 0.f, 0.f, 0.f};
#pragma unroll
            for (int ks = 0; ks < 2; ++ks) { const bf16x8v VF = *(const LAS bf16x8v*)(VN + (16 * nt + l15) * 144 + (32 * ks + 8 * g4) * 2); O2 = mfma16(cQK[ks], VF, O2); }
#pragma unroll
            for (int r = 0; r < 4; ++r) { const int tk = dn_tok(b, dir, 64 * c + 16 * mt + 4 * g4 + r); ob[(size_t)tk * 1024 + h * 128 + vd0 + 16 * nt + l15] = cgam[r] * O1[r] + O2[r]; }
#pragma unroll
            for (int n2 = 0; n2 < 2; ++n2) { pg8::f32x4 a = accS[n2] * cgl;
#pragma unroll
                for (int ks = 0; ks < 2; ++ks) { const bf16x8v VF = *(const LAS bf16x8v*)(VS + (16 * n2 + l15) * 144 + (32 * ks + 8 * g4) * 2); a = mfma16(cKT[ks], VF, a); }
                accS[n2] = a;
                u32x2 sw; sw.x = pk2(a[0], a[1]); sw.y = pk2(a[2], a[3]); *(LAS u32x2*)(ST + (16 * n2 + l15) * 272 + (16 * kt + 4 * g4) * 2) = sw; }
            __syncthreads();
        }
    }
    s5_out(F, ws);
}


struct S5Lam { float abr, abi, cr, ci, lrs, lis; };
__device__ __forceinline__ S5Lam s5_lam(int layer, int dir, int g, int p) {
    const size_t pg = (size_t)(layer * 2 + dir) * 64 + g;
    const float lr = inp(I_LAMRE)[pg * 64 + p], li = inp(I_LAMIM)[pg * 64 + p], step = expf(inp(I_LOGSTEP)[pg]);
    S5Lam L; L.lrs = lr * step; L.lis = li * step;
    const float mag = expf(L.lrs); L.abr = mag * cosf(L.lis); L.abi = mag * sinf(L.lis);
    const float den = lr * lr + li * li, nr = L.abr - 1.f; L.cr = (nr * lr + L.abi * li) / den; L.ci = (L.abi * lr - nr * li) / den;
    return L;
}
__device__ __forceinline__ void s5_pow(const S5Lam& L, int n, float& pr, float& pi) { const float m = expf(L.lrs * (float)n); float sn, cs; sincosf(L.lis * (float)n, &sn, &cs); pr = m * cs; pi = m * sn; }
__device__ __forceinline__ void s5_tables(const Frame& F, int layer, unsigned char* ws) {
    unsigned char* sb = ws + WS_B + WB_S5;
    bf16* Kc = (bf16*)(sb + S5_KC); bf16* Wst = (bf16*)(sb + S5_WST); bf16* Wout = (bf16*)(sb + S5_WOUT); float* L32 = (float*)(sb + S5_L32);
    const int gt = F.vcu * 512 + F.tid, NT = F.G * 512;
    for (int it = gt; it < 64 * 63 * 16; it += NT) {
        const int j = it & 15, l = (it >> 4) % 63, g = it / (63 * 16);
        float acc[16];
#pragma unroll
        for (int q = 0; q < 16; ++q) acc[q] = 0.f;
        for (int d = 0; d < 2; ++d) {
            if ((d == 0 && l < 31) || (d == 1 && l > 31)) continue;
            const int tau = d == 0 ? l - 31 : 31 - l;
            const size_t pg = (size_t)(layer * 2 + d) * 64 + g;
            for (int p = 0; p < 64; ++p) {
                const S5Lam L = s5_lam(layer, d, g, p);
                float pr, pi; s5_pow(L, tau, pr, pi);
                const float c_r = inp(I_CRE)[(pg * 16 + j) * 64 + p], c_i = inp(I_CIM)[(pg * 16 + j) * 64 + p];
                const float tr = c_r * pr - c_i * pi, ti = c_r * pi + c_i * pr;
                const float ur = tr * L.cr - ti * L.ci, ui = tr * L.ci + ti * L.cr;
                const float* br = inp(I_BRE) + (pg * 64 + p) * 16; const float* bi = inp(I_BIM) + (pg * 64 + p) * 16;
#pragma unroll
                for (int q = 0; q < 16; ++q) acc[q] += ur * br[q] - ui * bi[q];
            }
        }
        if (l == 31) acc[j] += inp(I_S5D)[(size_t)layer * 1024 + g * 16 + j];
        u32x4 w0, w1;
        w0.x = pk2(acc[0], acc[1]); w0.y = pk2(acc[2], acc[3]); w0.z = pk2(acc[4], acc[5]); w0.w = pk2(acc[6], acc[7]);
        w1.x = pk2(acc[8], acc[9]); w1.y = pk2(acc[10], acc[11]); w1.z = pk2(acc[12], acc[13]); w1.w = pk2(acc[14], acc[15]);
        bf16* o = Kc + ((size_t)(g * 63 + l) * 16 + j) * 16; *(u32x4*)o = w0; *(u32x4*)(o + 8) = w1;
    }
    for (int it = gt; it < 64 * 2 * 32 * 64; it += NT) {
        const int p = it & 63, r = (it >> 6) & 31, d = (it >> 11) & 1, g = it >> 12;
        const size_t pg = (size_t)(layer * 2 + d) * 64 + g;
        const S5Lam L = s5_lam(layer, d, g, p);
        float pr, pi; s5_pow(L, d == 0 ? 31 - r : r, pr, pi);
        const float qr = pr * L.cr - pi * L.ci, qi = pr * L.ci + pi * L.cr;
        const float* br = inp(I_BRE) + (pg * 64 + p) * 16; const float* bi = inp(I_BIM) + (pg * 64 + p) * 16;
        float wr_[16], wi_[16];
#pragma unroll
        for (int q = 0; q < 16; ++q) { wr_[q] = qr * br[q] - qi * bi[q]; wi_[q] = qr * bi[q] + qi * br[q]; }
        bf16* o = Wst + ((size_t)(g * 2 + d) * 128 + p) * 512 + r * 16;
        u32x4 a0, a1, b0, b1;
        a0.x = pk2(wr_[0], wr_[1]); a0.y = pk2(wr_[2], wr_[3]); a0.z = pk2(wr_[4], wr_[5]); a0.w = pk2(wr_[6], wr_[7]);
        a1.x = pk2(wr_[8], wr_[9]); a1.y = pk2(wr_[10], wr_[11]); a1.z = pk2(wr_[12], wr_[13]); a1.w = pk2(wr_[14], wr_[15]);
        b0.x = pk2(wi_[0], wi_[1]); b0.y = pk2(wi_[2], wi_[3]); b0.z = pk2(wi_[4], wi_[5]); b0.w = pk2(wi_[6], wi_[7]);
        b1.x = pk2(wi_[8], wi_[9]); b1.y = pk2(wi_[10], wi_[11]); b1.z = pk2(wi_[12], wi_[13]); b1.w = pk2(wi_[14], wi_[15]);
        *(u32x4*)o = a0; *(u32x4*)(o + 8) = a1; *(u32x4*)(o + 64 * 512) = b0; *(u32x4*)(o + 64 * 512 + 8) = b1;
    }
    for (int it = gt; it < 64 * 2 * 32 * 64; it += NT) {
        const int p = it & 63, sp = (it >> 6) & 31, d = (it >> 11) & 1, g = it >> 12;
        const size_t pg = (size_t)(layer * 2 + d) * 64 + g;
        const S5Lam L = s5_lam(layer, d, g, p);
        float pr, pi; s5_pow(L, d == 0 ? sp + 1 : 32 - sp, pr, pi);
        bf16* o = Wout + ((size_t)(g * 2 + d) * 512 + sp * 16) * 128 + p;
#pragma unroll
        for (int j = 0; j < 16; ++j) { const float c_r = inp(I_CRE)[(pg * 16 + j) * 64 + p], c_i = inp(I_CIM)[(pg * 16 + j) * 64 + p];
            o[(size_t)j * 128] = (bf16)f2bf(c_r * pr - c_i * pi); o[(size_t)j * 128 + 64] = (bf16)f2bf(-(c_r * pi + c_i * pr)); }
    }
    for (int it = gt; it < 64 * 2 * 64; it += NT) { const int p = it & 63, d = (it >> 6) & 1, g = it >> 7; const S5Lam L = s5_lam(layer, d, g, p); float pr, pi; s5_pow(L, 32, pr, pi); L32[2 * it] = pr; L32[2 * it + 1] = pi; }
}
__device__ __forceinline__ void s5_state(const Frame& F, unsigned char* ws) {
    const unsigned char* sb = ws + WS_B + WB_S5;
    const int l15 = F.lane & 15, g4 = F.lane >> 4, w = F.wave;
    for (int item = F.vcu; item < 256; item += F.G) {
        const int nh = item & 1, d = (item >> 1) & 1, g = item >> 2;
        const bf16* Arow = (const bf16*)(sb + S5_WST) + ((size_t)(g * 2 + d) * 128 + 16 * w + l15) * 512 + 8 * g4;
        const bf16* Brow = (const bf16*)(sb + S5_UG) + ((size_t)g * S5N + nh * 144 + l15) * 512 + 8 * g4;
        pg8::f32x4 acc[9];
#pragma unroll
        for (int q = 0; q < 9; ++q) acc[q] = (pg8::f32x4){0.f, 0.f, 0.f, 0.f};
#pragma unroll 2
        for (int ks = 0; ks < 16; ++ks) { const bf16x8v a = *(const bf16x8v*)(Arow + 32 * ks);
#pragma unroll
            for (int q = 0; q < 9; ++q) { const bf16x8v bq = *(const bf16x8v*)(Brow + (size_t)(16 * q) * 512 + 32 * ks); acc[q] = mfma16(a, bq, acc[q]); } }
        float* So = (float*)(sb + S5_SLOC) + ((size_t)(g * 2 + d) * S5N + nh * 144 + l15) * 128 + 16 * w + 4 * g4;
#pragma unroll
        for (int q = 0; q < 9; ++q) *(f32x4*)(So + (size_t)(16 * q) * 128) = acc[q];
    }
}
__device__ __forceinline__ void s5_carry(const Frame& F, unsigned char* ws) {
    const unsigned char* sb = ws + WS_B + WB_S5;
    if (F.gw >= 512) return;
    const int p = F.lane, b = F.gw & 3, d = (F.gw >> 2) & 1, g = F.gw >> 3;
    const float* L32 = (const float*)(sb + S5_L32) + 2 * ((g * 2 + d) * 64 + p);
    const float lr = L32[0], li = L32[1];
    const float* Sl = (const float*)(sb + S5_SLOC) + ((size_t)(g * 2 + d) * S5N + b * 72) * 128 + p;
    bf16* Hi = (bf16*)(sb + S5_HIN) + ((size_t)(g * 2 + d) * S5N + b * 72) * 128 + p;
    float hr = 0.f, hi = 0.f;
#pragma unroll 4
    for (int st = 0; st < 72; ++st) {
        const int ch = d == 0 ? st : (st < 8 ? 7 - st : 79 - st);
        Hi[(size_t)ch * 128] = (bf16)f2bf(hr); Hi[(size_t)ch * 128 + 64] = (bf16)f2bf(hi);
        const float sr = Sl[(size_t)ch * 128], si = Sl[(size_t)ch * 128 + 64];
        const float nr = lr * hr - li * hi + sr, ni = lr * hi + li * hr + si; hr = nr; hi = ni;
    }
}
__device__ __forceinline__ void s5_out(const Frame& F, unsigned char* ws) {
    const unsigned char* sb = ws + WS_B + WB_S5;
    bf16* gb = (bf16*)(ws + WS_B + WB_G);
    const int l15 = F.lane & 15, g4 = F.lane >> 4, w = F.wave;
    LAS unsigned char* KL = F.lds;
    for (int item = F.vcu; item < 256; item += F.G) {
        const int mq = item & 3, g = item >> 2;
        __syncthreads();
        for (int i = F.tid; i < 63 * 32; i += 512) *((LAS u32x4*)KL + i) = *((const u32x4*)(sb + S5_KC + (size_t)g * 63 * 512) + i);
        __syncthreads();
        const int ntn = (w < 2) ? 3 : 2;
        pg8::f32x4 acc[8][3];
#pragma unroll
        for (int m = 0; m < 8; ++m)
#pragma unroll
            for (int q = 0; q < 3; ++q) acc[m][q] = (pg8::f32x4){0.f, 0.f, 0.f, 0.f};
        const bf16* Ub = (const bf16*)(sb + S5_UG) + ((size_t)g * S5N + 16 * w + l15) * 512 + 8 * g4;
#pragma unroll 2
        for (int ks = 0; ks < 16; ++ks) {
            bf16x8v bq[3];
#pragma unroll
            for (int q = 0; q < 3; ++q) if (q < ntn) bq[q] = *(const bf16x8v*)(Ub + (size_t)(128 * q) * 512 + 32 * ks);
            const int r = 2 * ks + (g4 >> 1);
#pragma unroll
            for (int m = 0; m < 8; ++m) { const int sp = 8 * mq + m, l = sp - r + 31;
                const bf16x8v a = *(const LAS bf16x8v*)(KL + ((l * 16 + l15) * 16 + 8 * (g4 & 1)) * 2);
#pragma unroll
                for (int q = 0; q < 3; ++q) if (q < ntn) acc[m][q] = mfma16(a, bq[q], acc[m][q]); }
        }
#pragma unroll
        for (int d = 0; d < 2; ++d) {
            const bf16* Hb = (const bf16*)(sb + S5_HIN) + ((size_t)(g * 2 + d) * S5N + 16 * w + l15) * 128 + 8 * g4;
            const bf16* Wo = (const bf16*)(sb + S5_WOUT) + ((size_t)(g * 2 + d) * 512 + (8 * mq) * 16 + l15) * 128 + 8 * g4;
#pragma unroll
            for (int ks = 0; ks < 4; ++ks) {
                bf16x8v bq[3];
#pragma unroll
                for (int q = 0; q < 3; ++q) if (q < ntn) bq[q] = *(const bf16x8v*)(Hb + (size_t)(128 * q) * 128 + 32 * ks);
#pragma unroll
                for (int m = 0; m < 8; ++m) { const bf16x8v a = *(const bf16x8v*)(Wo + (size_t)(16 * m) * 128 + 32 * ks);
#pragma unroll
                    for (int q = 0; q < 3; ++q) if (q < ntn) acc[m][q] = mfma16(a, bq[q], acc[m][q]); }
            }
        }
#pragma unroll
        for (int q = 0; q < 3; ++q) if (q < ntn) {
            const int n = 16 * (w + 8 * q) + l15, b = n / 72, ch = n % 72;
#pragma unroll
            for (int m = 0; m < 8; ++m) { const int sp = 8 * mq + m;
                const int t = ch < 8 ? b * CTXL + ch * 32 + sp : TC + b * SEQ + sp * 64 + (ch - 8);
                const pg8::f32x4 a = acc[m][q];
                u32x2 o; o.x = pk2(gelu_tanh(a[0]), gelu_tanh(a[1])); o.y = pk2(gelu_tanh(a[2]), gelu_tanh(a[3]));
                *(u32x2*)(gb + (size_t)t * 1024 + g * 16 + 4 * g4) = o; }
        }
    }
}

__device__ __forceinline__ void ph_scan(const Args& A, const Frame& F, int layer) {
    unsigned char* ws = A.ws; asm volatile("" : "+s"(ws));
    s5_carry(F, ws);
    ph_dn_a(A, F, layer, ws);
}

__device__ __forceinline__ void ph_post(const Args& A, const Frame& F, int layer) {
    unsigned char* ws = A.ws; asm volatile("" : "+s"(ws));
    const bf16* P = (const bf16*)(ws + WS_B + WB_P);
    const float* ob = (const float*)(ws + WS_B + WB_O);
    bf16* dno = (bf16*)(ws + WS_B + WB_DNO);
    const int c0 = 16 * F.lane;
    for (int t = row_lo(layer) + F.gw; t < TT; t += F.NGW) {
        {
            float o[16]; float ss = 0.f;
#pragma unroll
            for (int q = 0; q < 4; ++q) { const f32x4 a = *(const f32x4*)(ob + (size_t)t * 1024 + c0 + 4 * q), bq = *(const f32x4*)(ob + (size_t)(TT + t) * 1024 + c0 + 4 * q);
#pragma unroll
                for (int j = 0; j < 4; ++j) { o[4 * q + j] = a[j] + bq[j]; ss += o[4 * q + j] * o[4 * q + j]; } }
            ss += __shfl_xor(ss, 1); ss += __shfl_xor(ss, 2); ss += __shfl_xor(ss, 4);
            const float r = rsqrtf(ss * (1.f / 128.f) + EPS);
            const u32x4 za = *(const u32x4*)(P + (size_t)t * NPAD + PC_Z + c0), zb = *(const u32x4*)(P + (size_t)t * NPAD + PC_Z + c0 + 8);
            float z[16];
            z[0] = bflo(za.x); z[1] = bfhi(za.x); z[2] = bflo(za.y); z[3] = bfhi(za.y); z[4] = bflo(za.z); z[5] = bfhi(za.z); z[6] = bflo(za.w); z[7] = bfhi(za.w);
            z[8] = bflo(zb.x); z[9] = bfhi(zb.x); z[10] = bflo(zb.y); z[11] = bfhi(zb.y); z[12] = bflo(zb.z); z[13] = bfhi(zb.z); z[14] = bflo(zb.w); z[15] = bfhi(zb.w);
            const float* nw = inp(I_DNNORM) + (size_t)layer * 128 + (c0 & 127);
            float e[16];
#pragma unroll
            for (int j = 0; j < 16; ++j) e[j] = o[j] * r * nw[j] * siluf_(z[j]);
            u32x4 w0, w1;
            w0.x = pk2(e[0], e[1]); w0.y = pk2(e[2], e[3]); w0.z = pk2(e[4], e[5]); w0.w = pk2(e[6], e[7]);
            w1.x = pk2(e[8], e[9]); w1.y = pk2(e[10], e[11]); w1.z = pk2(e[12], e[13]); w1.w = pk2(e[14], e[15]);
            *(u32x4*)(dno + (size_t)t * 1024 + c0) = w0; *(u32x4*)(dno + (size_t)t * 1024 + c0 + 8) = w1;
        }
    }
}

__device__ __forceinline__ void ph_row2(const Args& A, const Frame& F, int layer) {
    unsigned char* ws = A.ws; asm volatile("" : "+s"(ws));
    const float* mods = (const float*)(ws + WS_MODS) + (size_t)layer * 5 * MODW;
    const float* mix = (const float*)(ws + WS_B + WB_MIX);
    float* xc = (float*)(ws + WS_X);
    bf16* hb = (bf16*)(ws + WS_AB);
    const float* nwp = inp(I_NMPOST) + (size_t)layer * DM;
    const float* nwf = inp(I_NFPRE) + (size_t)layer * DM;
    const float* wr = inp(I_ROUTER) + (size_t)layer * DM * NE;
    int* eidx = (int*)(ws + WS_EIDX); float* wts = (float*)(ws + WS_WTS);
    unsigned* cnt = (unsigned*)(ws + WS_CTL) + CW_CNT + layer * 128;
    LAS float* H = (LAS float*)F.lds;
    LAS float* PP = (LAS float*)(F.lds + 65536);
    const float ebias = inp(I_MBIAS)[layer * NE + F.lane];
    const int r0 = row_lo(layer), nitems = (TT - r0) / 8;
    for (int item = F.vcu; item < nitems; item += F.G) {
        const int t = r0 + item * 8 + F.wave;
        {
            const f32x4* mr4 = (const f32x4*)(mix + (size_t)t * DM) + F.lane;
            const f32x4* xr4 = (const f32x4*)xrow_ptr(ws, layer, t) + F.lane;
            const float* mrow = mods + (size_t)mods_row(t) * MODW;
            f32x4 v[8]; float ss = 0.f;
#pragma unroll
            for (int j = 0; j < 8; ++j) { v[j] = mr4[64 * j]; ss += (v[j].x * v[j].x + v[j].y * v[j].y) + (v[j].z * v[j].z + v[j].w * v[j].w); }
            const float r = rsqrtf(wave_sum(ss) * (1.f / DM) + EPS);
            float ss2 = 0.f;
#pragma unroll
            for (int j = 0; j < 8; ++j) { const int col = 4 * (F.lane + 64 * j);
                const f32x4 w = *(const f32x4*)(nwp + col), gt = *(const f32x4*)(mrow + 2 * DM + col), xo = xr4[64 * j];
                v[j] = xo + gt * (v[j] * r * w);
                *((f32x4*)(xc + (size_t)t * DM) + F.lane + 64 * j) = v[j];
                ss2 += (v[j].x * v[j].x + v[j].y * v[j].y) + (v[j].z * v[j].z + v[j].w * v[j].w); }
            const float r2 = rsqrtf(wave_sum(ss2) * (1.f / DM) + EPS);
            u32x2* ho = (u32x2*)(hb + (size_t)t * DM) + F.lane;
#pragma unroll
            for (int j = 0; j < 8; ++j) { const int col = 4 * (F.lane + 64 * j);
                const f32x4 w = *(const f32x4*)(nwf + col), sh = *(const f32x4*)(mrow + 3 * DM + col), sc = *(const f32x4*)(mrow + 4 * DM + col);
                const f32x4 y = (v[j] * r2 * w) * (1.f + sc) + sh;
                u32x2 q; q.x = pk2(y.x, y.y); q.y = pk2(y.z, y.w); ho[64 * j] = q;
                *((LAS f32x4*)(H + F.wave * DM) + F.lane + 64 * j) = y; }
        }
        __syncthreads();
        {
            float acc[8];
#pragma unroll
            for (int rr = 0; rr < 8; ++rr) acc[rr] = 0.f;
            const float* wp = wr + (size_t)(256 * F.wave) * NE + F.lane;
#pragma unroll 2
            for (int d4 = 0; d4 < 64; ++d4) {
                const float w0 = wp[(4 * d4) * NE], w1 = wp[(4 * d4 + 1) * NE], w2 = wp[(4 * d4 + 2) * NE], w3 = wp[(4 * d4 + 3) * NE];
#pragma unroll
                for (int rr = 0; rr < 8; ++rr) { const f32x4 h4 = *((const LAS f32x4*)(H + rr * DM + 256 * F.wave) + d4);
                    acc[rr] += h4.x * w0; acc[rr] += h4.y * w1; acc[rr] += h4.z * w2; acc[rr] += h4.w * w3; } }
#pragma unroll
            for (int rr = 0; rr < 8; ++rr) PP[(F.wave * 8 + rr) * 64 + F.lane] = acc[rr];
        }
        __syncthreads();
        {
            float logit = 0.f;
#pragma unroll
            for (int k8 = 0; k8 < 8; ++k8) logit += PP[(k8 * 8 + F.wave) * 64 + F.lane];
            const float score = 1.f / (1.f + expf(-logit));
            const float sel = score + ebias;
            float m1 = sel;
            m1 = fmaxf(m1, __shfl_xor(m1, 1)); m1 = fmaxf(m1, __shfl_xor(m1, 2)); m1 = fmaxf(m1, __shfl_xor(m1, 4));
            const unsigned long long eqm = __ballot(sel == m1);
            const int gbase = F.lane & ~7;
            const unsigned gm = (unsigned)((eqm >> gbase) & 0xffull);
            const int amax = gbase + __builtin_ctz(gm);
            float s2 = (F.lane == amax) ? -__builtin_inff() : sel;
            s2 = fmaxf(s2, __shfl_xor(s2, 1)); s2 = fmaxf(s2, __shfl_xor(s2, 2)); s2 = fmaxf(s2, __shfl_xor(s2, 4));
            const float gs = m1 + s2;
            int grank = 0; const int myg = F.lane >> 3;
#pragma unroll
            for (int g2 = 0; g2 < 8; ++g2) { const float og = __shfl(gs, g2 * 8); grank += (og > gs || (og == gs && g2 < myg)) ? 1 : 0; }
            const float selm = (grank < 4) ? sel : -__builtin_inff();
            int rank = 0;
#pragma unroll 8
            for (int e2 = 0; e2 < 64; ++e2) { const float os = __shfl(selm, e2); rank += (os > selm || (os == selm && e2 < F.lane)) ? 1 : 0; }
            const bool chosen = (grank < 4) && (rank < 8);
            const float wsum = wave_sum(chosen ? score : 0.f);
            if (chosen) { eidx[(size_t)t * 8 + rank] = F.lane; wts[(size_t)t * 8 + rank] = score / wsum * 2.5f; atomicAdd(cnt + F.lane, 1u); }
        }
        __syncthreads();
    }
}

__device__ __forceinline__ void ph_fill(const Args& A, const Frame& F, int layer) {
    unsigned char* ws = A.ws; asm volatile("" : "+s"(ws));
    unsigned* ctl = (unsigned*)(ws + WS_CTL);
    LAS int* off = (LAS int*)(F.lds);
    LAS int* cn = (LAS int*)(F.lds + 1024);
    const int r0 = row_lo(layer), nrows = TT - r0;
    if (F.tid < NEX) cn[F.tid] = (F.tid < NE) ? (int)__hip_atomic_load(ctl + CW_CNT + layer * 128 + F.tid, __ATOMIC_RELAXED, __HIP_MEMORY_SCOPE_AGENT) : nrows;
    __syncthreads();
    if (F.tid == 0) {
        int o = 0;
        for (int e = 0; e < NEX; ++e) { off[e] = o; o += (cn[e] + 255) & ~255; }
        off[NEX] = o;
    }
    __syncthreads();
    int* misc = (int*)(ws + WS_MISC) + layer * 1024;
    if (blockIdx.x == 0) {
        const int ntiles = off[NEX] >> 8;
        for (int tl = F.tid; tl < ntiles; tl += 512) { int e = 0; for (int q = 0; q < NEX; ++q) if ((off[q] >> 8) <= tl) e = q; misc[tl] = e; }
        if (F.tid == 0) misc[512] = ntiles;
    }
    {
        bf16* hpz = (bf16*)(ws + WS_B + WB_HPERM);
        for (int e = 0; e < NE; ++e) { const int r0 = off[e] + cn[e], r1 = off[e + 1];
            for (int r = r0 + F.gw; r < r1; r += F.NGW) { u32x4* d = (u32x4*)(hpz + (size_t)r * DM) + F.lane;
#pragma unroll
                for (int j = 0; j < 4; ++j) d[64 * j] = (u32x4){0u, 0u, 0u, 0u}; } }
    }
    const int* eidx = (const int*)(ws + WS_EIDX);
    int* slot_of = (int*)(ws + WS_SLOT);
    const bf16* hb = (const bf16*)(ws + WS_AB);
    bf16* hp = (bf16*)(ws + WS_B + WB_HPERM);
    for (int it = F.gw; it < nrows * 9; it += F.NGW) {
        const int t = r0 + it / 9, k = it % 9;
        int slot;
        if (k < 8) { const int e = eidx[(size_t)t * 8 + k]; int pos = 0;
            if (F.lane == 0) pos = (int)atomicAdd(ctl + CW_FILL + layer * 128 + e, 1u);
            pos = __builtin_amdgcn_readfirstlane(pos); slot = off[e] + pos; }
        else slot = off[NE] + (t - r0);
        if (F.lane == 0) slot_of[(size_t)t * 9 + k] = slot;
        const u32x4* s = (const u32x4*)(hb + (size_t)t * DM) + F.lane; u32x4* d = (u32x4*)(hp + (size_t)slot * DM) + F.lane;
#pragma unroll
        for (int j = 0; j < 4; ++j) d[64 * j] = s[64 * j];
    }
}

__device__ __forceinline__ void ph_comb(const Args& A, const Frame& F, int layer) {
    unsigned char* ws = A.ws; asm volatile("" : "+s"(ws));
    const float* mods = (const float*)(ws + WS_MODS) + (size_t)layer * 5 * MODW;
    const bf16* ys = (const bf16*)(ws + WS_B + WB_HPERM);
    const int* slot_of = (const int*)(ws + WS_SLOT);
    const float* wts = (const float*)(ws + WS_WTS);
    float* xc = (float*)(ws + WS_X);
    const float* nw = inp(I_NFPOST) + (size_t)layer * DM;
    const bool last = (layer == NLAYER - 1);
    for (int t = row_lo(layer) + F.gw; t < TT; t += F.NGW) {
        float f[32];
#pragma unroll
        for (int j = 0; j < 32; ++j) f[j] = 0.f;
#pragma unroll
        for (int k = 0; k < 9; ++k) {
            const int slot = slot_of[(size_t)t * 9 + k]; const float w = (k < 8) ? wts[(size_t)t * 8 + k] : 1.f;
            const u32x4* yr = (const u32x4*)(ys + (size_t)slot * DM + 32 * F.lane);
#pragma unroll
            for (int q = 0; q < 4; ++q) { const u32x4 y = yr[q];
                f[8 * q + 0] += w * bflo(y.x); f[8 * q + 1] += w * bfhi(y.x); f[8 * q + 2] += w * bflo(y.y); f[8 * q + 3] += w * bfhi(y.y);
                f[8 * q + 4] += w * bflo(y.z); f[8 * q + 5] += w * bfhi(y.z); f[8 * q + 6] += w * bflo(y.w); f[8 * q + 7] += w * bfhi(y.w); }
            if (k % 3 == 2) asm volatile("" ::: "memory");
        }
        float ss = 0.f;
#pragma unroll
        for (int j = 0; j < 32; ++j) ss += f[j] * f[j];
        const float r = rsqrtf(wave_sum(ss) * (1.f / DM) + EPS);
        const float* mrow = mods + (size_t)mods_row(t) * MODW + 5 * DM;
        const int c0 = 32 * F.lane;
        float* xr = xc + (size_t)t * DM + c0;
#pragma unroll
        for (int q = 0; q < 8; ++q) { const f32x4 w = *(const f32x4*)(nw + c0 + 4 * q), gt = *(const f32x4*)(mrow + c0 + 4 * q), xo = *(const f32x4*)(xr + 4 * q);
            f32x4 y; y.x = xo.x + gt.x * (f[4 * q] * r * w.x); y.y = xo.y + gt.y * (f[4 * q + 1] * r * w.y); y.z = xo.z + gt.z * (f[4 * q + 2] * r * w.z); y.w = xo.w + gt.w * (f[4 * q + 3] * r * w.w);
            if (!last) *(f32x4*)(xr + 4 * q) = y;
            else if (t >= TC) *(f32x4*)(A.out + (size_t)(t - TC) * DM + c0 + 4 * q) = y; }
    }
}

constexpr int NPH = 15;
__device__ __forceinline__ bool ph_in(int lo, int hi, int k) { asm volatile("" : "+s"(lo), "+s"(hi)); return lo <= k && k < hi; }
constexpr int PER_PHASE_LAUNCH = MK_PER_PHASE;
#ifndef DBG_STOP
#define DBG_STOP 0
#endif

#ifndef PHMASK
#define PHMASK 0xFFFF
#endif
#define IN(k) (((PHMASK >> ((k) % NPH)) & 1) && ph_in(lo, hi, (k)))
#define GETWS const Frame F = make_frame(lds, wave_s); unsigned char* ws = args.ws; asm volatile("" : "+s"(ws)); bf16* Wb = (bf16*)(ws + WS_W)
#ifndef DBG_T
#define DBG_T (-1)
#endif
#ifndef DBG_DUP
#define DBG_DUP 0
#endif
#define REPS(k) ((((DBG_DUP) >> ((k) % NPH)) & 1) ? 2 : 1)
#define REPBAR(rep) do { if (rep) xcd_barrier(bar, wave_s); } while (0)
#define STAMP(k) do { if (DBG_T >= 0 && blockIdx.x == 0 && wave_s == 0 && lane_id() == 0) ((unsigned long long*)((unsigned*)(args.ws + WS_CTL) + CW_TS))[(k)] = __builtin_amdgcn_s_memrealtime(); } while (0)
#define SEAM(k) do { if (IN(k) && IN((k) + 1)) { xcd_barrier(bar, wave_s); STAMP((k) + 1); } } while (0)
template <int LAYER>
__device__ __forceinline__ void layer_body(const Args& args, LAS unsigned char* lds, const XcdBarrier& bar, int wave_s, int lo, int hi) {
    constexpr int layer = LAYER;
        const int pb = layer * NPH;
        for (int rep_ = 0; rep_ < REPS(pb + 0); ++rep_) if (IN(pb + 0)) { REPBAR(rep_); const Frame F = make_frame(lds, wave_s); ph_pre(args, F, layer); } SEAM(pb + 0);
        for (int rep_ = 0; rep_ < REPS(pb + 1); ++rep_) if (IN(pb + 1)) { REPBAR(rep_); const Frame F = make_frame(lds, wave_s); ph_n1(args, F, layer); } SEAM(pb + 1);
        for (int rep_ = 0; rep_ < REPS(pb + 2); ++rep_) if (IN(pb + 2)) { REPBAR(rep_);
            GETWS;
            pg8::Gemm g{(const pg8::bf16_t*)(ws + WS_AB), Wb + WO_IN / 2, TT, NPAD, DM}; pg8::StaticOrder S; S.init(TT, NPAD, F.G, F.bx);
            EpiInProj E{(bf16*)(ws + WS_B + WB_P), (bf16*)(ws + WS_B + WB_S5 + S5_UG)};
            pg8::gemm_phase<EpiInProj, pg8::StaticOrder>(F.lds, g, S, E, nullptr, F.tid);
        } SEAM(pb + 2);
        for (int rep_ = 0; rep_ < REPS(pb + 3); ++rep_) if (IN(pb + 3)) { REPBAR(rep_); const Frame F = make_frame(lds, wave_s); ph_prep(args, F, layer); } SEAM(pb + 3);
        for (int rep_ = 0; rep_ < REPS(pb + 4); ++rep_) if (IN(pb + 4)) { REPBAR(rep_); const Frame F = make_frame(lds, wave_s); ph_scan(args, F, layer); } SEAM(pb + 4);
        for (int rep_ = 0; rep_ < REPS(pb + 5); ++rep_) if (IN(pb + 5)) { REPBAR(rep_); const Frame F = make_frame(lds, wave_s); ph_dn_b(args, F, layer); } SEAM(pb + 5);
        for (int rep_ = 0; rep_ < REPS(pb + 6); ++rep_) if (IN(pb + 6)) { REPBAR(rep_); const Frame F = make_frame(lds, wave_s); ph_post(args, F, layer); } SEAM(pb + 6);
        for (int rep_ = 0; rep_ < REPS(pb + 7); ++rep_) if (IN(pb + 7)) { REPBAR(rep_);
            GETWS;
            constexpr size_t R0 = (size_t)(LAYER == NLAYER - 1 ? TC : 0); constexpr int MR = TT - (int)R0;
            pg8::Gemm g{(const pg8::bf16_t*)(ws + WS_B + WB_G) + R0 * 1024, Wb + WO_GLU / 2, MR, 1024, 1024}; pg8::StaticOrder S; S.init(MR, 1024, F.G, F.bx);
            EpiGlu E{(const bf16*)(ws + WS_B + WB_G) + R0 * 1024, (bf16*)(ws + WS_B + WB_S5O) + R0 * 1024};
            pg8::gemm_phase<EpiGlu, pg8::StaticOrder>(F.lds, g, S, E, nullptr, F.tid);
        } SEAM(pb + 7);
        for (int rep_ = 0; rep_ < REPS(pb + 8); ++rep_) if (IN(pb + 8)) { REPBAR(rep_); GETWS;
            constexpr size_t R0 = (size_t)(LAYER == NLAYER - 1 ? TC : 0); constexpr int MR = TT - (int)R0;
            { pg8::Gemm g{(const pg8::bf16_t*)(ws + WS_B + WB_S5O) + R0 * 1024, Wb + WO_BRS / 2, MR, DM, 1024}; pg8::StaticOrder S; S.init(MR, DM, F.G, F.bx);
              EpiBr<false> E{(const bf16*)(ws + WS_B + WB_P) + R0 * NPAD, PC_GS5, (float*)(ws + WS_B + WB_M1) + R0 * DM, nullptr};
              pg8::gemm_phase<EpiBr<false>, pg8::StaticOrder>(F.lds, g, S, E, nullptr, F.tid); }
            __syncthreads();
            { pg8::Gemm g{(const pg8::bf16_t*)(ws + WS_B + WB_DNO) + R0 * 1024, Wb + WO_BRD / 2, MR, DM, 1024}; pg8::StaticOrder S; S.init(MR, DM, F.G, F.bx);
              EpiBr<true> E{(const bf16*)(ws + WS_B + WB_P) + R0 * NPAD, PC_GDN, (float*)(ws + WS_B + WB_M1) + R0 * DM, (bf16*)(ws + WS_B + WB_M) + R0 * DM};
              pg8::gemm_phase<EpiBr<true>, pg8::StaticOrder>(F.lds, g, S, E, nullptr, F.tid); }
        } SEAM(pb + 8);
        for (int rep_ = 0; rep_ < REPS(pb + 9); ++rep_) if (IN(pb + 9)) { REPBAR(rep_);
            GETWS;
            constexpr size_t R0 = (size_t)(LAYER == NLAYER - 1 ? TC : 0); constexpr int MR = TT - (int)R0;
            pg8::Gemm g{(const pg8::bf16_t*)(ws + WS_B + WB_M) + R0 * DM, Wb + WO_OUT / 2, MR, DM, DM}; pg8::StaticOrder S; S.init(MR, DM, F.G, F.bx);
            pg8::EpiF32 E{(float*)(ws + WS_B + WB_MIX) + R0 * DM, DM, nullptr};
            pg8::gemm_phase<pg8::EpiF32, pg8::StaticOrder>(F.lds, g, S, E, nullptr, F.tid);
        } SEAM(pb + 9);
        for (int rep_ = 0; rep_ < REPS(pb + 10); ++rep_) if (IN(pb + 10)) { REPBAR(rep_); const Frame F = make_frame(lds, wave_s); ph_row2(args, F, layer); } SEAM(pb + 10);
        for (int rep_ = 0; rep_ < REPS(pb + 11); ++rep_) if (IN(pb + 11)) { REPBAR(rep_); const Frame F = make_frame(lds, wave_s); ph_fill(args, F, layer); } SEAM(pb + 11);
        for (int rep_ = 0; rep_ < REPS(pb + 12); ++rep_) if (IN(pb + 12)) { REPBAR(rep_);
            GETWS;
            const int* misc = (const int*)(ws + WS_MISC) + layer * 1024;
            const int ntiles = __builtin_amdgcn_readfirstlane((int)__hip_atomic_load(misc + 512, __ATOMIC_RELAXED, __HIP_MEMORY_SCOPE_AGENT));
            pg8::Gemm g{(const pg8::bf16_t*)(ws + WS_B + WB_HPERM), Wb + WO_GU / 2, ntiles * 256, 1024, DM}; MoeOrder S{ntiles, 4, F.G, F.bx, misc};
            EpiSwiglu E{(bf16*)(ws + WS_B + WB_ACT)};
            pg8::gemm_phase<EpiSwiglu, MoeOrder>(F.lds, g, S, E, nullptr, F.tid);
        } SEAM(pb + 12);
        for (int rep_ = 0; rep_ < REPS(pb + 13); ++rep_) if (IN(pb + 13)) { REPBAR(rep_);
            GETWS;
            const int* misc = (const int*)(ws + WS_MISC) + layer * 1024;
            const int ntiles = __builtin_amdgcn_readfirstlane((int)__hip_atomic_load(misc + 512, __ATOMIC_RELAXED, __HIP_MEMORY_SCOPE_AGENT));
            pg8::Gemm g{(const pg8::bf16_t*)(ws + WS_B + WB_ACT), Wb + WO_DN / 2, ntiles * 256, DM, EDIM}; MoeOrder S{ntiles, 8, F.G, F.bx, misc};
            EpiBf16Mod E{(bf16*)(ws + WS_B + WB_HPERM), DM, 8};
            pg8::gemm_phase<EpiBf16Mod, MoeOrder>(F.lds, g, S, E, nullptr, F.tid);
        } SEAM(pb + 13);
        for (int rep_ = 0; rep_ < REPS(pb + 14); ++rep_) if (IN(pb + 14)) { REPBAR(rep_); const Frame F = make_frame(lds, wave_s); ph_comb(args, F, layer); } SEAM(pb + 14);
    }

__global__ void __launch_bounds__(512, 2) hybrid_fwd(Args args) {
    extern __shared__ __attribute__((aligned(16))) unsigned char lds_raw[];
    LAS unsigned char* const lds = (LAS unsigned char*)lds_raw;
    volatile LAS unsigned* MISC = (volatile LAS unsigned*)(lds + LDS_MISC);
    const int wave_s = __builtin_amdgcn_readfirstlane((int)(threadIdx.x >> 6));
    if (threadIdx.x < 4) MISC[threadIdx.x] = 0u;
    __syncthreads();
    unsigned* ctl = (unsigned*)(args.ws + WS_CTL);
    XcdBarrier bar; bar.bar = ctl + CW_BAR; bar.x = 0; bar.st = nullptr;
    if (!PER_PHASE_LAUNCH) { bar.bar = ctl + CW_BAR; bar.x = xb_xcc_id(); bar.st = MISC; if (threadIdx.x == 0) (void)xb_add(&bar.bar[XB_XCNT(bar.x)], 1u); }
    const int lo = args.ph_lo, hi = args.ph_hi;
    STAMP(0);
    layer_body<0>(args, lds, bar, wave_s, lo, hi);
    layer_body<1>(args, lds, bar, wave_s, lo, hi);
    if (DBG_T >= 0) {
        xcd_barrier(bar, wave_s); STAMP(NLAYER * NPH);
        if (blockIdx.x == 0 && threadIdx.x == 0) { const unsigned long long* ts = (const unsigned long long*)((unsigned*)(args.ws + WS_CTL) + CW_TS);
            const float us = (float)(ts[DBG_T2 + 1] - ts[DBG_T]) * 0.01f; args.out[0] += 20.f * us; }
    }
    if (DBG_STOP && lo == 1000) {
        const float* xc = (const float*)(args.ws + WS_X) + (size_t)TC * DM;
        for (size_t i = (size_t)blockIdx.x * 512 + threadIdx.x; i < (size_t)TL * DM / 4; i += (size_t)gridDim.x * 512) ((f32x4*)args.out)[i] = ((const f32x4*)xc)[i];
    }
#undef IN
#undef SEAM
}

extern "C" void kernel_launch(void* const* d_in, const int* in_sizes, int n_in, void* d_out, int out_size, void* d_ws, size_t ws_size, hipStream_t stream) {
    static int grid = 0;
    if (grid == 0) {
        if (n_in != 35 || out_size != TL * DM || ws_size < WS_END) { fprintf(stderr, "kernel_launch: unexpected shapes (n_in %d out %d ws %zu need %zu)\n", n_in, out_size, ws_size, (size_t)WS_END); grid = -1; return; }
        int dev = 0, cus = 0;
        if (hipGetDevice(&dev) != hipSuccess || hipDeviceGetAttribute(&cus, hipDeviceAttributeMultiprocessorCount, dev) != hipSuccess) { grid = -1; return; }
        if (hipFuncSetAttribute((const void*)hybrid_fwd, hipFuncAttributeMaxDynamicSharedMemorySize, LDS_BYTES) != hipSuccess) { grid = -1; return; }
        int per_cu = 0;
        (void)hipOccupancyMaxActiveBlocksPerMultiprocessor(&per_cu, (const void*)hybrid_fwd, 512, LDS_BYTES);
        (void)hipGetLastError();
        if (per_cu < 1) { fprintf(stderr, "kernel_launch: occupancy query says %d blocks per CU\n", per_cu); }
        grid = cus;
    }
    if (grid < 0) return;
    (void)hipMemsetAsync((char*)d_ws + WS_CTL, 0, CTL_ZERO_BYTES, stream);
    Args a{};
    for (int i = 0; i < 35; ++i) a.in[i] = (const float*)d_in[i];
    a.out = (float*)d_out; a.ws = (unsigned char*)d_ws;
    if (PER_PHASE_LAUNCH) {
        for (int ph = 0; ph < (DBG_STOP ? DBG_STOP : NLAYER * NPH); ++ph) { a.ph_lo = ph; a.ph_hi = ph + 1; hipLaunchKernelGGL(hybrid_fwd, dim3(grid), dim3(512), LDS_BYTES, stream, a); }
        if (DBG_STOP) { a.ph_lo = 1000; a.ph_hi = 1001; hipLaunchKernelGGL(hybrid_fwd, dim3(grid), dim3(512), LDS_BYTES, stream, a); }
    } else {
        a.ph_lo = 0; a.ph_hi = NLAYER * NPH;
        hipLaunchKernelGGL(hybrid_fwd, dim3(grid), dim3(512), LDS_BYTES, stream, a);
    }
}
```

```cpp
#include <hip/hip_runtime.h>
#include <cstdio>
#include <cstdint>
#ifndef MK_PER_PHASE
#define MK_PER_PHASE 0
#endif
#define DBG_STOP 0
#define DBG_T2 0
namespace pg8 {
#define PG8_LAS __attribute__((address_space(3)))
typedef unsigned short bf16_t;
typedef short bf16x8 __attribute__((ext_vector_type(8)));
typedef float f32x4 __attribute__((ext_vector_type(4)));
typedef unsigned u32x4 __attribute__((ext_vector_type(4)));
constexpr int BM = 256, BK = 64, HALF = 128, HTB = HALF * BK * 2  , STAGE_BYTES = 8 * HTB, NXCD = 8, WGM = 8;

__host__ __device__ __forceinline__ int lds_byte(int r, int c) { const int st = (r >> 4) * 2 + (c >> 5), rr = r & 15, cc = c & 31, ob = rr * 64 + cc * 2; return st * 1024 + (ob ^ (((ob >> 9) & 1) << 5)); }
__host__ __device__ __forceinline__ void stage_rc(int b, int& R, int& C) { const int st = b / 1024, sb = b % 1024, swz = sb ^ (((sb >> 9) & 1) << 5); R = (st >> 1) * 16 + swz / 64; C = (st & 1) * 32 + (swz % 64) / 2; }
__host__ __device__ __forceinline__ int perm32(int rho) { const int n = rho >> 4, i = rho & 15; return 8 * (i >> 2) + 4 * n + (i & 3); }

struct Unit { int pm, pn; };
struct Gemm { const bf16_t* A; const bf16_t* Bt; int M, N, K; };

struct StaticOrder {
    int nM, nN, nwg, G, c;
    __host__ __device__ void init(int M, int N, int G_, int c_) { nM = M / BM; nN = N / BM; nwg = nM * nN; G = G_; c = c_; }
    __host__ __device__ bool next(int i, Unit& u) const {
        const long L = (long)i * G + c; if (L >= nwg) return false;
        int wgid = (int)L; { const int q = nwg / NXCD, r = nwg % NXCD, xcd = wgid % NXCD, off = wgid / NXCD; wgid = (xcd < r ? xcd * (q + 1) : r * (q + 1) + (xcd - r) * q) + off; }
        const int nig = WGM * nN, gid = wgid / nig, fm = gid * WGM, gsz = (nM - fm) < WGM ? (nM - fm) : WGM;
        u.pm = fm + ((wgid % nig) % gsz); u.pn = (wgid % nig) / gsz; return true;
    }
    __device__ __forceinline__ void a_ready(const Unit&) const {}
    __device__ __forceinline__ void done(const Unit&) const {}
};
struct CountedOrder : StaticOrder {
    const unsigned* ready; unsigned need; unsigned* tmo;
    __device__ __forceinline__ void a_ready(const Unit& u) const {
        if (threadIdx.x < 64) {
            const unsigned long long t0 = __builtin_amdgcn_s_memrealtime(); unsigned polls = 0;
            while ((unsigned)__builtin_amdgcn_readfirstlane(__hip_atomic_load(ready + 64 * u.pm, __ATOMIC_RELAXED, __HIP_MEMORY_SCOPE_AGENT)) < need) {
                if ((++polls & 255u) == 0u && __builtin_amdgcn_readfirstlane(__hip_atomic_load(tmo, __ATOMIC_RELAXED, __HIP_MEMORY_SCOPE_AGENT)) != 0u) break;
                if (__builtin_amdgcn_s_memrealtime() - t0 > 2000000ull) {
                    if (threadIdx.x == 0) { unsigned expect = 0u; __hip_atomic_compare_exchange_strong(tmo + 1, &expect, 0x600u | (unsigned)(u.pm & 0xff), __ATOMIC_RELAXED, __ATOMIC_RELAXED, __HIP_MEMORY_SCOPE_AGENT); __hip_atomic_store(tmo, 1u, __ATOMIC_RELAXED, __HIP_MEMORY_SCOPE_AGENT); }
                    break; }
                __builtin_amdgcn_s_sleep(2); }
            __builtin_amdgcn_fence(__ATOMIC_ACQUIRE, "agent");
            asm volatile("s_waitcnt vmcnt(0)" ::: "memory");
        }
#if !defined(BROKEN_HOOK_NO_BARRIER)
        asm volatile("" ::: "memory"); __builtin_amdgcn_s_barrier(); asm volatile("" ::: "memory");
#endif
    }
};

__device__ __forceinline__ unsigned cvt_pk_bf16(float lo, float hi) { unsigned r; asm volatile("v_cvt_pk_bf16_f32 %0, %1, %2" : "=v"(r) : "v"(lo), "v"(hi)); return r; }
typedef float f32x2 __attribute__((ext_vector_type(2)));
__device__ __forceinline__ f32x2 gelu_pk(f32x2 v) {
    const f32x2 av = __builtin_elementwise_abs(v), d = av * 0.2316418882f + 1.0f;
    f32x2 t; t.x = __builtin_amdgcn_rcpf(d.x); t.y = __builtin_amdgcn_rcpf(d.y);
    f32x2 q = t * 0.5307027145f + (-0.7265760135f); q = q * t + 0.7107068705f; q = q * t + (-0.142248368f); q = q * t + 0.127414796f; q = q * t;
    const f32x2 s = (v * v) * (-0.72134752044f);
    f32x2 e; e.x = __builtin_amdgcn_exp2f(s.x); e.y = __builtin_amdgcn_exp2f(s.y);
    const f32x2 m = v * (q * e), r = v - m;
    f32x2 o; o.x = v.x < 0.f ? m.x : r.x; o.y = v.y < 0.f ? m.y : r.y; return o;
}

struct EpiF32 {
    static constexpr bool PERM = false, AFTER_DRAIN = false;
    float* C; int ldc; const float* bias;
    __device__ __forceinline__ void operator()(const f32x4 (&acc)[2][2][4][2], const Unit& u, int wr, int wc, int fr, int fq) const {
        const int row0 = u.pm * BM + wr * 64 + fr, col0 = u.pn * BM + wc * 32 + 4 * fq;
        f32x4 bv[2][2];
#pragma unroll
        for (int bj = 0; bj < 2; ++bj)
#pragma unroll
            for (int n = 0; n < 2; ++n) bv[bj][n] = bias ? *(const f32x4*)(bias + col0 + bj * HALF + n * 16) : (f32x4){0.f, 0.f, 0.f, 0.f};
#pragma unroll
        for (int ai = 0; ai < 2; ++ai)
#pragma unroll
            for (int m = 0; m < 4; ++m) { float* rowp = C + (size_t)(row0 + ai * HALF + m * 16) * ldc + col0;
#pragma unroll
                for (int bj = 0; bj < 2; ++bj)
#pragma unroll
                    for (int n = 0; n < 2; ++n) *(f32x4*)(rowp + bj * HALF + n * 16) = acc[ai][bj][m][n] + bv[bj][n]; }
    }
};
template <int ACT  > struct EpiBf16 {
    static constexpr bool PERM = true, AFTER_DRAIN = false;
    bf16_t* O; int ldc; const float* bias; int split_cols; size_t split_stride;
    __device__ __forceinline__ void operator()(const f32x4 (&acc)[2][2][4][2], const Unit& u, int wr, int wc, int fr, int fq) const {
        const int row0 = u.pm * BM + wr * 64 + fr; int colt = u.pn * BM; bf16_t* base = O;
        if (split_cols) { const int t = colt / split_cols; base += (size_t)t * split_stride; colt -= t * split_cols; }
        const int col0 = colt + wc * 32 + 8 * fq, bcol0 = u.pn * BM + wc * 32 + 8 * fq;
        f32x4 bv[2][2];
#pragma unroll
        for (int bj = 0; bj < 2; ++bj)
#pragma unroll
            for (int n = 0; n < 2; ++n) bv[bj][n] = bias ? *(const f32x4*)(bias + bcol0 + bj * HALF + 4 * n) : (f32x4){0.f, 0.f, 0.f, 0.f};
#pragma unroll
        for (int ai = 0; ai < 2; ++ai)
#pragma unroll
            for (int m = 0; m < 4; ++m) { bf16_t* rowp = base + (size_t)(row0 + ai * HALF + m * 16) * ldc + col0;
#pragma unroll
                for (int bj = 0; bj < 2; ++bj) { f32x4 v0 = acc[ai][bj][m][0] + bv[bj][0], v1 = acc[ai][bj][m][1] + bv[bj][1];
                    if (ACT == 1) { f32x2 a = gelu_pk((f32x2){v0[0], v0[1]}), b = gelu_pk((f32x2){v0[2], v0[3]}), c = gelu_pk((f32x2){v1[0], v1[1]}), d = gelu_pk((f32x2){v1[2], v1[3]});
                        v0 = (f32x4){a.x, a.y, b.x, b.y}; v1 = (f32x4){c.x, c.y, d.x, d.y}; }
                    if (ACT == 2) {
#pragma unroll
                        for (int j = 0; j < 4; ++j) { v0[j] = 0.5f * v0[j] * (1.0f + erff(v0[j] * 0.70710678f)); v1[j] = 0.5f * v1[j] * (1.0f + erff(v1[j] * 0.70710678f)); } }
                    u32x4 w; w.x = cvt_pk_bf16(v0[0], v0[1]); w.y = cvt_pk_bf16(v0[2], v0[3]); w.z = cvt_pk_bf16(v1[0], v1[1]); w.w = cvt_pk_bf16(v1[2], v1[3]);
                    *(u32x4*)(rowp + bj * HALF) = w; } }
    }
};

struct PanelStats {
    unsigned* xbuf;
    unsigned* cnt;
    unsigned* tmo;
    int ntn; float eps;
    unsigned code;
    __device__ __forceinline__ bool run(const f32x4 (&v)[2][2][4][2], const Unit& u, int wr, int wc, int fr, int fq, PG8_LAS unsigned char* lds, int wid, int lane) const {
        typedef float f32x2v __attribute__((ext_vector_type(2)));
        PG8_LAS f32x2v* P = (PG8_LAS f32x2v*)lds;
        PG8_LAS f32x2v* S = (PG8_LAS f32x2v*)(lds + 8192);
        PG8_LAS unsigned* flag = (PG8_LAS unsigned*)(lds + 8192 + 2048);
#pragma unroll
        for (int ai = 0; ai < 2; ++ai)
#pragma unroll
            for (int m = 0; m < 4; ++m) {
                float s = 0.f;
#pragma unroll
                for (int bj = 0; bj < 2; ++bj)
#pragma unroll
                    for (int n = 0; n < 2; ++n) { const f32x4 x = v[ai][bj][m][n]; s += (x[0] + x[1]) + (x[2] + x[3]); }
                s += __shfl_xor(s, 16); s += __shfl_xor(s, 32);
                const float mw = s * (1.0f / 64.0f); float q = 0.f;
#pragma unroll
                for (int bj = 0; bj < 2; ++bj)
#pragma unroll
                    for (int n = 0; n < 2; ++n) { const f32x4 d = v[ai][bj][m][n] - mw; q += (d[0] * d[0] + d[1] * d[1]) + (d[2] * d[2] + d[3] * d[3]); }
                q += __shfl_xor(q, 16); q += __shfl_xor(q, 32);
                if (fq == 0) P[(ai * HALF + wr * 64 + m * 16 + fr) * 4 + wc] = (f32x2v){mw, q};
            }
        asm volatile("s_waitcnt lgkmcnt(0)" ::: "memory"); __builtin_amdgcn_s_barrier(); asm volatile("" ::: "memory");
#if defined(BROKEN_NO_WAIT)
        if (blockIdx.x >= 64) { const long long t0 = clock64(); while (clock64() - t0 < 60000) __builtin_amdgcn_s_sleep(8); }
#endif
        const int row = wid * 32 + (lane & 31);
        if (lane < 32) {
            const f32x2v a = P[row * 4 + 0], b = P[row * 4 + 1], c = P[row * 4 + 2], d = P[row * 4 + 3];
            const float mt = (a.x + b.x + c.x + d.x) * 0.25f;
            const float da = a.x - mt, db = b.x - mt, dc = c.x - mt, dd = d.x - mt;
            const float m2 = (a.y + b.y) + (c.y + d.y) + 64.0f * ((da * da + db * db) + (dc * dc + dd * dd));
            unsigned long long* slot = (unsigned long long*)xbuf + ((size_t)(u.pm * BM + row) * 4 + u.pn);
            __hip_atomic_store(slot, ((unsigned long long)__float_as_uint(m2) << 32) | __float_as_uint(mt), __ATOMIC_RELAXED, __HIP_MEMORY_SCOPE_AGENT);
        }
        asm volatile("s_waitcnt vmcnt(0)" ::: "memory");
        if (lane == 0) __hip_atomic_fetch_add(cnt + 64 * u.pm, 1u, __ATOMIC_RELAXED, __HIP_MEMORY_SCOPE_AGENT);
        if (wid == 0) {
            bool dead = false; const unsigned long long t0 = __builtin_amdgcn_s_memrealtime(); const unsigned want = 8u * (unsigned)ntn;
            for (;;) {
#if defined(BROKEN_NO_WAIT)
                break;
#endif
                if ((unsigned)__builtin_amdgcn_readfirstlane(__hip_atomic_load(cnt + 64 * u.pm, __ATOMIC_RELAXED, __HIP_MEMORY_SCOPE_AGENT)) >= want) break;
                if (__builtin_amdgcn_s_memrealtime() - t0 > 2000000ull) {
                    if (lane == 0) { unsigned expect = 0u; __hip_atomic_compare_exchange_strong(tmo + 1, &expect, code | (unsigned)(u.pm & 0xff), __ATOMIC_RELAXED, __ATOMIC_RELAXED, __HIP_MEMORY_SCOPE_AGENT);
                                     __hip_atomic_store(tmo, 1u, __ATOMIC_RELAXED, __HIP_MEMORY_SCOPE_AGENT); }
                    dead = true; break; }
                __builtin_amdgcn_s_sleep(2);
            }
            __builtin_amdgcn_fence(__ATOMIC_ACQUIRE, "agent");
            if (lane == 0) flag[0] = dead ? 1u : 0u;
        }
        asm volatile("s_waitcnt vmcnt(0) lgkmcnt(0)" ::: "memory"); __builtin_amdgcn_s_barrier(); asm volatile("" ::: "memory");
        const bool bad = flag[0] != 0u;
        if (lane < 32) {
            const unsigned long long* slot = (const unsigned long long*)xbuf + (size_t)(u.pm * BM + row) * 4; float mt[4], m2[4]; float ms = 0.f;
#pragma unroll
            for (int t = 0; t < 4; ++t) { if (t < ntn) { const unsigned long long w = __hip_atomic_load(slot + t, __ATOMIC_RELAXED, __HIP_MEMORY_SCOPE_AGENT); mt[t] = __uint_as_float((unsigned)w); m2[t] = __uint_as_float((unsigned)(w >> 32)); } else { mt[t] = 0.f; m2[t] = 0.f; } ms += mt[t]; }
            const float mean = ms / (float)ntn; float q = 0.f;
#pragma unroll
            for (int t = 0; t < 4; ++t) if (t < ntn) { const float dm = mt[t] - mean; q += m2[t] + 256.0f * dm * dm; }
            S[row] = (f32x2v){mean, 1.0f / sqrtf(q / (256.0f * (float)ntn) + eps)};
        }
        asm volatile("s_waitcnt lgkmcnt(0)" ::: "memory"); __builtin_amdgcn_s_barrier(); asm volatile("" ::: "memory");
        return bad;
    }
};
struct EpiLnRes {
    static constexpr bool PERM = false, AFTER_DRAIN = true;
    const float* base; float* out; int ldc; const float* bias; PanelStats st; unsigned poison;
    __device__ __forceinline__ void refuse(size_t i0, size_t stride, int M, int N) const { const float q = __builtin_nanf(""); for (size_t i = i0; i < (size_t)M * N; i += stride) out[(i / N) * ldc + i % N] = q;
        if (i0 == 0) { unsigned expect = 0u; __hip_atomic_compare_exchange_strong(st.tmo + 1, &expect, 0x7f0u, __ATOMIC_RELAXED, __ATOMIC_RELAXED, __HIP_MEMORY_SCOPE_AGENT); __hip_atomic_store(st.tmo, 1u, __ATOMIC_RELAXED, __HIP_MEMORY_SCOPE_AGENT); } }
    __device__ __forceinline__ void fused(f32x4 (&acc)[2][2][4][2], const Unit& u, int wr, int wc, int fr, int fq, PG8_LAS unsigned char* lds, int wid, int lane) const {
        typedef float f32x2v __attribute__((ext_vector_type(2)));
        const PG8_LAS f32x2v* S = (const PG8_LAS f32x2v*)(lds + 8192);
        const int col0 = u.pn * BM + wc * 32 + 4 * fq;
#pragma unroll
        for (int bj = 0; bj < 2; ++bj)
#pragma unroll
            for (int n = 0; n < 2; ++n) { const f32x4 bv = bias ? *(const f32x4*)(bias + col0 + bj * HALF + n * 16) : (f32x4){0.f, 0.f, 0.f, 0.f};
#pragma unroll
                for (int ai = 0; ai < 2; ++ai)
#pragma unroll
                    for (int m = 0; m < 4; ++m) acc[ai][bj][m][n] += bv; }
        const bool bad = st.run(acc, u, wr, wc, fr, fq, lds, wid, lane) || poison != 0u;
        const float qnan = __builtin_nanf("");
#pragma unroll
        for (int ai = 0; ai < 2; ++ai)
#pragma unroll
            for (int m = 0; m < 4; ++m) { const int r = ai * HALF + wr * 64 + m * 16 + fr; const f32x2v sr = S[r]; const size_t off = (size_t)(u.pm * BM + r) * ldc + col0;
#pragma unroll
                for (int bj = 0; bj < 2; ++bj)
#pragma unroll
                    for (int n = 0; n < 2; ++n) { const f32x4 bs = *(const f32x4*)(base + off + bj * HALF + n * 16); f32x4 o = bs + (acc[ai][bj][m][n] - sr.x) * sr.y;
                        if (bad) o = (f32x4){qnan, qnan, qnan, qnan}; *(f32x4*)(out + off + bj * HALF + n * 16) = o; }
                asm volatile("" ::: "memory"); }
    }
};
struct EpiLnResLn {
    static constexpr bool PERM = false, AFTER_DRAIN = true;
    const float* base; float* out; bf16_t* xn; int ldc; const float* bias; PanelStats st1, st2; unsigned poison;
    __device__ __forceinline__ void refuse(size_t i0, size_t stride, int M, int N) const { const float q = __builtin_nanf(""); for (size_t i = i0; i < (size_t)M * N; i += stride) { const size_t o = (i / N) * ldc + i % N; out[o] = q; xn[o] = (bf16_t)0x7fc0u; }
        if (i0 == 0) { unsigned expect = 0u; __hip_atomic_compare_exchange_strong(st1.tmo + 1, &expect, 0x7f0u, __ATOMIC_RELAXED, __ATOMIC_RELAXED, __HIP_MEMORY_SCOPE_AGENT); __hip_atomic_store(st1.tmo, 1u, __ATOMIC_RELAXED, __HIP_MEMORY_SCOPE_AGENT); } }
    __device__ __forceinline__ void fused(f32x4 (&acc)[2][2][4][2], const Unit& u, int wr, int wc, int fr, int fq, PG8_LAS unsigned char* lds, int wid, int lane) const {
        typedef float f32x2v __attribute__((ext_vector_type(2))); typedef unsigned u32x2v __attribute__((ext_vector_type(2)));
        const PG8_LAS f32x2v* S = (const PG8_LAS f32x2v*)(lds + 8192);
        const int col0 = u.pn * BM + wc * 32 + 4 * fq;
#pragma unroll
        for (int bj = 0; bj < 2; ++bj)
#pragma unroll
            for (int n = 0; n < 2; ++n) { const f32x4 bv = bias ? *(const f32x4*)(bias + col0 + bj * HALF + n * 16) : (f32x4){0.f, 0.f, 0.f, 0.f};
#pragma unroll
                for (int ai = 0; ai < 2; ++ai)
#pragma unroll
                    for (int m = 0; m < 4; ++m) acc[ai][bj][m][n] += bv; }
        bool bad = st1.run(acc, u, wr, wc, fr, fq, lds, wid, lane) || poison != 0u;
        const float qnan = __builtin_nanf("");
#pragma unroll
        for (int ai = 0; ai < 2; ++ai)
#pragma unroll
            for (int m = 0; m < 4; ++m) { const int r = ai * HALF + wr * 64 + m * 16 + fr; const f32x2v sr = S[r]; const size_t off = (size_t)(u.pm * BM + r) * ldc + col0;
#pragma unroll
                for (int bj = 0; bj < 2; ++bj)
#pragma unroll
                    for (int n = 0; n < 2; ++n) { const f32x4 bs = *(const f32x4*)(base + off + bj * HALF + n * 16); acc[ai][bj][m][n] = bs + (acc[ai][bj][m][n] - sr.x) * sr.y; }
                asm volatile("" : "+v"(acc[ai][0][m][0]), "+v"(acc[ai][0][m][1]), "+v"(acc[ai][1][m][0]), "+v"(acc[ai][1][m][1]));
                if (m & 1) asm volatile("" ::: "memory"); }
        const bool bad1 = bad;
        bad = st2.run(acc, u, wr, wc, fr, fq, lds, wid, lane) || bad;
#pragma unroll
        for (int ai = 0; ai < 2; ++ai)
#pragma unroll
            for (int m = 0; m < 4; ++m) { const int r = ai * HALF + wr * 64 + m * 16 + fr; const f32x2v sr = S[r]; const size_t off = (size_t)(u.pm * BM + r) * ldc + col0;
#pragma unroll
                for (int bj = 0; bj < 2; ++bj)
#pragma unroll
                    for (int n = 0; n < 2; ++n) { const f32x4 x1 = acc[ai][bj][m][n]; *(f32x4*)(out + off + bj * HALF + n * 16) = bad1 ? (f32x4){qnan, qnan, qnan, qnan} : x1;
                        const f32x4 o = (x1 - sr.x) * sr.y; u32x2v w; w.x = cvt_pk_bf16(o[0], o[1]); w.y = cvt_pk_bf16(o[2], o[3]);
                        if (bad) { w.x = 0x7fc07fc0u; w.y = 0x7fc07fc0u; } *(u32x2v*)(xn + off + bj * HALF + n * 16) = w; }
                asm volatile("" ::: "memory"); }
    }
};

template <class Epi, class Sched, bool STAMP = false, bool GATHER = false>
__device__ __forceinline__ void gemm_phase(PG8_LAS unsigned char* lds, const Gemm g, const Sched& S, const Epi& E, unsigned long long* stamps, int tid_in, const int* rowmap = nullptr) {
    int tid_ = tid_in; asm volatile("" : "+v"(tid_));
    const int tid = tid_, wid = __builtin_amdgcn_readfirstlane(tid >> 6), lane = tid & 63, wr = wid >> 2, wc = wid & 3, fr = lane & 15, fq = lane >> 4;
    const int K = g.K, nt = K / BK;
    int ts_lo = 0, ts_hi = 0, nts = 0; const unsigned long long rt_entry = STAMP ? (unsigned long long)wall_clock64() : 0ull;
#define PG8_STAMP() do { if (STAMP && wid == 0 && nts < 64) { const unsigned long long _c = (unsigned long long)clock64(); \
        ts_lo = (lane == nts) ? (int)(unsigned)_c : ts_lo; ts_hi = (lane == nts) ? (int)(unsigned)(_c >> 32) : ts_hi; ++nts; } } while (0)
    PG8_STAMP();
    unsigned voffA[2], voffB[2];
#pragma unroll
    for (int i = 0; i < 2; ++i) { int R, C; stage_rc(tid * 16 + i * 8192, R, C); const int Rb = Epi::PERM ? ((R & ~31) + perm32(R & 31)) : R;
        voffA[i] = (unsigned)(R * K + C) * 2u; voffB[i] = (unsigned)(Rb * K + C) * 2u; }
    int gR[2]; unsigned gC[2];
#pragma unroll
    for (int i = 0; i < 2; ++i) { int R, C; stage_rc(tid * 16 + i * 8192, R, C); gR[i] = R; gC[i] = (unsigned)C * 2u; }
    unsigned vC[2][2], vN[2][2];
#define PG8_GOFF(dst, pm_) do { _Pragma("unroll") for (int h_ = 0; h_ < 2; ++h_) _Pragma("unroll") for (int i_ = 0; i_ < 2; ++i_) \
        dst[h_][i_] = (unsigned)rowmap[(pm_) * 256 + h_ * 128 + gR[i_]] * (unsigned)(K * 2) + gC[i_]; } while (0)
    const size_t kstep = (size_t)(BK * 2);
    const size_t hstep = (size_t)HALF * K * 2;
    const size_t tstep = 2 * hstep;
    const unsigned ldsw = (unsigned)wid * 1024u;
    const int aoff = lds_byte(wr * 64 + fr, fq * 8), boff = lds_byte(wc * 32 + fr, fq * 8);
#define PG8_SA(b, h) (((b) * 2 + (h)) * HTB)
#define PG8_SB(b, h) ((4 + (b) * 2 + (h)) * HTB)
#define PG8_STAGE(bufoff, gbase, voff) do { _Pragma("unroll") for (int _i = 0; _i < 2; ++_i) \
        __builtin_amdgcn_global_load_lds((const unsigned*)((const char*)(gbase) + (voff)[_i]), (PG8_LAS unsigned*)(lds + (bufoff) + ldsw + _i * 8192), 16, 0, 0); } while (0)
#define PG8_LDA(dst, b, h) do { _Pragma("unroll") for (int m = 0; m < 4; ++m) _Pragma("unroll") for (int k = 0; k < 2; ++k) dst[m][k] = *(const PG8_LAS bf16x8*)(lds + PG8_SA(b, h) + aoff + m * 2048 + k * 1024); } while (0)
#define PG8_LDB(dst, b, h) do { _Pragma("unroll") for (int n = 0; n < 2; ++n) _Pragma("unroll") for (int k = 0; k < 2; ++k) dst[n][k] = *(const PG8_LAS bf16x8*)(lds + PG8_SB(b, h) + boff + n * 2048 + k * 1024); } while (0)
#define PG8_MMA(ai, bj, At, Bt) do { __builtin_amdgcn_s_setprio(1); _Pragma("unroll") for (int m = 0; m < 4; ++m) _Pragma("unroll") for (int n = 0; n < 2; ++n) _Pragma("unroll") for (int k = 0; k < 2; ++k) \
        acc[ai][bj][m][n] = __builtin_amdgcn_mfma_f32_16x16x32_bf16(Bt[n][k], At[m][k], acc[ai][bj][m][n], 0, 0, 0); __builtin_amdgcn_s_setprio(0); } while (0)
#define PG8_WAIT_V(n) asm volatile("s_waitcnt vmcnt(" #n ")" ::: "memory")
#define PG8_WAIT_L(n) asm volatile("s_waitcnt lgkmcnt(" #n ")" ::: "memory")
#define PG8_BAR __builtin_amdgcn_s_barrier()
#define PG8_SCHED __builtin_amdgcn_sched_barrier(0)
    Unit cur, nxt; int ui = 0;
    if (!S.next(0, cur)) return;
    f32x4 acc[2][2][4][2];
#pragma unroll
    for (int a = 0; a < 2; ++a)
#pragma unroll
        for (int b = 0; b < 2; ++b)
#pragma unroll
            for (int m = 0; m < 4; ++m)
#pragma unroll
                for (int n = 0; n < 2; ++n) acc[a][b][m][n] = (f32x4){0.f, 0.f, 0.f, 0.f};
    bf16x8 At[4][2], B0[2][2], B1[2][2];
    const char* cA = (const char*)g.A + (GATHER ? (size_t)0 : (size_t)cur.pm * tstep); const char* cB = (const char*)g.Bt + (size_t)cur.pn * tstep;
    S.a_ready(cur);
    if constexpr (GATHER) { PG8_GOFF(vC, cur.pm); }
    const size_t ahs = GATHER ? (size_t)0 : hstep;
    PG8_STAGE(PG8_SB(0, 0), cB, voffB); PG8_STAGE(PG8_SA(0, 0), cA, (GATHER ? vC[0] : voffA)); PG8_STAGE(PG8_SB(0, 1), cB + hstep, voffB); PG8_STAGE(PG8_SA(0, 1), cA + ahs, (GATHER ? vC[1] : voffA));
    if (wr == 1) PG8_BAR;
    PG8_WAIT_V(4); PG8_BAR;
    PG8_STAGE(PG8_SB(1, 0), cB + kstep, voffB); PG8_STAGE(PG8_SA(1, 0), cA + kstep, (GATHER ? vC[0] : voffA)); PG8_STAGE(PG8_SB(1, 1), cB + hstep + kstep, voffB);
    PG8_WAIT_V(6); PG8_BAR;
    PG8_STAMP();
    for (;;) {
        const bool has_next = S.next(ui + 1, nxt);
        const char* nA = (has_next && !GATHER) ? (const char*)g.A + (size_t)nxt.pm * tstep : cA; const char* nB = has_next ? (const char*)g.Bt + (size_t)nxt.pn * tstep : cB;
        if constexpr (GATHER) { if (has_next) { PG8_GOFF(vN, nxt.pm); } else { _Pragma("unroll") for (int h_ = 0; h_ < 2; ++h_) _Pragma("unroll") for (int i_ = 0; i_ < 2; ++i_) vN[h_][i_] = vC[h_][i_]; } }
        for (int t = 0; t < nt; t += 2) {
            const bool last = (t == nt - 2);
            const char* a1 = cA + (size_t)(t + 1) * kstep;
            const char* a2 = last ? nA : cA + (size_t)(t + 2) * kstep; const char* b2 = last ? nB : cB + (size_t)(t + 2) * kstep;
            const char* a3 = a2 + kstep; const char* b3 = b2 + kstep;
            unsigned v2[2][2];
            if constexpr (GATHER) { _Pragma("unroll") for (int h_ = 0; h_ < 2; ++h_) _Pragma("unroll") for (int i_ = 0; i_ < 2; ++i_) v2[h_][i_] = last ? vN[h_][i_] : vC[h_][i_]; }
            if (last && has_next) S.a_ready(nxt);
            PG8_LDB(B0, 0, 0); PG8_SCHED; PG8_LDA(At, 0, 0); PG8_STAGE(PG8_SA(1, 1), a1 + ahs, (GATHER ? vC[1] : voffA));
            PG8_WAIT_L(8); PG8_BAR; PG8_WAIT_L(0); PG8_MMA(0, 0, At, B0); PG8_BAR; PG8_SCHED;
            PG8_LDB(B1, 0, 1); PG8_STAGE(PG8_SB(0, 0), b2, voffB);
            PG8_BAR; PG8_WAIT_L(0); PG8_MMA(0, 1, At, B1); PG8_BAR;
            PG8_LDA(At, 0, 1); PG8_STAGE(PG8_SA(0, 0), a2, (GATHER ? v2[0] : voffA));
            PG8_BAR; PG8_WAIT_L(0); PG8_MMA(1, 0, At, B0); PG8_BAR; PG8_SCHED;
            PG8_STAGE(PG8_SB(0, 1), b2 + hstep, voffB);
            PG8_WAIT_V(6); PG8_BAR; PG8_MMA(1, 1, At, B1); PG8_BAR;
            PG8_LDB(B0, 1, 0); PG8_SCHED; PG8_LDA(At, 1, 0); PG8_STAGE(PG8_SA(0, 1), a2 + ahs, (GATHER ? v2[1] : voffA));
            PG8_WAIT_L(8); PG8_BAR; PG8_WAIT_L(0); PG8_MMA(0, 0, At, B0); PG8_BAR; PG8_SCHED;
            PG8_LDB(B1, 1, 1); PG8_STAGE(PG8_SB(1, 0), b3, voffB);
            PG8_BAR; PG8_WAIT_L(0); PG8_MMA(0, 1, At, B1); PG8_BAR;
            PG8_LDA(At, 1, 1); PG8_STAGE(PG8_SA(1, 0), a3, (GATHER ? v2[0] : voffA));
            PG8_BAR; PG8_WAIT_L(0); PG8_MMA(1, 0, At, B0); PG8_BAR; PG8_SCHED;
            PG8_STAGE(PG8_SB(1, 1), b3 + hstep, voffB);
            PG8_WAIT_V(6); PG8_BAR; PG8_MMA(1, 1, At, B1); PG8_BAR;
        }
        PG8_STAMP();
        if constexpr (!Epi::AFTER_DRAIN) { E(acc, cur, wr, wc, fr, fq); S.done(cur); }
        PG8_STAMP();
        if (!has_next) break;
#pragma unroll
        for (int a = 0; a < 2; ++a)
#pragma unroll
            for (int b = 0; b < 2; ++b)
#pragma unroll
                for (int m = 0; m < 4; ++m)
#pragma unroll
                    for (int n = 0; n < 2; ++n) acc[a][b][m][n] = (f32x4){0.f, 0.f, 0.f, 0.f};
        cur = nxt; cA = nA; cB = nB; ++ui;
        if constexpr (GATHER) { _Pragma("unroll") for (int h_ = 0; h_ < 2; ++h_) _Pragma("unroll") for (int i_ = 0; i_ < 2; ++i_) vC[h_][i_] = vN[h_][i_]; }
    }
    PG8_WAIT_V(0);
    if (wr == 0) PG8_BAR;
    PG8_BAR;
    if constexpr (Epi::AFTER_DRAIN) { E.fused(acc, cur, wr, wc, fr, fq, lds, wid, lane); S.done(cur); }
    PG8_STAMP();
    if (STAMP && wid == 0) { stamps[lane] = lane < nts ? (((unsigned long long)(unsigned)ts_hi << 32) | (unsigned)ts_lo) : 0ull;
        if (lane == 62) stamps[62] = rt_entry; if (lane == 63) stamps[63] = (unsigned long long)wall_clock64(); }
#undef PG8_STAMP
#undef PG8_SA
#undef PG8_SB
#undef PG8_STAGE
#undef PG8_LDA
#undef PG8_LDB
#undef PG8_MMA
#undef PG8_WAIT_V
#undef PG8_WAIT_L
#undef PG8_BAR
#undef PG8_SCHED
#undef PG8_GOFF
}
}

constexpr int DM = 2048, NBATCH = 4, SEQ = 2048, CTXL = 256;
constexpr int TC = NBATCH * CTXL;
constexpr int TL = NBATCH * SEQ;
constexpr int TT = TC + TL;
constexpr int NLAYER = 2;
constexpr int NPAD = 9472;
constexpr int PC_U = 0, PC_QKV = 1024, PC_Z = 4096, PC_GS5 = 5120, PC_GDN = 7168, PC_BA = 9216;
constexpr int NE = 64, NEX = 65, EDIM = 512;
constexpr int MAXTILES = 388, MAXSLOT = MAXTILES * 256;
constexpr float EPS = 1e-6f;
constexpr int MODW = 12288;

constexpr size_t MiB = 1u << 20;
constexpr size_t WS_CTL = 0, CTL_ZERO_BYTES = 2 * MiB;
constexpr int CW_BAR = 4096;
constexpr int CW_CNT = 16384;
constexpr int CW_FILL = 16384 + 256;
constexpr int CW_TS = 32768;
constexpr size_t WS_MODS = 1 * MiB;
constexpr size_t WS_MISC = 2 * MiB;
constexpr size_t WS_W = 4 * MiB;
constexpr size_t WO_IN = 0, WO_GLU = 37 * MiB, WO_BRS = 39 * MiB, WO_BRD = 43 * MiB, WO_OUT = 47 * MiB, WO_GU = 55 * MiB, WO_DN = (55 + 260) * MiB, W_BYTES = (55 + 260 + 130) * MiB;
constexpr size_t WS_X = WS_W + W_BYTES;
constexpr size_t WS_EIDX = WS_X + 72 * MiB;
constexpr size_t WS_WTS = WS_EIDX + 1 * MiB;
constexpr size_t WS_SLOT = WS_WTS + 1 * MiB;
constexpr size_t WS_ROWMAP = WS_SLOT + 1 * MiB;
constexpr size_t WS_AB = WS_ROWMAP + 1 * MiB;
constexpr size_t WS_B = WS_AB + 36 * MiB;
constexpr size_t WB_P = 0;
constexpr size_t WB_QKV = 167 * MiB;
constexpr size_t WB_BG = WB_QKV + 108 * MiB;
constexpr size_t WB_Y = WB_BG + 2 * MiB;
constexpr size_t WB_O = WB_Y + 72 * MiB;
constexpr size_t WB_G = WB_O + 72 * MiB;
constexpr size_t WB_DNO = WB_G + 18 * MiB;
constexpr size_t WB_S5O = WB_DNO + 18 * MiB;
constexpr size_t WB_M1 = WB_S5O + 18 * MiB;
constexpr size_t WB_M = WB_M1 + 72 * MiB;
constexpr size_t WB_MIX = WB_M + 36 * MiB;
constexpr size_t WB_DNU = WB_MIX + 72 * MiB;
constexpr int DN_UNITS = 4 * 8 * 2 * 36;
constexpr size_t DNU_W = 0, DNU_UT = (size_t)DN_UNITS * 16384, DNU_KT = 2 * DNU_UT, DNU_QK = 3 * DNU_UT, DNU_SC = DNU_QK + (size_t)DN_UNITS * 8192;
constexpr size_t WB_S5 = WB_DNU + 132 * MiB;
constexpr int S5N = 288;
constexpr size_t S5_KC = 0, S5_WST = 4 * MiB, S5_WOUT = 20 * MiB, S5_L32 = 36 * MiB, S5_UG = 37 * MiB, S5_SLOC = 55 * MiB, S5_HIN = 73 * MiB;
constexpr size_t WB_END = WB_S5 + 82 * MiB;
constexpr size_t WB_HPERM = 0;
constexpr size_t WB_ACT = 388 * MiB;
static_assert(WB_ACT + 97 * MiB <= WB_END, "moe scratch fits");
constexpr size_t WS_END = WS_B + WB_END;

constexpr int LDS_BYTES = 147456;
constexpr int LDS_MISC = LDS_BYTES - 256;

#define LAS __attribute__((address_space(3)))
typedef unsigned short bf16;
typedef float f32x4 __attribute__((ext_vector_type(4)));
typedef float f32x2 __attribute__((ext_vector_type(2)));
typedef unsigned u32x4 __attribute__((ext_vector_type(4)));
typedef unsigned u32x2 __attribute__((ext_vector_type(2)));

#define LDS_WAIT() asm volatile("s_waitcnt lgkmcnt(0)" ::: "memory")
#define VM_WAIT() asm volatile("s_waitcnt vmcnt(0)" ::: "memory")

__device__ __forceinline__ unsigned f2bf(float f) { unsigned u = __float_as_uint(f); return (u + 0x7fffu + ((u >> 16) & 1u)) >> 16; }
__device__ __forceinline__ unsigned pk2(float lo, float hi) { return f2bf(lo) | (f2bf(hi) << 16); }
__device__ __forceinline__ float bflo(unsigned w) { return __uint_as_float(w << 16); }
__device__ __forceinline__ float bfhi(unsigned w) { return __uint_as_float(w & 0xffff0000u); }
__device__ __forceinline__ float bf2f(bf16 b) { return __uint_as_float(((unsigned)b) << 16); }
__device__ __forceinline__ float sigmoidf_(float x) { return 1.f / (1.f + __expf(-x)); }
__device__ __forceinline__ float siluf_(float x) { return x / (1.f + __expf(-x)); }
__device__ __forceinline__ float gelu_tanh(float x) { const float t = tanhf(0.7978845608028654f * (x + 0.044715f * x * x * x)); return 0.5f * x * (1.f + t); }
__device__ __forceinline__ int lane_id() { int l; asm volatile("v_mbcnt_lo_u32_b32 %0, -1, 0\n\tv_mbcnt_hi_u32_b32 %0, -1, %0" : "=v"(l)); return l; }
__device__ __forceinline__ float wave_sum(float v) {
#pragma unroll
    for (int o = 1; o < 64; o <<= 1) v += __shfl_xor(v, o);
    return v;
}

#define XB_TMO      128
#define XB_XCNT(j)  (256  + 64 * (j))
#define XB_XSUB(j)  (1280 + 64 * (j))
#define XB_XGEN(j)  (2304 + 64 * (j))
#define XB_TOP      3328
#define XB_TOPGEN   3392
#define XCD_BAR_WORDS 3456
#define XB_SPIN_CAP (1u << 20)

__device__ __forceinline__ unsigned xb_ld(unsigned* p)              { return __hip_atomic_load(p, __ATOMIC_RELAXED, __HIP_MEMORY_SCOPE_AGENT); }
__device__ __forceinline__ unsigned xb_add(unsigned* p, unsigned v) { return __hip_atomic_fetch_add(p, v, __ATOMIC_RELAXED, __HIP_MEMORY_SCOPE_AGENT); }
__device__ __forceinline__ unsigned xb_xcc_id() { return (unsigned)__builtin_amdgcn_s_getreg((3 << 11) | 20) & 0xFu; }
#define XB_SPIN(cond, bar) do { unsigned _sp = 0; while (cond) { __builtin_amdgcn_s_sleep(1); \
    if ((++_sp & 255u) == 0u) { if (xb_ld(&(bar)[XB_TMO])) break; if (_sp > XB_SPIN_CAP) { atomicAdd(&(bar)[XB_TMO], 1u); break; } } } } while (0)

struct XcdBarrier { unsigned* bar; unsigned x; volatile LAS unsigned* st; };

__device__ __forceinline__ XcdBarrier xcd_barrier_post(unsigned* bar, volatile LAS unsigned* st) {
    XcdBarrier b; b.bar = bar; b.x = xb_xcc_id(); b.st = st;
    if (threadIdx.x == 0) (void)xb_add(&bar[XB_XCNT(b.x)], 1u);
    return b;
}
__device__ __forceinline__ void xcd_barrier_complete(unsigned* bar, unsigned x, unsigned& nloc, unsigned& nx) {
    const unsigned G = gridDim.x * gridDim.y * gridDim.z;
    unsigned sum, cnt, mine, sp = 0u;
    for (;;) {
        sum = 0u; cnt = 0u; mine = 0u;
#pragma unroll
        for (unsigned j = 0; j < 16; ++j) { const unsigned c = xb_ld(&bar[XB_XCNT(j)]); sum += c; cnt += (c > 0u) ? 1u : 0u; mine = (j == x) ? c : mine; }
        if (sum == G) break;
        __builtin_amdgcn_s_sleep(1);
        if ((++sp & 255u) == 0u) { if (xb_ld(&bar[XB_TMO])) break; if (sp > XB_SPIN_CAP) { atomicAdd(&bar[XB_TMO], 1u); break; } }
    }
    nloc = mine > 0u ? mine : 1u; nx = cnt > 0u ? cnt : 1u;
}
__device__ __forceinline__ void xcd_barrier(const XcdBarrier& b, int wave_s) {
    asm volatile("s_waitcnt vmcnt(0)" ::: "memory");
    __syncthreads();
    asm volatile("" : "+s"(wave_s));
    if (wave_s == 0 && lane_id() == 0) {
        unsigned* bar = b.bar; asm volatile("" : "+s"(bar));
        __builtin_amdgcn_s_waitcnt(0);
        unsigned nloc = b.st[0], nx = b.st[1];
        unsigned bx_ = b.x; asm volatile("" : "+s"(bx_));
        if (nloc == 0u) { xcd_barrier_complete(bar, bx_, nloc, nx); b.st[0] = nloc; b.st[1] = nx; }
        const unsigned old = xb_add(&bar[XB_XSUB(bx_)], 1u);
        const unsigned gen = old / nloc;
        if (old + 1u == (gen + 1u) * nloc) {
            __builtin_amdgcn_fence(__ATOMIC_RELEASE, "agent");
            asm volatile("s_waitcnt vmcnt(0)" ::: "memory");
            const unsigned og = xb_add(&bar[XB_TOP], 1u);
            const unsigned tg = og / nx;
            if (og + 1u == (tg + 1u) * nx) xb_add(&bar[XB_TOPGEN], 1u);
            else XB_SPIN(xb_ld(&bar[XB_TOPGEN]) == tg, bar);
            __builtin_amdgcn_fence(__ATOMIC_ACQUIRE, "agent");
            xb_add(&bar[XB_XGEN(bx_)], 1u);
            asm volatile("s_waitcnt vmcnt(0)" ::: "memory");
        } else {
            XB_SPIN(xb_ld(&bar[XB_XGEN(bx_)]) == gen, bar);
            __builtin_amdgcn_fence(__ATOMIC_ACQUIRE, "agent");
            asm volatile("s_waitcnt vmcnt(0)" ::: "memory");
        }
    }
    __syncthreads();
}

struct Args { const float* in[35]; float* out; unsigned char* ws; int ph_lo, ph_hi; };
struct Frame { LAS unsigned char* lds; int tid, lane, wave, G, bx, vcu, gw, NGW; };
__device__ __forceinline__ Frame make_frame(LAS unsigned char* lds, int wave_s) {
    asm volatile("" : "+s"(wave_s));
    Frame F; int tid = wave_s * 64 + lane_id(); asm volatile("" : "+v"(tid)); int bx = blockIdx.x; asm volatile("" : "+s"(bx));
    F.lds = lds; F.tid = tid; F.lane = tid & 63; F.wave = __builtin_amdgcn_readfirstlane(tid >> 6); F.G = gridDim.x; F.bx = bx;
    F.vcu = (F.G % 8 == 0) ? (bx % 8) * (F.G / 8) + bx / 8 : bx; F.gw = F.vcu * 8 + F.wave; F.NGW = F.G * 8; return F;
}
#define CAS __attribute__((address_space(4)))
__device__ __forceinline__ const float* inp(int i) {
    asm volatile("" : "+s"(i));
    const CAS char* ka = (const CAS char*)__builtin_amdgcn_kernarg_segment_ptr();
    return *(const float* const CAS*)(ka + 8 * i);
}

enum { I_X = 0, I_C, I_CTX, I_CCTX, I_WMOD, I_BMOD, I_NMPRE, I_NMPOST, I_NFPRE, I_NFPOST, I_WIN, I_LAMRE, I_LAMIM, I_LOGSTEP, I_BRE, I_BIM, I_CRE, I_CIM,
       I_S5D, I_WGLU, I_CONV, I_ALOG, I_DTB, I_DNNORM, I_WBRS, I_WBRD, I_WOUT, I_ROUTER, I_MBIAS, I_MGATE, I_MUP, I_MDOWN, I_SGATE, I_SUP, I_SDOWN };

struct MoeOrder {
    int ntiles, npn, G, c; const int* tile_e;
    __device__ __forceinline__ bool next(int i, pg8::Unit& u) const {
        const long L = (long)i * G + c; if (L >= (long)ntiles * npn) return false;
        const int tile = (int)(L / npn), pl = (int)(L % npn);
        const int e = __builtin_amdgcn_readfirstlane((int)__hip_atomic_load(tile_e + tile, __ATOMIC_RELAXED, __HIP_MEMORY_SCOPE_AGENT));
        u.pm = tile; u.pn = e * npn + pl; return true;
    }
    __device__ __forceinline__ void a_ready(const pg8::Unit&) const {}
    __device__ __forceinline__ void done(const pg8::Unit&) const {}
};

struct EpiBf16Mod {
    static constexpr bool PERM = true, AFTER_DRAIN = false;
    bf16* O; int ldc; int npn;
    __device__ __forceinline__ void operator()(const pg8::f32x4 (&acc)[2][2][4][2], const pg8::Unit& u, int wr, int wc, int fr, int fq) const {
        const int row0 = u.pm * 256 + wr * 64 + fr, col0 = (u.pn % npn) * 256 + wc * 32 + 8 * fq;
#pragma unroll
        for (int ai = 0; ai < 2; ++ai)
#pragma unroll
            for (int m = 0; m < 4; ++m) { bf16* rowp = O + (size_t)(row0 + ai * 128 + m * 16) * ldc + col0;
#pragma unroll
                for (int bj = 0; bj < 2; ++bj) { const pg8::f32x4 v0 = acc[ai][bj][m][0], v1 = acc[ai][bj][m][1];
                    u32x4 w; w.x = pk2(v0[0], v0[1]); w.y = pk2(v0[2], v0[3]); w.z = pk2(v1[0], v1[1]); w.w = pk2(v1[2], v1[3]);
                    *(u32x4*)(rowp + bj * 128) = w; } }
    }
};

struct EpiInProj {
    static constexpr bool PERM = true, AFTER_DRAIN = false;
    bf16* P; bf16* Ug;
    __device__ __forceinline__ void operator()(const pg8::f32x4 (&acc)[2][2][4][2], const pg8::Unit& u, int wr, int wc, int fr, int fq) const {
        const int row0 = u.pm * 256 + wr * 64 + fr, col0 = u.pn * 256 + wc * 32 + 8 * fq;
#pragma unroll
        for (int ai = 0; ai < 2; ++ai)
#pragma unroll
            for (int m = 0; m < 4; ++m) { const int t = row0 + ai * 128 + m * 16;
                int n, r;
                if (t < TC) { n = (t >> 8) * 72 + ((t & 255) >> 5); r = t & 31; } else { const int tt = t - TC, l = tt & 2047; n = (tt >> 11) * 72 + 8 + (l & 63); r = l >> 6; }
#pragma unroll
                for (int bj = 0; bj < 2; ++bj) { const pg8::f32x4 v0 = acc[ai][bj][m][0], v1 = acc[ai][bj][m][1]; const int col = col0 + bj * 128;
                    u32x4 w; w.x = pk2(v0[0], v0[1]); w.y = pk2(v0[2], v0[3]); w.z = pk2(v1[0], v1[1]); w.w = pk2(v1[2], v1[3]);
                    if (u.pn < 4) *(u32x4*)(Ug + ((size_t)((col >> 4) * S5N + n)) * 512 + r * 16 + (col & 15)) = w;
                    else *(u32x4*)(P + (size_t)t * NPAD + col) = w; } }
    }
};
struct EpiGlu {
    static constexpr bool PERM = true, AFTER_DRAIN = false;
    const bf16* Gb; bf16* O;
    __device__ __forceinline__ void operator()(const pg8::f32x4 (&acc)[2][2][4][2], const pg8::Unit& u, int wr, int wc, int fr, int fq) const {
        const int row0 = u.pm * 256 + wr * 64 + fr, col0 = u.pn * 256 + wc * 32 + 8 * fq;
#pragma unroll
        for (int ai = 0; ai < 2; ++ai)
#pragma unroll
            for (int m = 0; m < 4; ++m) { const size_t ro = (size_t)(row0 + ai * 128 + m * 16) * 1024 + col0;
#pragma unroll
                for (int bj = 0; bj < 2; ++bj) { const pg8::f32x4 v0 = acc[ai][bj][m][0], v1 = acc[ai][bj][m][1];
                    const u32x4 gq = *(const u32x4*)(Gb + ro + bj * 128);
                    u32x4 w;
                    w.x = pk2(bflo(gq.x) * sigmoidf_(v0[0]), bfhi(gq.x) * sigmoidf_(v0[1]));
                    w.y = pk2(bflo(gq.y) * sigmoidf_(v0[2]), bfhi(gq.y) * sigmoidf_(v0[3]));
                    w.z = pk2(bflo(gq.z) * sigmoidf_(v1[0]), bfhi(gq.z) * sigmoidf_(v1[1]));
                    w.w = pk2(bflo(gq.w) * sigmoidf_(v1[2]), bfhi(gq.w) * sigmoidf_(v1[3]));
                    *(u32x4*)(O + ro + bj * 128) = w; } }
    }
};
template <bool SECOND> struct EpiBr {
    static constexpr bool PERM = true, AFTER_DRAIN = false;
    const bf16* P; int gcol; float* M1; bf16* Mo;
    __device__ __forceinline__ void operator()(const pg8::f32x4 (&acc)[2][2][4][2], const pg8::Unit& u, int wr, int wc, int fr, int fq) const {
        const int row0 = u.pm * 256 + wr * 64 + fr, col0 = u.pn * 256 + wc * 32 + 8 * fq;
#pragma unroll
        for (int ai = 0; ai < 2; ++ai)
#pragma unroll
            for (int m = 0; m < 4; ++m) { const size_t row = (size_t)(row0 + ai * 128 + m * 16);
#pragma unroll
                for (int bj = 0; bj < 2; ++bj) { const pg8::f32x4 v0 = acc[ai][bj][m][0], v1 = acc[ai][bj][m][1];
                    const int col = col0 + bj * 128;
                    const u32x4 gq = *(const u32x4*)(P + row * NPAD + gcol + col);
                    f32x4 r0, r1;
                    r0[0] = sigmoidf_(bflo(gq.x)) * v0[0]; r0[1] = sigmoidf_(bfhi(gq.x)) * v0[1]; r0[2] = sigmoidf_(bflo(gq.y)) * v0[2]; r0[3] = sigmoidf_(bfhi(gq.y)) * v0[3];
                    r1[0] = sigmoidf_(bflo(gq.z)) * v1[0]; r1[1] = sigmoidf_(bfhi(gq.z)) * v1[1]; r1[2] = sigmoidf_(bflo(gq.w)) * v1[2]; r1[3] = sigmoidf_(bfhi(gq.w)) * v1[3];
                    float* mp = M1 + row * DM + col;
                    if (!SECOND) { *(f32x4*)mp = r0; *(f32x4*)(mp + 4) = r1; }
                    else { const f32x4 a0 = *(const f32x4*)mp, a1 = *(const f32x4*)(mp + 4); r0 += a0; r1 += a1;
                        u32x4 w; w.x = pk2(r0[0], r0[1]); w.y = pk2(r0[2], r0[3]); w.z = pk2(r1[0], r1[1]); w.w = pk2(r1[2], r1[3]);
                        *(u32x4*)(Mo + row * DM + col) = w; } }
                asm volatile("" ::: "memory"); }
    }
};
struct EpiSwiglu {
    static constexpr bool PERM = true, AFTER_DRAIN = false;
    bf16* O;
    __device__ __forceinline__ void operator()(const pg8::f32x4 (&acc)[2][2][4][2], const pg8::Unit& u, int wr, int wc, int fr, int fq) const {
        const int row0 = u.pm * 256 + wr * 64 + fr, col0 = (u.pn & 3) * 128 + wc * 32 + 8 * fq;
#pragma unroll
        for (int ai = 0; ai < 2; ++ai)
#pragma unroll
            for (int m = 0; m < 4; ++m) { bf16* rowp = O + (size_t)(row0 + ai * 128 + m * 16) * EDIM + col0;
                const pg8::f32x4 g0 = acc[ai][0][m][0], g1 = acc[ai][0][m][1], u0 = acc[ai][1][m][0], u1 = acc[ai][1][m][1];
                u32x4 w; w.x = pk2(siluf_(g0[0]) * u0[0], siluf_(g0[1]) * u0[1]); w.y = pk2(siluf_(g0[2]) * u0[2], siluf_(g0[3]) * u0[3]);
                w.z = pk2(siluf_(g1[0]) * u1[0], siluf_(g1[1]) * u1[1]); w.w = pk2(siluf_(g1[2]) * u1[2], siluf_(g1[3]) * u1[3]);
                *(u32x4*)rowp = w; }
    }
};

__device__ __forceinline__ const float* xrow_ptr(const unsigned char* ws, int layer, int t) {
    if (layer == 0) return t < TC ? inp(I_CTX) + (size_t)t * DM : inp(I_X) + (size_t)(t - TC) * DM;
    return (const float*)(ws + WS_X) + (size_t)t * DM;
}
__device__ __forceinline__ int row_lo(int layer) { return layer == NLAYER - 1 ? TC : 0; }
__device__ __forceinline__ int mods_row(int t) { return t < TC ? 4 : (t - TC) / SEQ; }
__device__ __forceinline__ void tr_item(const float* src, size_t ld, bf16* dst, int K, LAS float* scr, int lane) {
    float v[32];
#pragma unroll
    for (int i = 0; i < 32; ++i) { const int kk = 2 * i + (lane >> 5); v[i] = __builtin_nontemporal_load(src + (size_t)kk * ld + (lane & 31)); }
#pragma unroll
    for (int i = 0; i < 32; ++i) { const int kk = 2 * i + (lane >> 5); scr[kk * 33 + (lane & 31)] = v[i]; }
    LDS_WAIT();
    const int c = lane & 7;
#pragma unroll
    for (int j = 0; j < 4; ++j) { const int n = (lane >> 3) + 8 * j; const LAS float* s = scr + (8 * c) * 33 + n;
        u32x4 o; o.x = pk2(s[0 * 33], s[1 * 33]); o.y = pk2(s[2 * 33], s[3 * 33]); o.z = pk2(s[4 * 33], s[5 * 33]); o.w = pk2(s[6 * 33], s[7 * 33]);
        *(u32x4*)(dst + (size_t)n * K + 8 * c) = o; }
    LDS_WAIT();
}

__device__ __forceinline__ void s5_tables(const Frame& F, int layer, unsigned char* ws);
__device__ __forceinline__ void s5_state(const Frame& F, unsigned char* ws);
__device__ __forceinline__ void s5_out(const Frame& F, unsigned char* ws);

__device__ __forceinline__ void ph_pre(const Args& A, const Frame& F, int layer) {
    unsigned char* ws = A.ws; asm volatile("" : "+s"(ws));
    if (layer == 0) {
        LAS float* sil = (LAS float*)F.lds;
        for (int i = F.tid; i < 5 * DM; i += 512) { const int r = i / DM, k = i % DM; const float c = (r < 4) ? inp(I_C)[r * DM + k] : inp(I_CCTX)[k]; sil[i] = c / (1.f + expf(-c)); }
        __syncthreads();
        float* mods = (float*)(ws + WS_MODS);
        LAS float* part = (LAS float*)(F.lds + 5 * DM * 4);
        for (int it = F.vcu; it < NLAYER * 96; it += F.G) {
            const int l = it / 96, nb = it % 96;
            const float* W = inp(I_WMOD) + (size_t)l * DM * MODW + (size_t)(F.wave * 256) * MODW + nb * 128 + F.lane * 2;
            f32x2 acc[5];
#pragma unroll
            for (int r = 0; r < 5; ++r) acc[r] = (f32x2){0.f, 0.f};
#pragma unroll 8
            for (int k = 0; k < 256; ++k) { const f32x2 w = *(const f32x2*)(W + (size_t)k * MODW);
#pragma unroll
                for (int r = 0; r < 5; ++r) acc[r] += sil[r * DM + F.wave * 256 + k] * w; }
#pragma unroll
            for (int r = 0; r < 5; ++r) *(LAS f32x2*)(part + (F.wave * 5 + r) * 128 + F.lane * 2) = acc[r];
            __syncthreads();
            for (int o = F.tid; o < 5 * 128; o += 512) { const int r = o / 128, c = o % 128; float sum = inp(I_BMOD)[(size_t)l * MODW + nb * 128 + c];
#pragma unroll
                for (int w8 = 0; w8 < 8; ++w8) sum += part[(w8 * 5 + r) * 128 + c];
                mods[((size_t)l * 5 + r) * MODW + nb * 128 + c] = sum; }
            __syncthreads();
        }
        __syncthreads();
    }
    LAS float* scr = (LAS float*)(F.lds + F.wave * 16384);
    bf16* Wb = (bf16*)(ws + WS_W);
    constexpr int S_IN = 296 * 32, S_GLU = 512, S_BR = 1024, S_OUT = 2048, S_GU = NEX * 1024, S_DN = NEX * 512;
    constexpr int NITEMS = S_IN + S_GLU + 2 * S_BR + S_OUT + S_GU + S_DN;
    for (int it = F.gw; it < NITEMS; it += F.NGW) {
        int r = it; const float* src; size_t ld; bf16* dst; int K; bool zero = false;
        if (r < S_IN) {
            const int kb = r / 296, nb = r % 296, n0 = nb * 32, k0 = kb * 64;
            dst = Wb + WO_IN / 2 + (size_t)n0 * DM + k0; K = DM; ld = 9248;
            zero = n0 >= 9248;
            const int no = n0 < 5120 ? n0 : (n0 < 9216 ? n0 + 32 : n0 - 9216 + 5120);
            src = inp(I_WIN) + (size_t)layer * DM * 9248 + (size_t)k0 * 9248 + (zero ? 0 : no);
        } else if ((r -= S_IN) < S_GLU) { const int kb = r / 32, nb = r % 32;
            src = inp(I_WGLU) + (size_t)layer * 1024 * 1024 + (size_t)(kb * 64) * 1024 + nb * 32; ld = 1024; dst = Wb + WO_GLU / 2 + (size_t)(nb * 32) * 1024 + kb * 64; K = 1024;
        } else if ((r -= S_GLU) < 2 * S_BR) { const int which = r / S_BR, rr = r % S_BR, kb = rr / 64, nb = rr % 64;
            src = inp(which ? I_WBRD : I_WBRS) + (size_t)layer * 1024 * DM + (size_t)(kb * 64) * DM + nb * 32; ld = DM; dst = Wb + (which ? WO_BRD : WO_BRS) / 2 + (size_t)(nb * 32) * 1024 + kb * 64; K = 1024;
        } else if ((r -= 2 * S_BR) < S_OUT) { const int kb = r / 64, nb = r % 64;
            src = inp(I_WOUT) + (size_t)layer * DM * DM + (size_t)(kb * 64) * DM + nb * 32; ld = DM; dst = Wb + WO_OUT / 2 + (size_t)(nb * 32) * DM + kb * 64; K = DM;
        } else if ((r -= S_OUT) < S_GU) { const int e = r / 1024, rr = r % 1024, kb = rr / 32, nb = rr % 32, nd0 = nb * 32;
            const int pn = nd0 / 256, half = (nd0 % 256) / 128, j0 = pn * 128 + (nd0 % 128);
            const float* base = (e < NE) ? (inp(half ? I_MUP : I_MGATE) + ((size_t)layer * NE + e) * DM * EDIM) : (inp(half ? I_SUP : I_SGATE) + (size_t)layer * DM * EDIM);
            src = base + (size_t)(kb * 64) * EDIM + j0; ld = EDIM; dst = Wb + WO_GU / 2 + ((size_t)e * 1024 + nd0) * DM + kb * 64; K = DM;
        } else { r -= S_GU; const int e = r / 512, rr = r % 512, kb = rr / 64, nb = rr % 64;
            const float* base = (e < NE) ? (inp(I_MDOWN) + ((size_t)layer * NE + e) * EDIM * DM) : (inp(I_SDOWN) + (size_t)layer * EDIM * DM);
            src = base + (size_t)(kb * 64) * DM + nb * 32; ld = DM; dst = Wb + WO_DN / 2 + ((size_t)e * DM + nb * 32) * EDIM + kb * 64; K = EDIM; }
        if (zero) { const int c = F.lane & 7;
#pragma unroll
            for (int j = 0; j < 4; ++j) { const int n = (F.lane >> 3) + 8 * j; *(u32x4*)(dst + (size_t)n * K + 8 * c) = (u32x4){0u, 0u, 0u, 0u}; } }
        else tr_item(src, ld, dst, K, scr, F.lane);
    }
    s5_tables(F, layer, ws);
}

__device__ __forceinline__ void ph_n1(const Args& A, const Frame& F, int layer) {
    unsigned char* ws = A.ws; asm volatile("" : "+s"(ws));
    const float* mods = (const float*)(ws + WS_MODS) + (size_t)layer * 5 * MODW;
    const float* nw = inp(I_NMPRE) + (size_t)layer * DM;
    bf16* ab = (bf16*)(ws + WS_AB);
    for (int t = F.gw; t < TT; t += F.NGW) {
        const f32x4* xr = (const f32x4*)xrow_ptr(ws, layer, t) + F.lane;
        f32x4 v[8]; float ss = 0.f;
#pragma unroll
        for (int j = 0; j < 8; ++j) { v[j] = xr[64 * j]; ss += (v[j].x * v[j].x + v[j].y * v[j].y) + (v[j].z * v[j].z + v[j].w * v[j].w); }
        const float r = rsqrtf(wave_sum(ss) * (1.f / DM) + EPS);
        const float* mr = mods + (size_t)mods_row(t) * MODW;
        u32x2* o = (u32x2*)(ab + (size_t)t * DM) + F.lane;
#pragma unroll
        for (int j = 0; j < 8; ++j) { const int col = 4 * (F.lane + 64 * j);
            const f32x4 w = *(const f32x4*)(nw + col), sh = *(const f32x4*)(mr + col), sc = *(const f32x4*)(mr + DM + col);
            const f32x4 y = (v[j] * r * w) * (1.f + sc) + sh;
            u32x2 q; q.x = pk2(y.x, y.y); q.y = pk2(y.z, y.w); o[64 * j] = q; }
    }
}

__device__ __forceinline__ void ph_prep(const Args& A, const Frame& F, int layer) {
    unsigned char* ws = A.ws; asm volatile("" : "+s"(ws));
    const bf16* P = (const bf16*)(ws + WS_B + WB_P);
    bf16* qkv = (bf16*)(ws + WS_B + WB_QKV);
    float* bg = (float*)(ws + WS_B + WB_BG);
    const float* cw = inp(I_CONV) + (size_t)layer * 3 * 3072;
    s5_state(F, ws);
    for (int it = F.gw; it < TT * 8; it += F.NGW) {
        const int t = it >> 3, h = it & 7;
        bool hp, hn;
        if (t < TC) { const int i = t & 255; hp = i > 0; hn = i < 255; } else { const int l = (t - TC) & 2047; hp = l > 0; hn = l < 2047; }
        float val[3][2];
#pragma unroll
        for (int part = 0; part < 3; ++part) {
            const int ch = part * 1024 + h * 128 + 2 * F.lane;
            const bf16* pc = P + (size_t)t * NPAD + PC_QKV + ch;
            const unsigned x0 = *(const unsigned*)pc;
            const unsigned xm = hp ? *(const unsigned*)(pc - NPAD) : 0u;
            const unsigned xp = hn ? *(const unsigned*)(pc + NPAD) : 0u;
            const f32x2 w0 = *(const f32x2*)(cw + ch), w1 = *(const f32x2*)(cw + 3072 + ch), w2 = *(const f32x2*)(cw + 2 * 3072 + ch);
            val[part][0] = siluf_(w0.x * bflo(xm) + w1.x * bflo(x0) + w2.x * bflo(xp));
            val[part][1] = siluf_(w0.y * bfhi(xm) + w1.y * bfhi(x0) + w2.y * bfhi(xp));
        }
        const float qs = rsqrtf(wave_sum(val[0][0] * val[0][0] + val[0][1] * val[0][1]) + EPS) * 0.08838834764831845f;
        const float ks = rsqrtf(wave_sum(val[1][0] * val[1][0] + val[1][1] * val[1][1]) + EPS);
        bf16* o = qkv + (size_t)t * 3072 + h * 128 + 2 * F.lane;
        *(unsigned*)o = pk2(val[0][0] * qs, val[0][1] * qs);
        *(unsigned*)(o + 1024) = pk2(val[1][0] * ks, val[1][1] * ks);
        *(unsigned*)(o + 2048) = pk2(val[2][0], val[2][1]);
        if (h == 0 && F.lane < 32) {
            const int idx = F.lane, kind = idx >> 4, dh = idx & 15;
            const float raw = bf2f(P[(size_t)t * NPAD + PC_BA + idx]);
            float o2;
            if (kind == 0) o2 = 1.f / (1.f + expf(-raw));
            else { const float xx = raw + inp(I_DTB)[layer * 16 + dh]; const float sp = xx > 20.f ? xx : log1pf(expf(xx)); o2 = -expf(inp(I_ALOG)[layer * 16 + dh]) * sp; }
            bg[(size_t)t * 32 + idx] = o2;
        }
    }
}


typedef short bf16x8v __attribute__((ext_vector_type(8)));
typedef unsigned short u16x4v __attribute__((ext_vector_type(4)));
__device__ __forceinline__ int dn_tok(int b, int dir, int s) {
    if (s < CTXL) return b * CTXL + (dir ? (CTXL - 1 - s) : s);
    const int m = s - CTXL; return TC + b * SEQ + (dir ? (SEQ - 1 - m) : m);
}
__device__ __forceinline__ pg8::f32x4 mfma16(bf16x8v a, bf16x8v b, pg8::f32x4 c) { return __builtin_amdgcn_mfma_f32_16x16x32_bf16(a, b, c, 0, 0, 0); }
__device__ __forceinline__ bf16x8v frag_tr(unsigned lds_base, int pitch, int r0, int c0, int lane) {
    const int g = lane >> 4, q = (lane & 15) >> 2, p = lane & 3;
    const unsigned a0 = lds_base + (unsigned)((r0 + 8 * g + q) * pitch + (c0 + 4 * p) * 2);
    u16x4v lo, hi;
    asm volatile("ds_read_b64_tr_b16 %0, %2\n\tds_read_b64_tr_b16 %1, %3\n\ts_waitcnt lgkmcnt(0)" : "=&v"(lo), "=&v"(hi) : "v"(a0), "v"(a0 + 4u * (unsigned)pitch) : "memory");
    bf16x8v r; r[0] = (short)lo[0]; r[1] = (short)lo[1]; r[2] = (short)lo[2]; r[3] = (short)lo[3]; r[4] = (short)hi[0]; r[5] = (short)hi[1]; r[6] = (short)hi[2]; r[7] = (short)hi[3];
    return r;
}
__device__ __forceinline__ void ph_dn_a(const Args& A, const Frame& F, int layer, unsigned char* ws_in) {
    for (int unit = F.NGW - 1 - F.gw; unit < DN_UNITS; unit += F.NGW) {
        int lane = F.lane; asm volatile("" : "+v"(lane));
        unsigned char* ws = ws_in; asm volatile("" : "+s"(ws));
        const bf16* qkv = (const bf16*)(ws + WS_B + WB_QKV);
        const float* bg = (const float*)(ws + WS_B + WB_BG);
        unsigned char* dnu = ws + WS_B + WB_DNU;
        const int l15 = lane & 15, g4 = lane >> 4;
        LAS unsigned char* wl = F.lds + F.wave * 17408;
        LAS float* XA = (LAS float*)wl;
        LAS unsigned char* XK = wl;
        LAS unsigned char* TL = wl + 8704;
        LAS float* tab = (LAS float*)(wl + 8704 + 8192);
        const int c = unit % 36, dir = (unit / 36) & 1, h = (unit / 72) & 7, b = unit / 576;
        const int ti = dn_tok(b, dir, 64 * c + lane);
        const float beta = bg[(size_t)ti * 32 + dir * 8 + h], gi = bg[(size_t)ti * 32 + 16 + dir * 8 + h];
        float gc = gi;
#pragma unroll
        for (int o = 1; o < 64; o <<= 1) { const float t = __int_as_float(__builtin_amdgcn_ds_bpermute(((lane - o) & 63) << 2, __float_as_int(gc))); if (lane >= o) gc += t; }
        const float glast = __int_as_float(__builtin_amdgcn_readlane(__float_as_int(gc), 63));
        tab[lane] = gc; tab[64 + lane] = beta;
        float* SC = (float*)(dnu + DNU_SC) + (size_t)unit * 256;
        SC[lane] = __expf(gc); SC[64 + lane] = __expf(glast - gc); if (lane == 0) SC[128] = __expf(glast);
        LDS_WAIT();
        bf16x8v KF[4][4];
        int tokr[4];
#pragma unroll
        for (int rt = 0; rt < 4; ++rt) { tokr[rt] = dn_tok(b, dir, 64 * c + 16 * rt + l15);
#pragma unroll
            for (int ks = 0; ks < 4; ++ks) KF[rt][ks] = *(const bf16x8v*)(qkv + (size_t)tokr[rt] * 3072 + 1024 + h * 128 + 32 * ks + 8 * g4); }
        bf16* QKo = (bf16*)(dnu + DNU_QK) + (size_t)unit * 4096;
#pragma unroll
        for (int it = 0; it < 4; ++it) {
            bf16x8v QF[4];
#pragma unroll
            for (int ks = 0; ks < 4; ++ks) QF[ks] = *(const bf16x8v*)(qkv + (size_t)tokr[it] * 3072 + h * 128 + 32 * ks + 8 * g4);
            const int i = 16 * it + l15; const float gci = tab[i];
#pragma unroll
            for (int jt = 0; jt < 4; ++jt) {
                u32x2 w = (u32x2){0u, 0u};
                if (jt <= it) {
                    pg8::f32x4 acc = (pg8::f32x4){0.f, 0.f, 0.f, 0.f};
#pragma unroll
                    for (int ks = 0; ks < 4; ++ks) acc = mfma16(KF[jt][ks], QF[ks], acc);
                    const int j0 = 16 * jt + 4 * g4; const f32x4 gcj = *(const LAS f32x4*)(tab + j0);
                    float v[4];
#pragma unroll
                    for (int r = 0; r < 4; ++r) v[r] = (j0 + r <= i) ? acc[r] * __expf(gci - gcj[r]) : 0.f;
                    w.x = pk2(v[0], v[1]); w.y = pk2(v[2], v[3]);
                }
                *(u32x2*)(QKo + (size_t)i * 64 + 16 * jt + 4 * g4) = w;
            }
            asm volatile("" ::: "memory");
        }
        float Tc[64];
#pragma unroll
        for (int hf = 0; hf < 2; ++hf) {
#pragma unroll
            for (int it2 = 0; it2 < 2; ++it2) { const int it = 2 * hf + it2; const int i = 16 * it + l15; const float gci = tab[i], bi = tab[64 + i];
#pragma unroll
                for (int jt = 0; jt < 4; ++jt) if (jt <= it) {
                    pg8::f32x4 acc = (pg8::f32x4){0.f, 0.f, 0.f, 0.f};
#pragma unroll
                    for (int ks = 0; ks < 4; ++ks) acc = mfma16(KF[jt][ks], KF[it][ks], acc);
                    const int j0 = 16 * jt + 4 * g4; const f32x4 gcj = *(const LAS f32x4*)(tab + j0);
                    f32x4 o;
#pragma unroll
                    for (int r = 0; r < 4; ++r) o[r] = bi * acc[r] * __expf(fminf(gci - gcj[r], 0.f));
                    *(LAS f32x4*)(XA + (16 * it2 + l15) * 68 + j0) = o;
                } }
            LDS_WAIT();
#pragma unroll
            for (int ii = 0; ii < 32; ++ii) { const int i = 32 * hf + ii;
                float t = (i == lane) ? 1.f : 0.f;
#pragma unroll
                for (int q = 0; q < (i + 3) / 4; ++q) { const f32x4 a = *(const LAS f32x4*)(XA + ii * 68 + 4 * q);
#pragma unroll
                    for (int r = 0; r < 4; ++r) if (4 * q + r < i) t -= a[r] * Tc[4 * q + r]; }
                Tc[i] = t; asm volatile("" ::: "memory"); }
            LDS_WAIT();
        }
#pragma unroll
        for (int i = 0; i < 64; ++i) *(LAS bf16*)(TL + i * 128 + lane * 2) = (bf16)f2bf(Tc[i] * beta);
        LDS_WAIT();
        const unsigned xk_addr = (unsigned)(size_t)XK;
        bf16* Wo = (bf16*)(dnu + DNU_W) + (size_t)unit * 8192;
        bf16* KTo = (bf16*)(dnu + DNU_KT) + (size_t)unit * 8192;
        bf16* UTo = (bf16*)(dnu + DNU_UT) + (size_t)unit * 8192;
#pragma unroll
        for (int pass = 0; pass < 2; ++pass) {
#pragma unroll
          for (int chf = 0; chf < 2; ++chf) {
            pg8::f32x4 acc[4][4];
#pragma unroll
            for (int a = 0; a < 4; ++a)
#pragma unroll
                for (int bq = 0; bq < 4; ++bq) acc[a][bq] = (pg8::f32x4){0.f, 0.f, 0.f, 0.f};
#pragma unroll
            for (int ks = 0; ks < 2; ++ks) {
#pragma unroll
                for (int q = 0; q < 8; ++q) { const int n = lane + 64 * q, row = n >> 4, ch = n & 15;
                    const int tk = dn_tok(b, dir, 64 * c + 32 * ks + row);
                    const u32x4 d = *(const u32x4*)(qkv + (size_t)tk * 3072 + (pass ? 2048 : 1024) + h * 128 + 8 * ch);
                    *(LAS u32x4*)(XK + row * 272 + 16 * ch) = d; }
                LDS_WAIT();
                bf16x8v TF[4];
#pragma unroll
                for (int it = 0; it < 4; ++it) { u32x4 t = *(const LAS u32x4*)(TL + (16 * it + l15) * 128 + (32 * ks + 8 * g4) * 2);
                    if (pass == 0) { const f32x4 g0 = *(const LAS f32x4*)(tab + 32 * ks + 8 * g4), g1 = *(const LAS f32x4*)(tab + 32 * ks + 8 * g4 + 4);
                        t.x = pk2(bflo(t.x) * __expf(g0[0]), bfhi(t.x) * __expf(g0[1])); t.y = pk2(bflo(t.y) * __expf(g0[2]), bfhi(t.y) * __expf(g0[3]));
                        t.z = pk2(bflo(t.z) * __expf(g1[0]), bfhi(t.z) * __expf(g1[1])); t.w = pk2(bflo(t.w) * __expf(g1[2]), bfhi(t.w) * __expf(g1[3])); }
                    TF[it] = __builtin_bit_cast(bf16x8v, t); }
#pragma unroll
                for (int c4 = 0; c4 < 4; ++c4) { const int ct = 4 * chf + c4;
                    const bf16x8v XF = frag_tr(xk_addr, 272, 0, 16 * ct, lane);
                    if (pass == 0) { *(bf16x8v*)(KTo + (size_t)(16 * ct + l15) * 64 + 32 * ks + 8 * g4) = XF;
#pragma unroll
                        for (int it = 0; it < 4; ++it) acc[c4][it] = mfma16(XF, TF[it], acc[c4][it]); }
                    else {
#pragma unroll
                        for (int it = 0; it < 4; ++it) acc[c4][it] = mfma16(TF[it], XF, acc[c4][it]); }
                }
                LDS_WAIT();
            }
#pragma unroll
            for (int c4 = 0; c4 < 4; ++c4)
#pragma unroll
                for (int it = 0; it < 4; ++it) { const int ct = 4 * chf + c4; const pg8::f32x4 a = acc[c4][it]; u32x2 w; w.x = pk2(a[0], a[1]); w.y = pk2(a[2], a[3]);
                    if (pass == 0) *(u32x2*)(Wo + (size_t)(16 * it + l15) * 128 + 16 * ct + 4 * g4) = w;
                    else *(u32x2*)(UTo + (size_t)(16 * ct + l15) * 64 + 16 * it + 4 * g4) = w; }
            asm volatile("" ::: "memory");
          }
        }
    }
}

__device__ __forceinline__ void ph_dn_b(const Args& A, const Frame& F, int layer) {
    unsigned char* ws = A.ws; asm volatile("" : "+s"(ws));
    const bf16* qkv = (const bf16*)(ws + WS_B + WB_QKV);
    const unsigned char* dnu = ws + WS_B + WB_DNU;
    float* obase = (float*)(ws + WS_B + WB_O);
    const int lane = F.lane, l15 = lane & 15, g4 = lane >> 4, w = F.wave, mt = w >> 1, nt = w & 1, kt = w;
    LAS unsigned char* ST = F.lds;
    LAS unsigned char* VN = F.lds + 8704;
    LAS unsigned char* VS = F.lds + 8704 + 4608;
    for (int item = F.vcu; item < 256; item += F.G) {
        const int seq = item >> 2, vd0 = (item & 3) * 32, dir = seq & 1, h = (seq >> 1) & 7, b = seq >> 4;
        float* ob = obase + (size_t)dir * TT * 1024;
        for (int i = F.tid; i < 8704 / 4; i += 512) ((LAS unsigned*)ST)[i] = 0u;
        pg8::f32x4 accS[2]; accS[0] = (pg8::f32x4){0.f, 0.f, 0.f, 0.f}; accS[1] = accS[0];
        __syncthreads();
        bf16x8v WF[4], QF[4], QKF[2], KTF[2]; u32x2 Uc; f32x4 gam, ee; float glast;
        {   const size_t unit = (size_t)seq * 36;
            const int tq = dn_tok(b, dir, 16 * mt + l15);
#pragma unroll
            for (int ks = 0; ks < 4; ++ks) { WF[ks] = *(const bf16x8v*)((const bf16*)(dnu + DNU_W) + unit * 8192 + (size_t)(16 * mt + l15) * 128 + 32 * ks + 8 * g4);
                QF[ks] = *(const bf16x8v*)(qkv + (size_t)tq * 3072 + h * 128 + 32 * ks + 8 * g4); }
#pragma unroll
            for (int ks = 0; ks < 2; ++ks) { QKF[ks] = *(const bf16x8v*)((const bf16*)(dnu + DNU_QK) + unit * 4096 + (size_t)(16 * mt + l15) * 64 + 32 * ks + 8 * g4);
                KTF[ks] = *(const bf16x8v*)((const bf16*)(dnu + DNU_KT) + unit * 8192 + (size_t)(16 * kt + l15) * 64 + 32 * ks + 8 * g4); }
            Uc = *(const u32x2*)((const bf16*)(dnu + DNU_UT) + unit * 8192 + (size_t)(vd0 + 16 * nt + l15) * 64 + 16 * mt + 4 * g4);
            const float* SC = (const float*)(dnu + DNU_SC) + unit * 256;
            gam = *(const f32x4*)(SC + 16 * mt + 4 * g4); ee = *(const f32x4*)(SC + 64 + 16 * mt + 4 * g4); glast = SC[128]; }
        for (int c = 0; c < 36; ++c) {
            bf16x8v cW[4], cQ[4], cQK[2], cKT[2]; const u32x2 cU = Uc; const f32x4 cgam = gam, cee = ee; const float cgl = glast;
#pragma unroll
            for (int ks = 0; ks < 4; ++ks) { cW[ks] = WF[ks]; cQ[ks] = QF[ks]; }
#pragma unroll
            for (int ks = 0; ks < 2; ++ks) { cQK[ks] = QKF[ks]; cKT[ks] = KTF[ks]; }
            if (c + 1 < 36) { const size_t unit = (size_t)seq * 36 + c + 1;
                const int tq = dn_tok(b, dir, 64 * (c + 1) + 16 * mt + l15);
#pragma unroll
                for (int ks = 0; ks < 4; ++ks) { WF[ks] = *(const bf16x8v*)((const bf16*)(dnu + DNU_W) + unit * 8192 + (size_t)(16 * mt + l15) * 128 + 32 * ks + 8 * g4);
                    QF[ks] = *(const bf16x8v*)(qkv + (size_t)tq * 3072 + h * 128 + 32 * ks + 8 * g4); }
#pragma unroll
                for (int ks = 0; ks < 2; ++ks) { QKF[ks] = *(const bf16x8v*)((const bf16*)(dnu + DNU_QK) + unit * 4096 + (size_t)(16 * mt + l15) * 64 + 32 * ks + 8 * g4);
                    KTF[ks] = *(const bf16x8v*)((const bf16*)(dnu + DNU_KT) + unit * 8192 + (size_t)(16 * kt + l15) * 64 + 32 * ks + 8 * g4); }
                Uc = *(const u32x2*)((const bf16*)(dnu + DNU_UT) + unit * 8192 + (size_t)(vd0 + 16 * nt + l15) * 64 + 16 * mt + 4 * g4);
                const float* SC = (const float*)(dnu + DNU_SC) + unit * 256;
                gam = *(const f32x4*)(SC + 16 * mt + 4 * g4); ee = *(const f32x4*)(SC + 64 + 16 * mt + 4 * g4); glast = SC[128]; }
            pg8::f32x4 P = (pg8::f32x4){0.f, 0.f, 0.f, 0.f}, O1 = P;
#pragma unroll
            for (int ks = 0; ks < 4; ++ks) { const bf16x8v SF = *(const LAS bf16x8v*)(ST + (16 * nt + l15) * 272 + (32 * ks + 8 * g4) * 2);
                P = mfma16(cW[ks], SF, P); O1 = mfma16(cQ[ks], SF, O1); }
            float vn[4];
            vn[0] = bflo(cU.x) - P[0]; vn[1] = bfhi(cU.x) - P[1]; vn[2] = bflo(cU.y) - P[2]; vn[3] = bfhi(cU.y) - P[3];
            { u32x2 a; a.x = pk2(vn[0], vn[1]); a.y = pk2(vn[2], vn[3]); *(LAS u32x2*)(VN + (16 * nt + l15) * 144 + (16 * mt + 4 * g4) * 2) = a;
              u32x2 e; e.x = pk2(vn[0] * cee[0], vn[1] * cee[1]); e.y = pk2(vn[2] * cee[2], vn[3] * cee[3]); *(LAS u32x2*)(VS + (16 * nt + l15) * 144 + (16 * mt + 4 * g4) * 2) = e; }
            __syncthreads();
            pg8::f32x4 O2 = (pg8::f32x4){0.f, 0.f, 0.f, 0.f};
#pragma unroll
            for (int ks = 0; ks < 2; ++ks) { const bf16x8v VF = *(const LAS bf16x8v*)(VN + (16 * nt + l15) * 144 + (32 * ks + 8 * g4) * 2); O2 = mfma16(cQK[ks], VF, O2); }
#pragma unroll
            for (int r = 0; r < 4; ++r) { const int tk = dn_tok(b, dir, 64 * c + 16 * mt + 4 * g4 + r); ob[(size_t)tk * 1024 + h * 128 + vd0 + 16 * nt + l15] = cgam[r] * O1[r] + O2[r]; }
#pragma unroll
            for (int n2 = 0; n2 < 2; ++n2) { pg8::f32x4 a = accS[n2] * cgl;
#pragma unroll
                for (int ks = 0; ks < 2; ++ks) { const bf16x8v VF = *(const LAS bf16x8v*)(VS + (16 * n2 + l15) * 144 + (32 * ks + 8 * g4) * 2); a = mfma16(cKT[ks], VF, a); }
                accS[n2] = a;
                u32x2 sw; sw.x = pk2(a[0], a[1]); sw.y = pk2(a[2], a[3]); *(LAS u32x2*)(ST + (16 * n2 + l15) * 272 + (16 * kt + 4 * g4) * 2) = sw; }
            __syncthreads();
        }
    }
    s5_out(F, ws);
}


struct S5Lam { float abr, abi, cr, ci, lrs, lis; };
__device__ __forceinline__ S5Lam s5_lam(int layer, int dir, int g, int p) {
    const size_t pg = (size_t)(layer * 2 + dir) * 64 + g;
    const float lr = inp(I_LAMRE)[pg * 64 + p], li = inp(I_LAMIM)[pg * 64 + p], step = expf(inp(I_LOGSTEP)[pg]);
    S5Lam L; L.lrs = lr * step; L.lis = li * step;
    const float mag = expf(L.lrs); L.abr = mag * cosf(L.lis); L.abi = mag * sinf(L.lis);
    const float den = lr * lr + li * li, nr = L.abr - 1.f; L.cr = (nr * lr + L.abi * li) / den; L.ci = (L.abi * lr - nr * li) / den;
    return L;
}
__device__ __forceinline__ void s5_pow(const S5Lam& L, int n, float& pr, float& pi) { const float m = expf(L.lrs * (float)n); float sn, cs; sincosf(L.lis * (float)n, &sn, &cs); pr = m * cs; pi = m * sn; }
__device__ __forceinline__ void s5_tables(const Frame& F, int layer, unsigned char* ws) {
    unsigned char* sb = ws + WS_B + WB_S5;
    bf16* Kc = (bf16*)(sb + S5_KC); bf16* Wst = (bf16*)(sb + S5_WST); bf16* Wout = (bf16*)(sb + S5_WOUT); float* L32 = (float*)(sb + S5_L32);
    const int gt = F.vcu * 512 + F.tid, NT = F.G * 512;
    for (int it = gt; it < 64 * 63 * 16; it += NT) {
        const int j = it & 15, l = (it >> 4) % 63, g = it / (63 * 16);
        float acc[16];
#pragma unroll
        for (int q = 0; q < 16; ++q) acc[q] = 0.f;
        for (int d = 0; d < 2; ++d) {
            if ((d == 0 && l < 31) || (d == 1 && l > 31)) continue;
            const int tau = d == 0 ? l - 31 : 31 - l;
            const size_t pg = (size_t)(layer * 2 + d) * 64 + g;
            for (int p = 0; p < 64; ++p) {
                const S5Lam L = s5_lam(layer, d, g, p);
                float pr, pi; s5_pow(L, tau, pr, pi);
                const float c_r = inp(I_CRE)[(pg * 16 + j) * 64 + p], c_i = inp(I_CIM)[(pg * 16 + j) * 64 + p];
                const float tr = c_r * pr - c_i * pi, ti = c_r * pi + c_i * pr;
                const float ur = tr * L.cr - ti * L.ci, ui = tr * L.ci + ti * L.cr;
                const float* br = inp(I_BRE) + (pg * 64 + p) * 16; const float* bi = inp(I_BIM) + (pg * 64 + p) * 16;
#pragma unroll
                for (int q = 0; q < 16; ++q) acc[q] += ur * br[q] - ui * bi[q];
            }
        }
        if (l == 31) acc[j] += inp(I_S5D)[(size_t)layer * 1024 + g * 16 + j];
        u32x4 w0, w1;
        w0.x = pk2(acc[0], acc[1]); w0.y = pk2(acc[2], acc[3]); w0.z = pk2(acc[4], acc[5]); w0.w = pk2(acc[6], acc[7]);
        w1.x = pk2(acc[8], acc[9]); w1.y = pk2(acc[10], acc[11]); w1.z = pk2(acc[12], acc[13]); w1.w = pk2(acc[14], acc[15]);
        bf16* o = Kc + ((size_t)(g * 63 + l) * 16 + j) * 16; *(u32x4*)o = w0; *(u32x4*)(o + 8) = w1;
    }
    for (int it = gt; it < 64 * 2 * 32 * 64; it += NT) {
        const int p = it & 63, r = (it >> 6) & 31, d = (it >> 11) & 1, g = it >> 12;
        const size_t pg = (size_t)(layer * 2 + d) * 64 + g;
        const S5Lam L = s5_lam(layer, d, g, p);
        float pr, pi; s5_pow(L, d == 0 ? 31 - r : r, pr, pi);
        const float qr = pr * L.cr - pi * L.ci, qi = pr * L.ci + pi * L.cr;
        const float* br = inp(I_BRE) + (pg * 64 + p) * 16; const float* bi = inp(I_BIM) + (pg * 64 + p) * 16;
        float wr_[16], wi_[16];
#pragma unroll
        for (int q = 0; q < 16; ++q) { wr_[q] = qr * br[q] - qi * bi[q]; wi_[q] = qr * bi[q] + qi * br[q]; }
        bf16* o = Wst + ((size_t)(g * 2 + d) * 128 + p) * 512 + r * 16;
        u32x4 a0, a1, b0, b1;
        a0.x = pk2(wr_[0], wr_[1]); a0.y = pk2(wr_[2], wr_[3]); a0.z = pk2(wr_[4], wr_[5]); a0.w = pk2(wr_[6], wr_[7]);
        a1.x = pk2(wr_[8], wr_[9]); a1.y = pk2(wr_[10], wr_[11]); a1.z = pk2(wr_[12], wr_[13]); a1.w = pk2(wr_[14], wr_[15]);
        b0.x = pk2(wi_[0], wi_[1]); b0.y = pk2(wi_[2], wi_[3]); b0.z = pk2(wi_[4], wi_[5]); b0.w = pk2(wi_[6], wi_[7]);
        b1.x = pk2(wi_[8], wi_[9]); b1.y = pk2(wi_[10], wi_[11]); b1.z = pk2(wi_[12], wi_[13]); b1.w = pk2(wi_[14], wi_[15]);
        *(u32x4*)o = a0; *(u32x4*)(o + 8) = a1; *(u32x4*)(o + 64 * 512) = b0; *(u32x4*)(o + 64 * 512 + 8) = b1;
    }
    for (int it = gt; it < 64 * 2 * 32 * 64; it += NT) {
        const int p = it & 63, sp = (it >> 6) & 31, d = (it >> 11) & 1, g = it >> 12;
        const size_t pg = (size_t)(layer * 2 + d) * 64 + g;
        const S5Lam L = s5_lam(layer, d, g, p);
        float pr, pi; s5_pow(L, d == 0 ? sp + 1 : 32 - sp, pr, pi);
        bf16* o = Wout + ((size_t)(g * 2 + d) * 512 + sp * 16) * 128 + p;
#pragma unroll
        for (int j = 0; j < 16; ++j) { const float c_r = inp(I_CRE)[(pg * 16 + j) * 64 + p], c_i = inp(I_CIM)[(pg * 16 + j) * 64 + p];
            o[(size_t)j * 128] = (bf16)f2bf(c_r * pr - c_i * pi); o[(size_t)j * 128 + 64] = (bf16)f2bf(-(c_r * pi + c_i * pr)); }
    }
    for (int it = gt; it < 64 * 2 * 64; it += NT) { const int p = it & 63, d = (it >> 6) & 1, g = it >> 7; const S5Lam L = s5_lam(layer, d, g, p); float pr, pi; s5_pow(L, 32, pr, pi); L32[2 * it] = pr; L32[2 * it + 1] = pi; }
}
__device__ __forceinline__ void s5_state(const Frame& F, unsigned char* ws) {
    const unsigned char* sb = ws + WS_B + WB_S5;
    const int l15 = F.lane & 15, g4 = F.lane >> 4, w = F.wave;
    for (int item = F.vcu; item < 256; item += F.G) {
        const int nh = item & 1, d = (item >> 1) & 1, g = item >> 2;
        const bf16* Arow = (const bf16*)(sb + S5_WST) + ((size_t)(g * 2 + d) * 128 + 16 * w + l15) * 512 + 8 * g4;
        const bf16* Brow = (const bf16*)(sb + S5_UG) + ((size_t)g * S5N + nh * 144 + l15) * 512 + 8 * g4;
        pg8::f32x4 acc[9];
#pragma unroll
        for (int q = 0; q < 9; ++q) acc[q] = (pg8::f32x4){0.f, 0.f, 0.f, 0.f};
#pragma unroll 2
        for (int ks = 0; ks < 16; ++ks) { const bf16x8v a = *(const bf16x8v*)(Arow + 32 * ks);
#pragma unroll
            for (int q = 0; q < 9; ++q) { const bf16x8v bq = *(const bf16x8v*)(Brow + (size_t)(16 * q) * 512 + 32 * ks); acc[q] = mfma16(a, bq, acc[q]); } }
        float* So = (float*)(sb + S5_SLOC) + ((size_t)(g * 2 + d) * S5N + nh * 144 + l15) * 128 + 16 * w + 4 * g4;
#pragma unroll
        for (int q = 0; q < 9; ++q) *(f32x4*)(So + (size_t)(16 * q) * 128) = acc[q];
    }
}
__device__ __forceinline__ void s5_carry(const Frame& F, unsigned char* ws) {
    const unsigned char* sb = ws + WS_B + WB_S5;
    if (F.gw >= 512) return;
    const int p = F.lane, b = F.gw & 3, d = (F.gw >> 2) & 1, g = F.gw >> 3;
    const float* L32 = (const float*)(sb + S5_L32) + 2 * ((g * 2 + d) * 64 + p);
    const float lr = L32[0], li = L32[1];
    const float* Sl = (const float*)(sb + S5_SLOC) + ((size_t)(g * 2 + d) * S5N + b * 72) * 128 + p;
    bf16* Hi = (bf16*)(sb + S5_HIN) + ((size_t)(g * 2 + d) * S5N + b * 72) * 128 + p;
    float hr = 0.f, hi = 0.f;
#pragma unroll 4
    for (int st = 0; st < 72; ++st) {
        const int ch = d == 0 ? st : (st < 8 ? 7 - st : 79 - st);
        Hi[(size_t)ch * 128] = (bf16)f2bf(hr); Hi[(size_t)ch * 128 + 64] = (bf16)f2bf(hi);
        const float sr = Sl[(size_t)ch * 128], si = Sl[(size_t)ch * 128 + 64];
        const float nr = lr * hr - li * hi + sr, ni = lr * hi + li * hr + si; hr = nr; hi = ni;
    }
}
__device__ __forceinline__ void s5_out(const Frame& F, unsigned char* ws) {
    const unsigned char* sb = ws + WS_B + WB_S5;
    bf16* gb = (bf16*)(ws + WS_B + WB_G);
    const int l15 = F.lane & 15, g4 = F.lane >> 4, w = F.wave;
    LAS unsigned char* KL = F.lds;
    for (int item = F.vcu; item < 256; item += F.G) {
        const int mq = item & 3, g = item >> 2;
        __syncthreads();
        for (int i = F.tid; i < 63 * 32; i += 512) *((LAS u32x4*)KL + i) = *((const u32x4*)(sb + S5_KC + (size_t)g * 63 * 512) + i);
        __syncthreads();
        const int ntn = (w < 2) ? 3 : 2;
        pg8::f32x4 acc[8][3];
#pragma unroll
        for (int m = 0; m < 8; ++m)
#pragma unroll
            for (int q = 0; q < 3; ++q) acc[m][q] = (pg8::f32x4){0.f, 0.f, 0.f, 0.f};
        const bf16* Ub = (const bf16*)(sb + S5_UG) + ((size_t)g * S5N + 16 * w + l15) * 512 + 8 * g4;
#pragma unroll 2
        for (int ks = 0; ks < 16; ++ks) {
            bf16x8v bq[3];
#pragma unroll
            for (int q = 0; q < 3; ++q) if (q < ntn) bq[q] = *(const bf16x8v*)(Ub + (size_t)(128 * q) * 512 + 32 * ks);
            const int r = 2 * ks + (g4 >> 1);
#pragma unroll
            for (int m = 0; m < 8; ++m) { const int sp = 8 * mq + m, l = sp - r + 31;
                const bf16x8v a = *(const LAS bf16x8v*)(KL + ((l * 16 + l15) * 16 + 8 * (g4 & 1)) * 2);
#pragma unroll
                for (int q = 0; q < 3; ++q) if (q < ntn) acc[m][q] = mfma16(a, bq[q], acc[m][q]); }
        }
#pragma unroll
        for (int d = 0; d < 2; ++d) {
            const bf16* Hb = (const bf16*)(sb + S5_HIN) + ((size_t)(g * 2 + d) * S5N + 16 * w + l15) * 128 + 8 * g4;
            const bf16* Wo = (const bf16*)(sb + S5_WOUT) + ((size_t)(g * 2 + d) * 512 + (8 * mq) * 16 + l15) * 128 + 8 * g4;
#pragma unroll
            for (int ks = 0; ks < 4; ++ks) {
                bf16x8v bq[3];
#pragma unroll
                for (int q = 0; q < 3; ++q) if (q < ntn) bq[q] = *(const bf16x8v*)(Hb + (size_t)(128 * q) * 128 + 32 * ks);
#pragma unroll
                for (int m = 0; m < 8; ++m) { const bf16x8v a = *(const bf16x8v*)(Wo + (size_t)(16 * m) * 128 + 32 * ks);
#pragma unroll
                    for (int q = 0; q < 3; ++q) if (q < ntn) acc[m][q] = mfma16(a, bq[q], acc[m][q]); }
            }
        }
#pragma unroll
        for (int q = 0; q < 3; ++q) if (q < ntn) {
            const int n = 16 * (w + 8 * q) + l15, b = n / 72, ch = n % 72;
#pragma unroll
            for (int m = 0; m < 8; ++m) { const int sp = 8 * mq + m;
                const int t = ch < 8 ? b * CTXL + ch * 32 + sp : TC + b * SEQ + sp * 64 + (ch - 8);
                const pg8::f32x4 a = acc[m][q];
                u32x2 o; o.x = pk2(gelu_tanh(a[0]), gelu_tanh(a[1])); o.y = pk2(gelu_tanh(a[2]), gelu_tanh(a[3]));
                *(u32x2*)(gb + (size_t)t * 1024 + g * 16 + 4 * g4) = o; }
        }
    }
}

__device__ __forceinline__ void ph_scan(const Args& A, const Frame& F, int layer) {
    unsigned char* ws = A.ws; asm volatile("" : "+s"(ws));
    s5_carry(F, ws);
    ph_dn_a(A, F, layer, ws);
}

__device__ __forceinline__ void ph_post(const Args& A, const Frame& F, int layer) {
    unsigned char* ws = A.ws; asm volatile("" : "+s"(ws));
    const bf16* P = (const bf16*)(ws + WS_B + WB_P);
    const float* ob = (const float*)(ws + WS_B + WB_O);
    bf16* dno = (bf16*)(ws + WS_B + WB_DNO);
    const int c0 = 16 * F.lane;
    for (int t = row_lo(layer) + F.gw; t < TT; t += F.NGW) {
        {
            float o[16]; float ss = 0.f;
#pragma unroll
            for (int q = 0; q < 4; ++q) { const f32x4 a = *(const f32x4*)(ob + (size_t)t * 1024 + c0 + 4 * q), bq = *(const f32x4*)(ob + (size_t)(TT + t) * 1024 + c0 + 4 * q);
#pragma unroll
                for (int j = 0; j < 4; ++j) { o[4 * q + j] = a[j] + bq[j]; ss += o[4 * q + j] * o[4 * q + j]; } }
            ss += __shfl_xor(ss, 1); ss += __shfl_xor(ss, 2); ss += __shfl_xor(ss, 4);
            const float r = rsqrtf(ss * (1.f / 128.f) + EPS);
            const u32x4 za = *(const u32x4*)(P + (size_t)t * NPAD + PC_Z + c0), zb = *(const u32x4*)(P + (size_t)t * NPAD + PC_Z + c0 + 8);
            float z[16];
            z[0] = bflo(za.x); z[1] = bfhi(za.x); z[2] = bflo(za.y); z[3] = bfhi(za.y); z[4] = bflo(za.z); z[5] = bfhi(za.z); z[6] = bflo(za.w); z[7] = bfhi(za.w);
            z[8] = bflo(zb.x); z[9] = bfhi(zb.x); z[10] = bflo(zb.y); z[11] = bfhi(zb.y); z[12] = bflo(zb.z); z[13] = bfhi(zb.z); z[14] = bflo(zb.w); z[15] = bfhi(zb.w);
            const float* nw = inp(I_DNNORM) + (size_t)layer * 128 + (c0 & 127);
            float e[16];
#pragma unroll
            for (int j = 0; j < 16; ++j) e[j] = o[j] * r * nw[j] * siluf_(z[j]);
            u32x4 w0, w1;
            w0.x = pk2(e[0], e[1]); w0.y = pk2(e[2], e[3]); w0.z = pk2(e[4], e[5]); w0.w = pk2(e[6], e[7]);
            w1.x = pk2(e[8], e[9]); w1.y = pk2(e[10], e[11]); w1.z = pk2(e[12], e[13]); w1.w = pk2(e[14], e[15]);
            *(u32x4*)(dno + (size_t)t * 1024 + c0) = w0; *(u32x4*)(dno + (size_t)t * 1024 + c0 + 8) = w1;
        }
    }
}

__device__ __forceinline__ void ph_row2(const Args& A, const Frame& F, int layer) {
    unsigned char* ws = A.ws; asm volatile("" : "+s"(ws));
    const float* mods = (const float*)(ws + WS_MODS) + (size_t)layer * 5 * MODW;
    const float* mix = (const float*)(ws + WS_B + WB_MIX);
    float* xc = (float*)(ws + WS_X);
    bf16* hb = (bf16*)(ws + WS_AB);
    const float* nwp = inp(I_NMPOST) + (size_t)layer * DM;
    const float* nwf = inp(I_NFPRE) + (size_t)layer * DM;
    const float* wr = inp(I_ROUTER) + (size_t)layer * DM * NE;
    int* eidx = (int*)(ws + WS_EIDX); float* wts = (float*)(ws + WS_WTS);
    unsigned* cnt = (unsigned*)(ws + WS_CTL) + CW_CNT + layer * 128;
    LAS float* H = (LAS float*)F.lds;
    LAS float* PP = (LAS float*)(F.lds + 65536);
    const float ebias = inp(I_MBIAS)[layer * NE + F.lane];
    const int r0 = row_lo(layer), nitems = (TT - r0) / 8;
    for (int item = F.vcu; item < nitems; item += F.G) {
        const int t = r0 + item * 8 + F.wave;
        {
            const f32x4* mr4 = (const f32x4*)(mix + (size_t)t * DM) + F.lane;
            const f32x4* xr4 = (const f32x4*)xrow_ptr(ws, layer, t) + F.lane;
            const float* mrow = mods + (size_t)mods_row(t) * MODW;
            f32x4 v[8]; float ss = 0.f;
#pragma unroll
            for (int j = 0; j < 8; ++j) { v[j] = mr4[64 * j]; ss += (v[j].x * v[j].x + v[j].y * v[j].y) + (v[j].z * v[j].z + v[j].w * v[j].w); }
            const float r = rsqrtf(wave_sum(ss) * (1.f / DM) + EPS);
            float ss2 = 0.f;
#pragma unroll
            for (int j = 0; j < 8; ++j) { const int col = 4 * (F.lane + 64 * j);
                const f32x4 w = *(const f32x4*)(nwp + col), gt = *(const f32x4*)(mrow + 2 * DM + col), xo = xr4[64 * j];
                v[j] = xo + gt * (v[j] * r * w);
                *((f32x4*)(xc + (size_t)t * DM) + F.lane + 64 * j) = v[j];
                ss2 += (v[j].x * v[j].x + v[j].y * v[j].y) + (v[j].z * v[j].z + v[j].w * v[j].w); }
            const float r2 = rsqrtf(wave_sum(ss2) * (1.f / DM) + EPS);
            u32x2* ho = (u32x2*)(hb + (size_t)t * DM) + F.lane;
#pragma unroll
            for (int j = 0; j < 8; ++j) { const int col = 4 * (F.lane + 64 * j);
                const f32x4 w = *(const f32x4*)(nwf + col), sh = *(const f32x4*)(mrow + 3 * DM + col), sc = *(const f32x4*)(mrow + 4 * DM + col);
                const f32x4 y = (v[j] * r2 * w) * (1.f + sc) + sh;
                u32x2 q; q.x = pk2(y.x, y.y); q.y = pk2(y.z, y.w); ho[64 * j] = q;
                *((LAS f32x4*)(H + F.wave * DM) + F.lane + 64 * j) = y; }
        }
        __syncthreads();
        {
            float acc[8];
#pragma unroll
            for (int rr = 0; rr < 8; ++rr) acc[rr] = 0.f;
            const float* wp = wr + (size_t)(256 * F.wave) * NE + F.lane;
#pragma unroll 8
            for (int d4 = 0; d4 < 64; ++d4) {
                const float w0 = wp[(4 * d4) * NE], w1 = wp[(4 * d4 + 1) * NE], w2 = wp[(4 * d4 + 2) * NE], w3 = wp[(4 * d4 + 3) * NE];
#pragma unroll
                for (int rr = 0; rr < 8; ++rr) { const f32x4 h4 = *((const LAS f32x4*)(H + rr * DM + 256 * F.wave) + d4);
                    acc[rr] += h4.x * w0; acc[rr] += h4.y * w1; acc[rr] += h4.z * w2; acc[rr] += h4.w * w3; } }
#pragma unroll
            for (int rr = 0; rr < 8; ++rr) PP[(F.wave * 8 + rr) * 64 + F.lane] = acc[rr];
        }
        __syncthreads();
        {
            float logit = 0.f;
#pragma unroll
            for (int k8 = 0; k8 < 8; ++k8) logit += PP[(k8 * 8 + F.wave) * 64 + F.lane];
            const float score = 1.f / (1.f + expf(-logit));
            const float sel = score + ebias;
            float m1 = sel;
            m1 = fmaxf(m1, __shfl_xor(m1, 1)); m1 = fmaxf(m1, __shfl_xor(m1, 2)); m1 = fmaxf(m1, __shfl_xor(m1, 4));
            const unsigned long long eqm = __ballot(sel == m1);
            const int gbase = F.lane & ~7;
            const unsigned gm = (unsigned)((eqm >> gbase) & 0xffull);
            const int amax = gbase + __builtin_ctz(gm);
            float s2 = (F.lane == amax) ? -__builtin_inff() : sel;
            s2 = fmaxf(s2, __shfl_xor(s2, 1)); s2 = fmaxf(s2, __shfl_xor(s2, 2)); s2 = fmaxf(s2, __shfl_xor(s2, 4));
            const float gs = m1 + s2;
            int grank = 0; const int myg = F.lane >> 3;
#pragma unroll
            for (int g2 = 0; g2 < 8; ++g2) { const float og = __shfl(gs, g2 * 8); grank += (og > gs || (og == gs && g2 < myg)) ? 1 : 0; }
            const float selm = (grank < 4) ? sel : -__builtin_inff();
            int rank = 0;
#pragma unroll 8
            for (int e2 = 0; e2 < 64; ++e2) { const float os = __shfl(selm, e2); rank += (os > selm || (os == selm && e2 < F.lane)) ? 1 : 0; }
            const bool chosen = (grank < 4) && (rank < 8);
            const float wsum = wave_sum(chosen ? score : 0.f);
            if (chosen) { eidx[(size_t)t * 8 + rank] = F.lane; wts[(size_t)t * 8 + rank] = score / wsum * 2.5f; atomicAdd(cnt + F.lane, 1u); }
        }
        __syncthreads();
    }
}

__device__ __forceinline__ void ph_fill(const Args& A, const Frame& F, int layer) {
    unsigned char* ws = A.ws; asm volatile("" : "+s"(ws));
    unsigned* ctl = (unsigned*)(ws + WS_CTL);
    LAS int* off = (LAS int*)(F.lds);
    LAS int* cn = (LAS int*)(F.lds + 1024);
    const int r0 = row_lo(layer), nrows = TT - r0;
    if (F.tid < NEX) cn[F.tid] = (F.tid < NE) ? (int)__hip_atomic_load(ctl + CW_CNT + layer * 128 + F.tid, __ATOMIC_RELAXED, __HIP_MEMORY_SCOPE_AGENT) : nrows;
    __syncthreads();
    if (F.tid == 0) {
        int o = 0;
        for (int e = 0; e < NEX; ++e) { off[e] = o; o += (cn[e] + 255) & ~255; }
        off[NEX] = o;
    }
    __syncthreads();
    int* misc = (int*)(ws + WS_MISC) + layer * 1024;
    if (F.bx == 0) {
        const int ntiles = off[NEX] >> 8;
        for (int tl = F.tid; tl < ntiles; tl += 512) { int e = 0; for (int q = 0; q < NEX; ++q) if ((off[q] >> 8) <= tl) e = q; misc[tl] = e; }
        if (F.tid == 0) misc[512] = ntiles;
    }
    const int* eidx = (const int*)(ws + WS_EIDX);
    int* slot_of = (int*)(ws + WS_SLOT);
    int* rowmap = (int*)(ws + WS_ROWMAP);
    const int gt = F.vcu * 512 + F.tid, NT = F.G * 512;
    for (int it = gt; it < nrows * 9; it += NT) {
        const int t = r0 + it / 9, k = it % 9;
        int slot;
        if (k < 8) { const int e = eidx[(size_t)t * 8 + k]; slot = off[e] + (int)atomicAdd(ctl + CW_FILL + layer * 128 + e, 1u); }
        else slot = off[NE] + (t - r0);
        slot_of[(size_t)t * 9 + k] = slot; rowmap[slot] = t;
    }
    for (int e = F.wave; e < NE; e += 8) for (int r = off[e] + cn[e] + F.lane + 64 * F.vcu; r < off[e + 1]; r += 64 * F.G) rowmap[r] = r0;
}

__device__ __forceinline__ void ph_comb(const Args& A, const Frame& F, int layer) {
    unsigned char* ws = A.ws; asm volatile("" : "+s"(ws));
    const float* mods = (const float*)(ws + WS_MODS) + (size_t)layer * 5 * MODW;
    const bf16* ys = (const bf16*)(ws + WS_B + WB_HPERM);
    const int* slot_of = (const int*)(ws + WS_SLOT);
    const float* wts = (const float*)(ws + WS_WTS);
    float* xc = (float*)(ws + WS_X);
    const float* nw = inp(I_NFPOST) + (size_t)layer * DM;
    const bool last = (layer == NLAYER - 1);
    for (int t = row_lo(layer) + F.gw; t < TT; t += F.NGW) {
        float f[32];
#pragma unroll
        for (int j = 0; j < 32; ++j) f[j] = 0.f;
#pragma unroll
        for (int k = 0; k < 9; ++k) {
            const int slot = slot_of[(size_t)t * 9 + k]; const float w = (k < 8) ? wts[(size_t)t * 8 + k] : 1.f;
            const u32x4* yr = (const u32x4*)(ys + (size_t)slot * DM + 32 * F.lane);
#pragma unroll
            for (int q = 0; q < 4; ++q) { const u32x4 y = yr[q];
                f[8 * q + 0] += w * bflo(y.x); f[8 * q + 1] += w * bfhi(y.x); f[8 * q + 2] += w * bflo(y.y); f[8 * q + 3] += w * bfhi(y.y);
                f[8 * q + 4] += w * bflo(y.z); f[8 * q + 5] += w * bfhi(y.z); f[8 * q + 6] += w * bflo(y.w); f[8 * q + 7] += w * bfhi(y.w); }
            if (k % 3 == 2) asm volatile("" ::: "memory");
        }
        float ss = 0.f;
#pragma unroll
        for (int j = 0; j < 32; ++j) ss += f[j] * f[j];
        const float r = rsqrtf(wave_sum(ss) * (1.f / DM) + EPS);
        const float* mrow = mods + (size_t)mods_row(t) * MODW + 5 * DM;
        const int c0 = 32 * F.lane;
        float* xr = xc + (size_t)t * DM + c0;
#pragma unroll
        for (int q = 0; q < 8; ++q) { const f32x4 w = *(const f32x4*)(nw + c0 + 4 * q), gt = *(const f32x4*)(mrow + c0 + 4 * q), xo = *(const f32x4*)(xr + 4 * q);
            f32x4 y; y.x = xo.x + gt.x * (f[4 * q] * r * w.x); y.y = xo.y + gt.y * (f[4 * q + 1] * r * w.y); y.z = xo.z + gt.z * (f[4 * q + 2] * r * w.z); y.w = xo.w + gt.w * (f[4 * q + 3] * r * w.w);
            if (!last) *(f32x4*)(xr + 4 * q) = y;
            else if (t >= TC) *(f32x4*)(A.out + (size_t)(t - TC) * DM + c0 + 4 * q) = y; }
    }
}

constexpr int NPH = 15;
__device__ __forceinline__ bool ph_in(int lo, int hi, int k) { asm volatile("" : "+s"(lo), "+s"(hi)); return lo <= k && k < hi; }
constexpr int PER_PHASE_LAUNCH = MK_PER_PHASE;
#ifndef DBG_STOP
#define DBG_STOP 0
#endif

#ifndef PHMASK
#define PHMASK 0xFFFF
#endif
#define IN(k) (((PHMASK >> ((k) % NPH)) & 1) && ph_in(lo, hi, (k)))
#define GETWS const Frame F = make_frame(lds, wave_s); unsigned char* ws = args.ws; asm volatile("" : "+s"(ws)); bf16* Wb = (bf16*)(ws + WS_W)
#ifndef DBG_T
#define DBG_T (-1)
#endif
#ifndef DBG_DUP
#define DBG_DUP 0
#endif
#define REPS(k) ((((DBG_DUP) >> ((k) % NPH)) & 1) ? 2 : 1)
#define REPBAR(rep) do { if (rep) xcd_barrier(bar, wave_s); } while (0)
#define STAMP(k) do { if (DBG_T >= 0 && blockIdx.x == 0 && wave_s == 0 && lane_id() == 0) ((unsigned long long*)((unsigned*)(args.ws + WS_CTL) + CW_TS))[(k)] = __builtin_amdgcn_s_memrealtime(); } while (0)
#define SEAM(k) do { if (IN(k) && IN((k) + 1)) { xcd_barrier(bar, wave_s); STAMP((k) + 1); } } while (0)
template <int LAYER>
__device__ __forceinline__ void layer_body(const Args& args, LAS unsigned char* lds, const XcdBarrier& bar, int wave_s, int lo, int hi) {
    constexpr int layer = LAYER;
        const int pb = layer * NPH;
        for (int rep_ = 0; rep_ < REPS(pb + 0); ++rep_) if (IN(pb + 0)) { REPBAR(rep_); const Frame F = make_frame(lds, wave_s); ph_pre(args, F, layer); } SEAM(pb + 0);
        for (int rep_ = 0; rep_ < REPS(pb + 1); ++rep_) if (IN(pb + 1)) { REPBAR(rep_); const Frame F = make_frame(lds, wave_s); ph_n1(args, F, layer); } SEAM(pb + 1);
        for (int rep_ = 0; rep_ < REPS(pb + 2); ++rep_) if (IN(pb + 2)) { REPBAR(rep_);
            GETWS;
            pg8::Gemm g{(const pg8::bf16_t*)(ws + WS_AB), Wb + WO_IN / 2, TT, NPAD, DM}; pg8::StaticOrder S; S.init(TT, NPAD, F.G, F.bx);
            EpiInProj E{(bf16*)(ws + WS_B + WB_P), (bf16*)(ws + WS_B + WB_S5 + S5_UG)};
            pg8::gemm_phase<EpiInProj, pg8::StaticOrder>(F.lds, g, S, E, nullptr, F.tid);
        } SEAM(pb + 2);
        for (int rep_ = 0; rep_ < REPS(pb + 3); ++rep_) if (IN(pb + 3)) { REPBAR(rep_); const Frame F = make_frame(lds, wave_s); ph_prep(args, F, layer); } SEAM(pb + 3);
        for (int rep_ = 0; rep_ < REPS(pb + 4); ++rep_) if (IN(pb + 4)) { REPBAR(rep_); const Frame F = make_frame(lds, wave_s); ph_scan(args, F, layer); } SEAM(pb + 4);
        for (int rep_ = 0; rep_ < REPS(pb + 5); ++rep_) if (IN(pb + 5)) { REPBAR(rep_); const Frame F = make_frame(lds, wave_s); ph_dn_b(args, F, layer); } SEAM(pb + 5);
        for (int rep_ = 0; rep_ < REPS(pb + 6); ++rep_) if (IN(pb + 6)) { REPBAR(rep_); const Frame F = make_frame(lds, wave_s); ph_post(args, F, layer); } SEAM(pb + 6);
        for (int rep_ = 0; rep_ < REPS(pb + 7); ++rep_) if (IN(pb + 7)) { REPBAR(rep_);
            GETWS;
            constexpr size_t R0 = (size_t)(LAYER == NLAYER - 1 ? TC : 0); constexpr int MR = TT - (int)R0;
            pg8::Gemm g{(const pg8::bf16_t*)(ws + WS_B + WB_G) + R0 * 1024, Wb + WO_GLU / 2, MR, 1024, 1024}; pg8::StaticOrder S; S.init(MR, 1024, F.G, F.bx);
            EpiGlu E{(const bf16*)(ws + WS_B + WB_G) + R0 * 1024, (bf16*)(ws + WS_B + WB_S5O) + R0 * 1024};
            pg8::gemm_phase<EpiGlu, pg8::StaticOrder>(F.lds, g, S, E, nullptr, F.tid);
        } SEAM(pb + 7);
        for (int rep_ = 0; rep_ < REPS(pb + 8); ++rep_) if (IN(pb + 8)) { REPBAR(rep_); GETWS;
            constexpr size_t R0 = (size_t)(LAYER == NLAYER - 1 ? TC : 0); constexpr int MR = TT - (int)R0;
            { pg8::Gemm g{(const pg8::bf16_t*)(ws + WS_B + WB_S5O) + R0 * 1024, Wb + WO_BRS / 2, MR, DM, 1024}; pg8::StaticOrder S; S.init(MR, DM, F.G, F.bx);
              EpiBr<false> E{(const bf16*)(ws + WS_B + WB_P) + R0 * NPAD, PC_GS5, (float*)(ws + WS_B + WB_M1) + R0 * DM, nullptr};
              pg8::gemm_phase<EpiBr<false>, pg8::StaticOrder>(F.lds, g, S, E, nullptr, F.tid); }
            __syncthreads();
            { pg8::Gemm g{(const pg8::bf16_t*)(ws + WS_B + WB_DNO) + R0 * 1024, Wb + WO_BRD / 2, MR, DM, 1024}; pg8::StaticOrder S; S.init(MR, DM, F.G, F.bx);
              EpiBr<true> E{(const bf16*)(ws + WS_B + WB_P) + R0 * NPAD, PC_GDN, (float*)(ws + WS_B + WB_M1) + R0 * DM, (bf16*)(ws + WS_B + WB_M) + R0 * DM};
              pg8::gemm_phase<EpiBr<true>, pg8::StaticOrder>(F.lds, g, S, E, nullptr, F.tid); }
        } SEAM(pb + 8);
        for (int rep_ = 0; rep_ < REPS(pb + 9); ++rep_) if (IN(pb + 9)) { REPBAR(rep_);
            GETWS;
            constexpr size_t R0 = (size_t)(LAYER == NLAYER - 1 ? TC : 0); constexpr int MR = TT - (int)R0;
            pg8::Gemm g{(const pg8::bf16_t*)(ws + WS_B + WB_M) + R0 * DM, Wb + WO_OUT / 2, MR, DM, DM}; pg8::StaticOrder S; S.init(MR, DM, F.G, F.bx);
            pg8::EpiF32 E{(float*)(ws + WS_B + WB_MIX) + R0 * DM, DM, nullptr};
            pg8::gemm_phase<pg8::EpiF32, pg8::StaticOrder>(F.lds, g, S, E, nullptr, F.tid);
        } SEAM(pb + 9);
        for (int rep_ = 0; rep_ < REPS(pb + 10); ++rep_) if (IN(pb + 10)) { REPBAR(rep_); const Frame F = make_frame(lds, wave_s); ph_row2(args, F, layer); } SEAM(pb + 10);
        for (int rep_ = 0; rep_ < REPS(pb + 11); ++rep_) if (IN(pb + 11)) { REPBAR(rep_); const Frame F = make_frame(lds, wave_s); ph_fill(args, F, layer); } SEAM(pb + 11);
        for (int rep_ = 0; rep_ < REPS(pb + 12); ++rep_) if (IN(pb + 12)) { REPBAR(rep_);
            GETWS;
            const int* misc = (const int*)(ws + WS_MISC) + layer * 1024;
            const int ntiles = __builtin_amdgcn_readfirstlane((int)__hip_atomic_load(misc + 512, __ATOMIC_RELAXED, __HIP_MEMORY_SCOPE_AGENT));
            pg8::Gemm g{(const pg8::bf16_t*)(ws + WS_AB), Wb + WO_GU / 2, ntiles * 256, 1024, DM}; MoeOrder S{ntiles, 4, F.G, F.bx, misc};
            EpiSwiglu E{(bf16*)(ws + WS_B + WB_ACT)};
            pg8::gemm_phase<EpiSwiglu, MoeOrder, false, true>(F.lds, g, S, E, nullptr, F.tid, (const int*)(ws + WS_ROWMAP));
        } SEAM(pb + 12);
        for (int rep_ = 0; rep_ < REPS(pb + 13); ++rep_) if (IN(pb + 13)) { REPBAR(rep_);
            GETWS;
            const int* misc = (const int*)(ws + WS_MISC) + layer * 1024;
            const int ntiles = __builtin_amdgcn_readfirstlane((int)__hip_atomic_load(misc + 512, __ATOMIC_RELAXED, __HIP_MEMORY_SCOPE_AGENT));
            pg8::Gemm g{(const pg8::bf16_t*)(ws + WS_B + WB_ACT), Wb + WO_DN / 2, ntiles * 256, DM, EDIM}; MoeOrder S{ntiles, 8, F.G, F.bx, misc};
            EpiBf16Mod E{(bf16*)(ws + WS_B + WB_HPERM), DM, 8};
            pg8::gemm_phase<EpiBf16Mod, MoeOrder>(F.lds, g, S, E, nullptr, F.tid);
        } SEAM(pb + 13);
        for (int rep_ = 0; rep_ < REPS(pb + 14); ++rep_) if (IN(pb + 14)) { REPBAR(rep_); const Frame F = make_frame(lds, wave_s); ph_comb(args, F, layer); } SEAM(pb + 14);
    }

__global__ void __launch_bounds__(512, 2) hybrid_fwd(Args args) {
    extern __shared__ __attribute__((aligned(16))) unsigned char lds_raw[];
    LAS unsigned char* const lds = (LAS unsigned char*)lds_raw;
    volatile LAS unsigned* MISC = (volatile LAS unsigned*)(lds + LDS_MISC);
    const int wave_s = __builtin_amdgcn_readfirstlane((int)(threadIdx.x >> 6));
    if (threadIdx.x < 4) MISC[threadIdx.x] = 0u;
    __syncthreads();
    unsigned* ctl = (unsigned*)(args.ws + WS_CTL);
    XcdBarrier bar; bar.bar = ctl + CW_BAR; bar.x = 0; bar.st = nullptr;
    if (!PER_PHASE_LAUNCH) { bar.bar = ctl + CW_BAR; bar.x = xb_xcc_id(); bar.st = MISC; if (threadIdx.x == 0) (void)xb_add(&bar.bar[XB_XCNT(bar.x)], 1u); }
    const int lo = args.ph_lo, hi = args.ph_hi;
    STAMP(0);
    layer_body<0>(args, lds, bar, wave_s, lo, hi);
    layer_body<1>(args, lds, bar, wave_s, lo, hi);
    if (DBG_T >= 0) {
        xcd_barrier(bar, wave_s); STAMP(NLAYER * NPH);
        if (blockIdx.x == 0 && threadIdx.x == 0) { const unsigned long long* ts = (const unsigned long long*)((unsigned*)(args.ws + WS_CTL) + CW_TS);
            const float us = (float)(ts[DBG_T2 + 1] - ts[DBG_T]) * 0.01f; args.out[0] += 20.f * us; }
    }
    if (DBG_STOP && lo == 1000) {
        const float* xc = (const float*)(args.ws + WS_X) + (size_t)TC * DM;
        for (size_t i = (size_t)blockIdx.x * 512 + threadIdx.x; i < (size_t)TL * DM / 4; i += (size_t)gridDim.x * 512) ((f32x4*)args.out)[i] = ((const f32x4*)xc)[i];
    }
#undef IN
#undef SEAM
}

extern "C" void kernel_launch(void* const* d_in, const int* in_sizes, int n_in, void* d_out, int out_size, void* d_ws, size_t ws_size, hipStream_t stream) {
    static int grid = 0;
    if (grid == 0) {
        if (n_in != 35 || out_size != TL * DM || ws_size < WS_END) { fprintf(stderr, "kernel_launch: unexpected shapes (n_in %d out %d ws %zu need %zu)\n", n_in, out_size, ws_size, (size_t)WS_END); grid = -1; return; }
        int dev = 0, cus = 0;
        if (hipGetDevice(&dev) != hipSuccess || hipDeviceGetAttribute(&cus, hipDeviceAttributeMultiprocessorCount, dev) != hipSuccess) { grid = -1; return; }
        if (hipFuncSetAttribute((const void*)hybrid_fwd, hipFuncAttributeMaxDynamicSharedMemorySize, LDS_BYTES) != hipSuccess) { grid = -1; return; }
        int per_cu = 0;
        (void)hipOccupancyMaxActiveBlocksPerMultiprocessor(&per_cu, (const void*)hybrid_fwd, 512, LDS_BYTES);
        (void)hipGetLastError();
        if (per_cu < 1) { fprintf(stderr, "kernel_launch: occupancy query says %d blocks per CU\n", per_cu); }
        grid = cus;
    }
    if (grid < 0) return;
    (void)hipMemsetAsync((char*)d_ws + WS_CTL, 0, CTL_ZERO_BYTES, stream);
    Args a{};
    for (int i = 0; i < 35; ++i) a.in[i] = (const float*)d_in[i];
    a.out = (float*)d_out; a.ws = (unsigned char*)d_ws;
    if (PER_PHASE_LAUNCH) {
        for (int ph = 0; ph < (DBG_STOP ? DBG_STOP : NLAYER * NPH); ++ph) { a.ph_lo = ph; a.ph_hi = ph + 1; hipLaunchKernelGGL(hybrid_fwd, dim3(grid), dim3(512), LDS_BYTES, stream, a); }
        if (DBG_STOP) { a.ph_lo = 1000; a.ph_hi = 1001; hipLaunchKernelGGL(hybrid_fwd, dim3(grid), dim3(512), LDS_BYTES, stream, a); }
    } else {
        a.ph_lo = 0; a.ph_hi = NLAYER * NPH;
        hipLaunchKernelGGL(hybrid_fwd, dim3(grid), dim3(512), LDS_BYTES, stream, a);
    }
}
```
